# Optimizing an MI355X kernel written in HIP

```python
import jax, jax.numpy as jnp
from jax import lax
import numpy as np

D_MODEL = 2048
BATCH = 8
SEQ = 2048
DEPTH = 1

GRID_W = 64
CTX_LEN = 256
RET_HEADS = 8
RET_DK = 128
RET_DV = 256
RET_CHUNK = 128
RET_QK_W = RET_HEADS * RET_DK
RET_V_W = RET_HEADS * RET_DV
MLA_HEADS = 16
MLA_Q_RANK = 512
MLA_KV_RANK = 512
MLA_D_NOPE = 128
MLA_D_ROPE = 64
MLA_D_V = 128
MLA_V_W = MLA_HEADS * MLA_D_V
Q_BLOCK = 128
FFN_DIM = 5632
CONV_W = 3
ROPE_BASE = 10000.0
EPS = 1e-6
IN_SIZES = (RET_QK_W, RET_V_W, MLA_KV_RANK, MLA_D_ROPE,
            RET_QK_W, RET_V_W, MLA_Q_RANK, D_MODEL, D_MODEL)
CTX_COLS = RET_QK_W + RET_V_W + MLA_KV_RANK + MLA_D_ROPE
IN_COLS = CTX_COLS + RET_QK_W + RET_V_W + MLA_Q_RANK + 2 * D_MODEL

kernel_name = "hybrid_retention_mla_convffn_dit"


def rms_norm(t):
    tf = t.astype(jnp.float32)
    return (tf * lax.rsqrt(jnp.mean(tf * tf, axis=-1, keepdims=True) + EPS)).astype(t.dtype)


def split_cols(t, sizes):
    out, start = [], 0
    for s in sizes:
        out.append(t[..., start:start + s])
        start += s
    return out


def axial_rope(t, row, col):
    dr = t.shape[-1]
    q4 = dr // 4
    inv = ROPE_BASE ** (-jnp.arange(q4, dtype=jnp.float32) / q4)
    ang = jnp.stack([row[:, None] * inv, col[:, None] * inv], axis=1)
    ang = ang.reshape((t.shape[1],) + (1,) * (t.ndim - 3) + (2, q4))
    cos, sin = jnp.cos(ang).astype(t.dtype), jnp.sin(ang).astype(t.dtype)
    tr = t.reshape(t.shape[:-1] + (2, 2, q4))
    t1, t2 = tr[..., 0, :], tr[..., 1, :]
    return jnp.stack([t1 * cos - t2 * sin, t2 * cos + t1 * sin], axis=-2).reshape(t.shape)


def retention_scan(q, k, v, r0, log_gamma):
    b, L, h, _ = q.shape
    dv = v.shape[-1]
    n = L // RET_CHUNK
    pos = jnp.arange(RET_CHUNK, dtype=jnp.float32)
    diff = pos[:, None] - pos[None, :]
    lower = diff >= 0
    inner = jnp.where(lower[None], jnp.exp(jnp.where(lower, diff, 0.0)[None] * log_gamma[:, None, None]), 0.0)
    q_dec = jnp.exp((pos + 1.0)[:, None] * log_gamma[None, :])
    k_dec = jnp.exp((RET_CHUNK - 1.0 - pos)[:, None] * log_gamma[None, :])
    chunk_dec = jnp.exp(RET_CHUNK * log_gamma)

    def to_chunks(t):
        return t.reshape(b, n, RET_CHUNK, h, t.shape[-1]).transpose(1, 0, 2, 3, 4)

    def step(r, qkv):
        qc, kc, vc = qkv
        s = jnp.einsum('bihd,bjhd->bhij', qc, kc) * inner
        o = jnp.einsum('bhij,bjhe->bihe', s, vc) + jnp.einsum('bihd,bhde->bihe', qc * q_dec[:, :, None], r)
        r = r * chunk_dec[:, None, None] + jnp.einsum('bjhd,bjhe->bhde', kc * k_dec[:, :, None], vc)
        return r, o

    _, o = lax.scan(step, r0, (to_chunks(q), to_chunks(k), to_chunks(v)))
    return o.transpose(1, 0, 2, 3, 4).reshape(b, L, h, dv)


def mla_attention(q_nope, q_rope, k_nope, k_rope, v):
    b, s, h, dn = q_nope.shape
    dr = q_rope.shape[-1]
    nb = s // Q_BLOCK
    scale = (dn + dr) ** -0.5

    def block(args):
        qn, qr = args
        sc = jnp.einsum('bqhd,bkhd->bhqk', qn, k_nope) + jnp.einsum('bqhr,bkr->bhqk', qr, k_rope)
        p = jax.nn.softmax(sc.astype(jnp.float32) * scale, axis=-1).astype(v.dtype)
        return jnp.einsum('bhqk,bkhe->bqhe', p, v)

    qn_b = q_nope.reshape(b, nb, Q_BLOCK, h, dn).transpose(1, 0, 2, 3, 4)
    qr_b = q_rope.reshape(b, nb, Q_BLOCK, h, dr).transpose(1, 0, 2, 3, 4)
    o = lax.map(block, (qn_b, qr_b))
    return o.transpose(1, 0, 2, 3, 4).reshape(b, s, h * v.shape[-1])


def dwconv_centred(t, w, bias):
    L = t.shape[1]
    p = CONV_W // 2
    tp = jnp.pad(t, ((0, 0), (p, p), (0, 0)))
    out = bias
    for i in range(CONV_W):
        out = out + tp[:, i:i + L] * w[i]
    return out


def setup_inputs(seed: int = 0) -> dict:
    key = jax.random.key(seed)
    ks = jax.random.split(key, 24)

    def nrm(k, shape, s):
        return jax.random.normal(k, shape, jnp.float32) * s

    gam = 1.0 - 2.0 ** (-5.0 - np.arange(RET_HEADS))
    logit = jnp.asarray(np.log(gam / (1.0 - gam)), dtype=jnp.float32)
    return {
        "x": nrm(ks[0], (BATCH, SEQ, D_MODEL), 1.0),
        "c": nrm(ks[1], (BATCH, D_MODEL), 1.0),
        "ctx": nrm(ks[2], (BATCH, CTX_LEN, D_MODEL), 1.0),
        "c_ctx": nrm(ks[3], (D_MODEL,), 1.0),
        "w_ada": nrm(ks[4], (DEPTH, D_MODEL, 6 * D_MODEL), 0.5 * D_MODEL ** -0.5),
        "b_ada": nrm(ks[5], (DEPTH, 6 * D_MODEL), 0.01),
        "w_in": nrm(ks[6], (DEPTH, D_MODEL, IN_COLS), D_MODEL ** -0.5),
        "ret_decay_fwd": logit[None] + nrm(ks[7], (DEPTH, RET_HEADS), 0.05),
        "ret_decay_bwd": logit[None] + nrm(ks[8], (DEPTH, RET_HEADS), 0.05),
        "ret_gn": 1.0 + nrm(ks[9], (DEPTH, RET_V_W), 0.02),
        "w_ret_o": nrm(ks[10], (DEPTH, RET_V_W, D_MODEL), RET_V_W ** -0.5),
        "mla_q_norm": 1.0 + nrm(ks[11], (DEPTH, MLA_Q_RANK), 0.02),
        "w_q_up": nrm(ks[12], (DEPTH, MLA_Q_RANK, MLA_HEADS * (MLA_D_NOPE + MLA_D_ROPE)), MLA_Q_RANK ** -0.5),
        "mla_kv_norm": 1.0 + nrm(ks[13], (DEPTH, MLA_KV_RANK), 0.02),
        "w_kv_up": nrm(ks[14], (DEPTH, MLA_KV_RANK, MLA_HEADS * (MLA_D_NOPE + MLA_D_V)), MLA_KV_RANK ** -0.5),
        "w_mla_o": nrm(ks[15], (DEPTH, MLA_V_W, D_MODEL), MLA_V_W ** -0.5),
        "w_out": nrm(ks[16], (DEPTH, D_MODEL, D_MODEL), D_MODEL ** -0.5),
        "ffn_w_up": nrm(ks[17], (DEPTH, D_MODEL, 2 * FFN_DIM), D_MODEL ** -0.5),
        "ffn_conv_w": nrm(ks[18], (DEPTH, CONV_W, FFN_DIM), CONV_W ** -0.5),
        "ffn_conv_b": nrm(ks[19], (DEPTH, FFN_DIM), 0.01),
        "ffn_w_down": nrm(ks[20], (DEPTH, FFN_DIM, D_MODEL), FFN_DIM ** -0.5),
        "final_norm": 1.0 + nrm(ks[21], (D_MODEL,), 0.02),
    }


def reference(x, c, ctx, c_ctx, w_ada, b_ada, w_in, ret_decay_fwd, ret_decay_bwd, ret_gn, w_ret_o,
              mla_q_norm, w_q_up, mla_kv_norm, w_kv_up, w_mla_o, w_out,
              ffn_w_up, ffn_conv_w, ffn_conv_b, ffn_w_down, final_norm):
    b, s, d = x.shape
    lc = ctx.shape[1]
    rows = s // GRID_W
    row = jnp.repeat(jnp.arange(rows, dtype=jnp.float32), GRID_W)
    col = jnp.tile(jnp.arange(GRID_W, dtype=jnp.float32), rows)
    pos_c = jnp.arange(lc, dtype=jnp.float32)

    for l in range(DEPTH):
        mod = jax.nn.silu(c) @ w_ada[l] + b_ada[l]
        sh1, sc1, g1, sh2, sc2, g2 = jnp.split(mod, 6, axis=-1)
        mod_c = jax.nn.silu(c_ctx) @ w_ada[l][:, :2 * d] + b_ada[l][:2 * d]
        sh1c, sc1c = mod_c[:d], mod_c[d:]

        h = rms_norm(x) * (1.0 + sc1[:, None]) + sh1[:, None]
        hc = rms_norm(ctx) * (1.0 + sc1c) + sh1c
        rk, rv, kvd, kr, rq, rg, qd, gate_ret, gate_mla = split_cols(h @ w_in[l], IN_SIZES)
        rkc, rvc, kvdc, krc = split_cols(hc @ w_in[l][:, :CTX_COLS], IN_SIZES[:4])

        lg_f = jax.nn.log_sigmoid(ret_decay_fwd[l].astype(jnp.float32))
        lg_b = jax.nn.log_sigmoid(ret_decay_bwd[l].astype(jnp.float32))
        q_r = axial_rope(rq.reshape(b, s, RET_HEADS, RET_DK), row, col).astype(jnp.float32)
        k_r = (axial_rope(rk.reshape(b, s, RET_HEADS, RET_DK), row, col) * RET_DK ** -0.5).astype(jnp.float32)
        v_r = rv.reshape(b, s, RET_HEADS, RET_DV).astype(jnp.float32)
        k_rc = (rkc.reshape(b, lc, RET_HEADS, RET_DK) * RET_DK ** -0.5).astype(jnp.float32)
        v_rc = rvc.reshape(b, lc, RET_HEADS, RET_DV).astype(jnp.float32)
        w_cf = jnp.exp((lc - 1.0 - pos_c)[:, None] * lg_f[None])
        w_cb = jnp.exp(pos_c[:, None] * lg_b[None])
        r_ctx_f = jnp.einsum('bjhd,bjhe->bhde', k_rc * w_cf[:, :, None], v_rc)
        r_ctx_b = jnp.einsum('bjhd,bjhe->bhde', k_rc * w_cb[:, :, None], v_rc)
        o_f = retention_scan(q_r, k_r, v_r, r_ctx_f, lg_f)
        o_b = retention_scan(q_r[:, ::-1], k_r[:, ::-1], v_r[:, ::-1], r_ctx_b, lg_b)[:, ::-1]
        o_r = o_f + o_b
        o_r = o_r * lax.rsqrt(jnp.mean(o_r * o_r, axis=-1, keepdims=True) + EPS)
        o_r = o_r.reshape(b, s, RET_V_W).astype(x.dtype) * ret_gn[l] * jax.nn.silu(rg)
        ret_branch = o_r @ w_ret_o[l]

        q_m = (rms_norm(qd) * mla_q_norm[l]) @ w_q_up[l]
        q_m = q_m.reshape(b, s, MLA_HEADS, MLA_D_NOPE + MLA_D_ROPE)
        q_nope = q_m[..., :MLA_D_NOPE]
        q_rope = axial_rope(q_m[..., MLA_D_NOPE:], row, col)
        kv = ((rms_norm(kvd) * mla_kv_norm[l]) @ w_kv_up[l]).reshape(b, s, MLA_HEADS, MLA_D_NOPE + MLA_D_V)
        kvc = ((rms_norm(kvdc) * mla_kv_norm[l]) @ w_kv_up[l]).reshape(b, lc, MLA_HEADS, MLA_D_NOPE + MLA_D_V)
        k_rope = axial_rope(kr, row, col)
        k_nope_all = jnp.concatenate([kvc[..., :MLA_D_NOPE], kv[..., :MLA_D_NOPE]], axis=1)
        v_all = jnp.concatenate([kvc[..., MLA_D_NOPE:], kv[..., MLA_D_NOPE:]], axis=1)
        k_rope_all = jnp.concatenate([krc, k_rope], axis=1)
        mla_branch = mla_attention(q_nope, q_rope, k_nope_all, k_rope_all, v_all) @ w_mla_o[l]

        mixed = jax.nn.sigmoid(gate_ret) * ret_branch + jax.nn.sigmoid(gate_mla) * mla_branch
        x = x + g1[:, None] * (mixed @ w_out[l])

        h2 = rms_norm(x) * (1.0 + sc2[:, None]) + sh2[:, None]
        up = h2 @ ffn_w_up[l]
        a, v_f = up[..., :FFN_DIM], up[..., FFN_DIM:]
        a = dwconv_centred(a, ffn_conv_w[l], ffn_conv_b[l])
        x = x + g2[:, None] * ((jax.nn.silu(a) * v_f) @ ffn_w_down[l])

    return rms_norm(x) * final_norm
```

```cpp
#include <hip/hip_runtime.h>
#include <hip/hip_cooperative_groups.h>
#include <cstdio>
#include <cstdint>
namespace cg = cooperative_groups;

#ifndef MK_ONLY
#define MK_ONLY -1
#endif
#define PH_ON(k) (MK_ONLY < 0 || MK_ONLY == (k))
#ifndef MK_DEBUG
#define MK_DEBUG 0
#endif
#ifndef MK_REP
#define MK_REP -1
#endif
#ifndef MK_MULTI
#define MK_MULTI 0
#endif

typedef unsigned short bf16_t;
typedef short bf16x8 __attribute__((ext_vector_type(8)));
typedef short s16x4 __attribute__((ext_vector_type(4)));
typedef float f32x2 __attribute__((ext_vector_type(2)));
typedef float f32x4 __attribute__((ext_vector_type(4)));
typedef float f32x16 __attribute__((ext_vector_type(16)));
typedef unsigned u32x2 __attribute__((ext_vector_type(2)));
typedef unsigned u32x4 __attribute__((ext_vector_type(4)));
#define LAS __attribute__((address_space(3)))
#define DI __device__ __forceinline__

constexpr int NB = 8, SEQ = 2048, DM = 2048, LC = 256, TT = LC + SEQ  , MROWS = NB * TT  , SROWS = NB * SEQ  ;
constexpr int FFN = 5632, INCOLS = 11328, NIN = 11520  ;
constexpr float EPS = 1e-6f;
constexpr int NPHASE = 13;

constexpr size_t MB = 1024 * 1024;
constexpr size_t WS_MOD = 0;
constexpr size_t WS_SSQKV = WS_MOD + 9 * 12288 * 4;
constexpr size_t WS_SSQQ = WS_SSQKV + MROWS * 4;
constexpr size_t WS_DBG = WS_SSQQ + SROWS * 4;
constexpr size_t WS_BAR = WS_DBG + 4096;
constexpr size_t WS_ZERO_BYTES = WS_BAR + 3456 * 4;
constexpr size_t WS_SSQRET = 1 * MB;
constexpr size_t WS_WQUP = 2 * MB;
constexpr size_t WS_WKVUP = WS_WQUP + 3072ull * 512 * 2;
constexpr size_t WS_WRETO = WS_WKVUP + 4096ull * 512 * 2;
constexpr size_t WS_WMLAO = WS_WRETO + 2048ull * 2048 * 2;
constexpr size_t WS_WOUT = WS_WMLAO + 2048ull * 2048 * 2;
constexpr size_t WS_ARENA = WS_WOUT + 2048ull * 2048 * 2;
constexpr size_t WS_WIN = WS_ARENA;
constexpr size_t WS_WUP = WS_ARENA;
constexpr size_t SLOTA = (size_t)NIN * 2048 * 2;
constexpr size_t WS_ORET = WS_ARENA + SLOTA;
constexpr size_t WS_H2 = WS_ORET;
constexpr size_t WS_WDOWN = WS_ORET;
constexpr size_t SLOTB = (size_t)SROWS * 2048 * 2;
constexpr size_t WS_C = WS_ORET + SLOTB;
constexpr size_t WS_RG = WS_C;
constexpr size_t WS_MLAO = WS_C;
constexpr size_t WS_KVD = WS_RG + (size_t)SROWS * 2048 * 2;
constexpr size_t WS_QD = WS_KVD + (size_t)MROWS * 512 * 2;
constexpr size_t WS_KR = WS_QD + (size_t)SROWS * 512 * 2;
constexpr size_t WS_C2 = WS_KR + (size_t)MROWS * 64 * 2;
constexpr size_t WS_HBUF = WS_C2;
constexpr size_t WS_RK = WS_HBUF + (size_t)MROWS * 2048 * 2;
constexpr size_t WS_RV = WS_RK + (size_t)MROWS * 1024 * 2;
constexpr size_t WS_RQ = WS_RV + (size_t)MROWS * 2048 * 2;
constexpr size_t WS_QM = WS_C2;
constexpr size_t WS_KVUP = WS_QM + (size_t)SROWS * 3072 * 2;
constexpr size_t WS_TMP1 = WS_C2;
constexpr size_t WS_MIXED = WS_TMP1 + (size_t)SROWS * 2048 * 4;
constexpr size_t WS_ABUF = WS_C;
constexpr size_t WS_VBUF = WS_ABUF + (size_t)SROWS * FFN * 2;
constexpr size_t WS_END = WS_VBUF + (size_t)SROWS * FFN * 2;
static_assert(WS_KVUP + (size_t)MROWS * 4096 * 2 <= WS_END, "region C overflow");
static_assert(WS_RQ + (size_t)SROWS * 1024 * 2 <= WS_END, "region C overflow");
static_assert(WS_ZERO_BYTES <= WS_SSQRET, "zero region overflow");

struct Params {
    const float *x, *c, *ctx, *c_ctx, *w_ada, *b_ada, *w_in, *dec_f, *dec_b, *ret_gn, *w_ret_o, *q_norm, *w_q_up, *kv_norm, *w_kv_up, *w_mla_o, *w_out, *w_up, *conv_w, *conv_b, *w_down, *final_norm;
    float* out; unsigned char* ws;
    int ph_lo, ph_hi;
};

DI unsigned cvt_pk_bf16(float lo, float hi) { unsigned r; asm volatile("v_cvt_pk_bf16_f32 %0, %1, %2" : "=v"(r) : "v"(lo), "v"(hi)); return r; }
DI unsigned cvt_pk_bf16_t(float lo, float hi) { unsigned r; asm volatile("s_nop 1\n\tv_cvt_pk_bf16_f32 %0, %1, %2" : "=v"(r) : "v"(lo), "v"(hi)); return r; }
DI float bf_lo(unsigned w) { return __uint_as_float(w << 16); }
DI float bf_hi(unsigned w) { return __uint_as_float(w & 0xffff0000u); }
DI float sigmoidf_(float x) { return __builtin_amdgcn_rcpf(1.f + __expf(-x)); }
DI float siluf_(float x) { return x * sigmoidf_(x); }
DI float wave_sum(float v) {
#pragma unroll
    for (int o = 32; o > 0; o >>= 1) v += __shfl_xor(v, o);
    return v;
}


#define XB_TMO      128
#define XB_XCNT(j)  (256  + 64 * (j))
#define XB_XSUB(j)  (1280 + 64 * (j))
#define XB_XGEN(j)  (2304 + 64 * (j))
#define XB_TOP      3328
#define XB_TOPGEN   3392
#define XCD_BAR_WORDS 3456
#define XB_SPIN_CAP (1u << 20)
DI unsigned xb_ld(unsigned* p)              { return __hip_atomic_load(p, __ATOMIC_RELAXED, __HIP_MEMORY_SCOPE_AGENT); }
DI unsigned xb_add(unsigned* p, unsigned v) { return __hip_atomic_fetch_add(p, v, __ATOMIC_RELAXED, __HIP_MEMORY_SCOPE_AGENT); }
DI unsigned xb_xcc_id() { return (unsigned)__builtin_amdgcn_s_getreg((3 << 11) | 20) & 0xFu; }
#define XB_SPIN(cond, bar) do { unsigned _sp = 0; while (cond) { __builtin_amdgcn_s_sleep(1); \
    if ((++_sp & 255u) == 0u) { if (xb_ld(&(bar)[XB_TMO])) break; if (_sp > XB_SPIN_CAP) { atomicAdd(&(bar)[XB_TMO], 1u); break; } } } } while (0)
struct XcdBarrier { unsigned* bar; unsigned x; volatile LAS unsigned* st; };
DI XcdBarrier xcd_barrier_post(unsigned* bar, volatile LAS unsigned* st) {
    XcdBarrier b; b.bar = bar; b.x = xb_xcc_id(); b.st = st;
    if (threadIdx.x == 0) (void)xb_add(&bar[XB_XCNT(b.x)], 1u);
    return b;
}
DI void xcd_barrier_complete(unsigned* bar, unsigned x, unsigned& nloc, unsigned& nx) {
    const unsigned G = gridDim.x * gridDim.y * gridDim.z;
    unsigned sum, cnt, mine, sp = 0u;
    for (;;) {
        sum = 0u; cnt = 0u; mine = 0u;
#pragma unroll
        for (unsigned j = 0; j < 16; ++j) { const unsigned c = xb_ld(&bar[XB_XCNT(j)]); sum += c; cnt += (c > 0u) ? 1u : 0u; mine = (j == x) ? c : mine; }
        if (sum == G) break;
        __builtin_amdgcn_s_sleep(1);
        if ((++sp & 255u) == 0u) { if (xb_ld(&bar[XB_TMO])) break; if (sp > XB_SPIN_CAP) { atomicAdd(&bar[XB_TMO], 1u); break; } }
    }
    nloc = mine > 0u ? mine : 1u; nx = cnt > 0u ? cnt : 1u;
}
DI void xcd_barrier(const XcdBarrier& b) {
    asm volatile("s_waitcnt vmcnt(0)" ::: "memory");
    __syncthreads();
    if (threadIdx.x == 0) {
        unsigned* bar = b.bar;
        __builtin_amdgcn_s_waitcnt(0);
        unsigned nloc = b.st[0], nx = b.st[1];
        if (nloc == 0u) { xcd_barrier_complete(bar, b.x, nloc, nx); b.st[0] = nloc; b.st[1] = nx; }
        const unsigned old = xb_add(&bar[XB_XSUB(b.x)], 1u);
        const unsigned gen = old / nloc;
        if (old + 1u == (gen + 1u) * nloc) {
            __builtin_amdgcn_fence(__ATOMIC_RELEASE, "agent");
            asm volatile("s_waitcnt vmcnt(0)" ::: "memory");
            const unsigned og = xb_add(&bar[XB_TOP], 1u);
            const unsigned tg = og / nx;
            if (og + 1u == (tg + 1u) * nx) xb_add(&bar[XB_TOPGEN], 1u);
            else XB_SPIN(xb_ld(&bar[XB_TOPGEN]) == tg, bar);
            __builtin_amdgcn_fence(__ATOMIC_ACQUIRE, "agent");
            xb_add(&bar[XB_XGEN(b.x)], 1u);
            asm volatile("s_waitcnt vmcnt(0)" ::: "memory");
        } else {
            XB_SPIN(xb_ld(&bar[XB_XGEN(b.x)]) == gen, bar);
            __builtin_amdgcn_fence(__ATOMIC_ACQUIRE, "agent");
            asm volatile("s_waitcnt vmcnt(0)" ::: "memory");
        }
    }
    __syncthreads();
}

namespace pg8 {
constexpr int BM = 256, BK = 64, HALF = 128, HTB = HALF * BK * 2, STAGE_BYTES = 8 * HTB, NXCD = 8, WGM = 8;
DI int lds_byte(int r, int c) { const int st = (r >> 4) * 2 + (c >> 5), rr = r & 15, cc = c & 31, ob = rr * 64 + cc * 2; return st * 1024 + (ob ^ (((ob >> 9) & 1) << 5)); }
DI void stage_rc(int b, int& R, int& C) { const int st = b / 1024, sb = b % 1024, swz = sb ^ (((sb >> 9) & 1) << 5); R = (st >> 1) * 16 + swz / 64; C = (st & 1) * 32 + (swz % 64) / 2; }
DI int perm32(int rho) { const int n = rho >> 4, i = rho & 15; return 8 * (i >> 2) + 4 * n + (i & 3); }
struct Unit { int pm, pn; };
struct Gemm { const bf16_t* A; const bf16_t* Bt; int K; const bf16_t* A2; const bf16_t* Bt2; };

DI void tile_map(int L, int nM, int nN, int& pm, int& pn) {
    const int nwg = nM * nN; int wgid = L;
    { const int q = nwg / NXCD, r = nwg % NXCD, xcd = wgid % NXCD, off = wgid / NXCD; wgid = (xcd < r ? xcd * (q + 1) : r * (q + 1) + (xcd - r) * q) + off; }
    const int nig = WGM * nN, gid = wgid / nig, fm = gid * WGM, gsz = (nM - fm) < WGM ? (nM - fm) : WGM;
    pm = fm + ((wgid % nig) % gsz); pn = (wgid % nig) / gsz;
}
template <int KIND> struct Sched {
    int nM, nN, G, c;
    DI bool next(int i, Unit& u) const {
        const int L = i * G + c;
        if (KIND == 0) { if (L >= nM * nN) return false; tile_map(L, nM, nN, u.pm, u.pn); return true; }
        else {
            if (L < 2880) { int lm, ln; tile_map(L, 64, 45, lm, ln); u.pm = (lm >> 3) * 9 + 1 + (lm & 7); u.pn = ln; return true; }
            if (L < 3000) { int lm, ln; tile_map(L - 2880, 8, 15, lm, ln); u.pm = lm * 9; u.pn = ln; return true; }
            return false;
        }
    }
    DI void a_ready(const Unit&) const {}
    DI void done(const Unit&) const {}
};

template <class Epi, class SchedT>
DI void gemm_phase(LAS unsigned char* lds, const Gemm g, const SchedT& S, const Epi& E) {
    int tid = threadIdx.x; asm volatile("" : "+v"(tid));
    const int wid = __builtin_amdgcn_readfirstlane(tid >> 6), lane = tid & 63, wr = wid >> 2, wc = wid & 3, fr = lane & 15, fq = lane >> 4;
    constexpr bool DUAL = Epi::DUAL;
    const int K = g.K, nth = K / BK, nt = DUAL ? 2 * nth : nth;
    unsigned voffA[2], voffB[2];
#pragma unroll
    for (int i = 0; i < 2; ++i) { int R, C; stage_rc(tid * 16 + i * 8192, R, C); const int Rb = Epi::PERM ? ((R & ~31) + perm32(R & 31)) : R;
        voffA[i] = (unsigned)(R * K + C) * 2u; voffB[i] = (unsigned)(Rb * K + C) * 2u; }
    const size_t kstep = (size_t)(BK * 2);
    const size_t hstep = (size_t)HALF * K * 2;
    const size_t tstep = 2 * hstep;
    const unsigned ldsw = (unsigned)wid * 1024u;
    const int aoff = lds_byte(wr * 64 + fr, fq * 8), boff = lds_byte(wc * 32 + fr, fq * 8);
#define PG8_SA(b, h) (((b) * 2 + (h)) * HTB)
#define PG8_SB(b, h) ((4 + (b) * 2 + (h)) * HTB)
#define PG8_STAGE(bufoff, gbase, voff) do { _Pragma("unroll") for (int _i = 0; _i < 2; ++_i) \
        __builtin_amdgcn_global_load_lds((const unsigned*)((const char*)(gbase) + (voff)[_i]), (LAS unsigned*)(lds + (bufoff) + ldsw + _i * 8192), 16, 0, 0); } while (0)
#define PG8_LDA(dst, b, h) do { _Pragma("unroll") for (int m = 0; m < 4; ++m) _Pragma("unroll") for (int k = 0; k < 2; ++k) dst[m][k] = *(const LAS bf16x8*)(lds + PG8_SA(b, h) + aoff + m * 2048 + k * 1024); } while (0)
#define PG8_LDB(dst, b, h) do { _Pragma("unroll") for (int n = 0; n < 2; ++n) _Pragma("unroll") for (int k = 0; k < 2; ++k) dst[n][k] = *(const LAS bf16x8*)(lds + PG8_SB(b, h) + boff + n * 2048 + k * 1024); } while (0)
#define PG8_MMA(ai, bj, At, Bt) do { __builtin_amdgcn_s_setprio(1); _Pragma("unroll") for (int m = 0; m < 4; ++m) _Pragma("unroll") for (int n = 0; n < 2; ++n) _Pragma("unroll") for (int k = 0; k < 2; ++k) \
        acc[ai][bj][m][n] = __builtin_amdgcn_mfma_f32_16x16x32_bf16(Bt[n][k], At[m][k], acc[ai][bj][m][n], 0, 0, 0); __builtin_amdgcn_s_setprio(0); } while (0)
#define PG8_WAIT_V(n) asm volatile("s_waitcnt vmcnt(" #n ")" ::: "memory")
#define PG8_WAIT_L(n) asm volatile("s_waitcnt lgkmcnt(" #n ")" ::: "memory")
#define PG8_BAR __builtin_amdgcn_s_barrier()
#define PG8_SCHED __builtin_amdgcn_sched_barrier(0)
    Unit cur, nxt; int ui = 0;
    if (!S.next(0, cur)) return;
    f32x4 acc[2][2][4][2];
#pragma unroll
    for (int a = 0; a < 2; ++a)
#pragma unroll
        for (int b = 0; b < 2; ++b)
#pragma unroll
            for (int m = 0; m < 4; ++m)
#pragma unroll
                for (int n = 0; n < 2; ++n) acc[a][b][m][n] = (f32x4){0.f, 0.f, 0.f, 0.f};
    bf16x8 At[4][2], B0[2][2], B1[2][2];
    const char* cA = (const char*)g.A + (size_t)cur.pm * tstep; const char* cB = (const char*)g.Bt + (size_t)cur.pn * tstep;
    const char* cA2 = DUAL ? (const char*)g.A2 + (size_t)cur.pm * tstep : cA; const char* cB2 = DUAL ? (const char*)g.Bt2 + (size_t)cur.pn * tstep : cB;
    S.a_ready(cur);
    PG8_STAGE(PG8_SB(0, 0), cB, voffB); PG8_STAGE(PG8_SA(0, 0), cA, voffA); PG8_STAGE(PG8_SB(0, 1), cB + hstep, voffB); PG8_STAGE(PG8_SA(0, 1), cA + hstep, voffA);
    if (wr == 1) PG8_BAR;
    PG8_WAIT_V(4); PG8_BAR;
    PG8_STAGE(PG8_SB(1, 0), cB + kstep, voffB); PG8_STAGE(PG8_SA(1, 0), cA + kstep, voffA); PG8_STAGE(PG8_SB(1, 1), cB + hstep + kstep, voffB);
    PG8_WAIT_V(6); PG8_BAR;
    for (;;) {
        const bool has_next = S.next(ui + 1, nxt);
        const char* nA = has_next ? (const char*)g.A + (size_t)nxt.pm * tstep : cA; const char* nB = has_next ? (const char*)g.Bt + (size_t)nxt.pn * tstep : cB;
        for (int t = 0; t < nt; t += 2) {
            const bool last = (t == nt - 2);
            const bool h2a = DUAL && (t + 1 >= nth), h2b = DUAL && (t + 2 >= nth);
            const char* a1 = (h2a ? cA2 - (size_t)nth * kstep : cA) + (size_t)(t + 1) * kstep;
            const char* a2 = last ? nA : (h2b ? cA2 - (size_t)nth * kstep : cA) + (size_t)(t + 2) * kstep; const char* b2 = last ? nB : (h2b ? cB2 - (size_t)nth * kstep : cB) + (size_t)(t + 2) * kstep;
            const char* a3 = a2 + kstep; const char* b3 = b2 + kstep;
            if (last && has_next) S.a_ready(nxt);
            if constexpr (DUAL) { if (t == nth) { int fr_ = fr, fq_ = fq; asm volatile("" : "+v"(fr_), "+v"(fq_)); E.mid(acc, cur, wr, wc, fr_, fq_); } }
            PG8_LDB(B0, 0, 0); PG8_SCHED; PG8_LDA(At, 0, 0); PG8_STAGE(PG8_SA(1, 1), a1 + hstep, voffA);
            PG8_WAIT_L(8); PG8_BAR; PG8_WAIT_L(0); PG8_MMA(0, 0, At, B0); PG8_BAR; PG8_SCHED;
            PG8_LDB(B1, 0, 1); PG8_STAGE(PG8_SB(0, 0), b2, voffB);
            PG8_BAR; PG8_WAIT_L(0); PG8_MMA(0, 1, At, B1); PG8_BAR;
            PG8_LDA(At, 0, 1); PG8_STAGE(PG8_SA(0, 0), a2, voffA);
            PG8_BAR; PG8_WAIT_L(0); PG8_MMA(1, 0, At, B0); PG8_BAR; PG8_SCHED;
            PG8_STAGE(PG8_SB(0, 1), b2 + hstep, voffB);
            PG8_WAIT_V(6); PG8_BAR; PG8_MMA(1, 1, At, B1); PG8_BAR;
            PG8_LDB(B0, 1, 0); PG8_SCHED; PG8_LDA(At, 1, 0); PG8_STAGE(PG8_SA(0, 1), a2 + hstep, voffA);
            PG8_WAIT_L(8); PG8_BAR; PG8_WAIT_L(0); PG8_MMA(0, 0, At, B0); PG8_BAR; PG8_SCHED;
            PG8_LDB(B1, 1, 1); PG8_STAGE(PG8_SB(1, 0), b3, voffB);
            PG8_BAR; PG8_WAIT_L(0); PG8_MMA(0, 1, At, B1); PG8_BAR;
            PG8_LDA(At, 1, 1); PG8_STAGE(PG8_SA(1, 0), a3, voffA);
            PG8_BAR; PG8_WAIT_L(0); PG8_MMA(1, 0, At, B0); PG8_BAR; PG8_SCHED;
            PG8_STAGE(PG8_SB(1, 1), b3 + hstep, voffB);
            PG8_WAIT_V(6); PG8_BAR; PG8_MMA(1, 1, At, B1); PG8_BAR;
        }
        { int fr_ = fr, fq_ = fq; asm volatile("" : "+v"(fr_), "+v"(fq_)); E(acc, cur, wr, wc, fr_, fq_); } S.done(cur);
        if (!has_next) break;
#pragma unroll
        for (int a = 0; a < 2; ++a)
#pragma unroll
            for (int b = 0; b < 2; ++b)
#pragma unroll
                for (int m = 0; m < 4; ++m)
#pragma unroll
                    for (int n = 0; n < 2; ++n) acc[a][b][m][n] = (f32x4){0.f, 0.f, 0.f, 0.f};
        cur = nxt; cA = nA; cB = nB; ++ui;
        if constexpr (DUAL) { cA2 = (const char*)g.A2 + (size_t)cur.pm * tstep; cB2 = (const char*)g.Bt2 + (size_t)cur.pn * tstep; }
    }
    PG8_WAIT_V(0);
    if (wr == 0) PG8_BAR;
    PG8_BAR;
#undef PG8_SA
#undef PG8_SB
#undef PG8_STAGE
#undef PG8_LDA
#undef PG8_LDB
#undef PG8_MMA
#undef PG8_WAIT_V
#undef PG8_WAIT_L
#undef PG8_BAR
#undef PG8_SCHED
}
}
using pg8::Unit;
typedef const f32x4 (&AccRef)[2][2][4][2];

template <int ACT  >
DI void store_plain(AccRef acc, bf16_t* dst, size_t ld, int row0, int col0) {
#pragma unroll
    for (int ai = 0; ai < 2; ++ai)
#pragma unroll
        for (int m = 0; m < 4; ++m) { int rowi = row0 + ai * 128 + m * 16; asm volatile("" : "+v"(rowi)); bf16_t* rowp = dst + (size_t)rowi * ld + col0;
#pragma unroll
            for (int bj = 0; bj < 2; ++bj) { f32x4 v0 = acc[ai][bj][m][0], v1 = acc[ai][bj][m][1];
                if (ACT == 1) {
#pragma unroll
                    for (int j = 0; j < 4; ++j) { v0[j] = siluf_(v0[j]); v1[j] = siluf_(v1[j]); } }
                if (ACT == 2) {
#pragma unroll
                    for (int j = 0; j < 4; ++j) { v0[j] = sigmoidf_(v0[j]); v1[j] = sigmoidf_(v1[j]); } }
                u32x4 w;
                if (ACT == 0) { w.x = cvt_pk_bf16(v0[0], v0[1]); w.y = cvt_pk_bf16(v0[2], v0[3]); w.z = cvt_pk_bf16(v1[0], v1[1]); w.w = cvt_pk_bf16(v1[2], v1[3]); }
                else { w.x = cvt_pk_bf16_t(v0[0], v0[1]); w.y = cvt_pk_bf16_t(v0[2], v0[3]); w.z = cvt_pk_bf16_t(v1[0], v1[1]); w.w = cvt_pk_bf16_t(v1[2], v1[3]); }
                *(u32x4*)(rowp + bj * 128) = w; } }
}
DI void add_ssq(AccRef acc, float* ssq, int row0, int fq) {
#pragma unroll
    for (int ai = 0; ai < 2; ++ai)
#pragma unroll
        for (int m = 0; m < 4; ++m) { float s = 0.f;
#pragma unroll
            for (int bj = 0; bj < 2; ++bj)
#pragma unroll
                for (int n = 0; n < 2; ++n)
#pragma unroll
                    for (int j = 0; j < 4; ++j) { const float v = acc[ai][bj][m][n][j]; s += v * v; }
            s += __shfl_xor(s, 16); s += __shfl_xor(s, 32);
            if (fq == 0) atomicAdd(ssq + row0 + ai * 128 + m * 16, s); }
}
DI void store_rope128(AccRef acc, bf16_t* dst, int row0, int head0, int s0, bool do_rope, float scale, int wc, int fq) {
    const int half = wc >> 1, f0 = ((wc & 1) * 4 + fq) * 4;
    float inv[4];
#pragma unroll
    for (int j = 0; j < 4; ++j) inv[j] = __builtin_amdgcn_exp2f(-(float)(f0 + j) * 0.41524101186f) * 0.15915494309f;
#pragma unroll
    for (int ai = 0; ai < 2; ++ai)
#pragma unroll
        for (int m = 0; m < 4; ++m) { const int s = s0 + ai * 128 + m * 16; const float pos = (float)(half ? (s & 63) : (s >> 6));
            float cs[4], sn[4];
#pragma unroll
            for (int j = 0; j < 4; ++j) { const float rev = pos * inv[j]; cs[j] = do_rope ? __builtin_amdgcn_cosf(rev) : 1.f; sn[j] = do_rope ? __builtin_amdgcn_sinf(rev) : 0.f; }
#pragma unroll
            for (int bj = 0; bj < 2; ++bj) { const f32x4 t1 = acc[ai][bj][m][0], t2 = acc[ai][bj][m][1]; float o1[4], o2[4];
#pragma unroll
                for (int j = 0; j < 4; ++j) { o1[j] = (t1[j] * cs[j] - t2[j] * sn[j]) * scale; o2[j] = (t2[j] * cs[j] + t1[j] * sn[j]) * scale; }
                int rowi = row0 + ai * 128 + m * 16; asm volatile("" : "+v"(rowi)); bf16_t* p = dst + (size_t)rowi * 1024 + (head0 + bj) * 128 + half * 64 + f0;
                u32x2 w1, w2; w1.x = cvt_pk_bf16(o1[0], o1[1]); w1.y = cvt_pk_bf16(o1[2], o1[3]); w2.x = cvt_pk_bf16(o2[0], o2[1]); w2.y = cvt_pk_bf16(o2[2], o2[3]);
                *(u32x2*)p = w1; *(u32x2*)(p + 32) = w2; } }
}
DI void store_rope32(AccRef acc, int bj, const float (&rs)[2][4], bf16_t* dst, size_t ld, int row0, int colbase, int g, int s0, bool do_rope, int fq) {
    const int f0 = 4 * fq; float inv[4];
#pragma unroll
    for (int j = 0; j < 4; ++j) inv[j] = __builtin_amdgcn_exp2f(-(float)(f0 + j) * 0.83048202372f) * 0.15915494309f;
#pragma unroll
    for (int ai = 0; ai < 2; ++ai)
#pragma unroll
        for (int m = 0; m < 4; ++m) { const int s = s0 + ai * 128 + m * 16; const float pos = (float)(g ? (s & 63) : (s >> 6));
            const f32x4 t1 = (bj ? acc[ai][1][m][0] : acc[ai][0][m][0]) * rs[ai][m], t2 = (bj ? acc[ai][1][m][1] : acc[ai][0][m][1]) * rs[ai][m]; float o1[4], o2[4];
#pragma unroll
            for (int j = 0; j < 4; ++j) { const float rev = pos * inv[j]; const float cs = do_rope ? __builtin_amdgcn_cosf(rev) : 1.f, sn = do_rope ? __builtin_amdgcn_sinf(rev) : 0.f;
                o1[j] = t1[j] * cs - t2[j] * sn; o2[j] = t2[j] * cs + t1[j] * sn; }
            int rowi = row0 + ai * 128 + m * 16; asm volatile("" : "+v"(rowi)); bf16_t* p = dst + (size_t)rowi * ld + colbase + f0;
            u32x2 w1, w2; w1.x = cvt_pk_bf16(o1[0], o1[1]); w1.y = cvt_pk_bf16(o1[2], o1[3]); w2.x = cvt_pk_bf16(o2[0], o2[1]); w2.y = cvt_pk_bf16(o2[2], o2[3]);
            *(u32x2*)p = w1; *(u32x2*)(p + 16) = w2; }
}

struct EpiInProj {
    static constexpr bool PERM = true, DUAL = false;
    bf16_t *rk, *rv, *kvd, *kr, *rq, *rg, *qd, *gr, *gm; float *ssq_kv, *ssq_q; bf16_t* dcopy;
    DI void operator()(AccRef acc, const Unit& u, int wr, int wc, int fr, int fq) const {
        const int pn = u.pn, b = u.pm / 9, jt = u.pm % 9; const bool latent = jt != 0;
        const int trow0 = u.pm * 256 + wr * 64 + fr;
        const int srow0 = (b * 8 + jt - 1) * 256 + wr * 64 + fr;
        const int s0 = (jt - 1) * 256 + wr * 64 + fr;
        const int cw = wc * 32 + 8 * fq;
        if (pn < 4) store_rope128(acc, rk, trow0, pn * 2, s0, latent, 0.08838834764831845f, wc, fq);
        else if (pn < 12) store_plain<0>(acc, rv, 2048, trow0, (pn - 4) * 256 + cw);
        else if (pn < 14) { store_plain<0>(acc, kvd, 512, trow0, (pn - 12) * 256 + cw); add_ssq(acc, ssq_kv, trow0, fq); }
        else if (pn == 14) { if (wc < 2) { const float one[2][4] = {{1.f, 1.f, 1.f, 1.f}, {1.f, 1.f, 1.f, 1.f}}; store_rope32(acc, 0, one, kr, 64, trow0, wc * 32, wc, s0, latent, fq); } }
        else if (pn < 19) store_rope128(acc, rq, srow0, (pn - 15) * 2, s0, true, 1.f, wc, fq);
        else if (pn < 27) store_plain<1>(acc, rg, 2048, srow0, (pn - 19) * 256 + cw);
        else if (pn < 29) { store_plain<0>(acc, qd, 512, srow0, (pn - 27) * 256 + cw); add_ssq(acc, ssq_q, srow0, fq); }
        else if (pn < 37) store_plain<2>(acc, gr, 2048, srow0, (pn - 29) * 256 + cw);
        else store_plain<2>(acc, gm, 2048, srow0, (pn - 37) * 256 + cw);
    }
};
struct EpiQup {
    static constexpr bool PERM = true, DUAL = false;
    bf16_t* qm; const float* ssq_q;
    DI void operator()(AccRef acc, const Unit& u, int wr, int wc, int fr, int fq) const {
        const int row0 = u.pm * 256 + wr * 64 + fr; const int s0 = (u.pm & 7) * 256 + wr * 64 + fr;
        float rs[2][4];
#pragma unroll
        for (int ai = 0; ai < 2; ++ai)
#pragma unroll
            for (int m = 0; m < 4; ++m) rs[ai][m] = __builtin_amdgcn_rsqf(ssq_q[row0 + ai * 128 + m * 16] * (1.f / 512.f) + EPS);
#pragma unroll
        for (int bj = 0; bj < 2; ++bj) {
            const int gidx = u.pn * 8 + bj * 4 + wc, head = gidx / 6, gi = gidx % 6;
            if (gi < 4) {
#pragma unroll
                for (int ai = 0; ai < 2; ++ai)
#pragma unroll
                    for (int m = 0; m < 4; ++m) { const f32x4 v0 = acc[ai][bj][m][0] * rs[ai][m], v1 = acc[ai][bj][m][1] * rs[ai][m];
                        u32x4 w; w.x = cvt_pk_bf16(v0[0], v0[1]); w.y = cvt_pk_bf16(v0[2], v0[3]); w.z = cvt_pk_bf16(v1[0], v1[1]); w.w = cvt_pk_bf16(v1[2], v1[3]);
                        int rowi = row0 + ai * 128 + m * 16; asm volatile("" : "+v"(rowi));
                        *(u32x4*)(qm + (size_t)rowi * 3072 + head * 192 + gi * 32 + 8 * fq) = w; }
            } else store_rope32(acc, bj, rs, qm, 3072, row0, head * 192 + 128 + (gi - 4) * 32, gi - 4, s0, true, fq);
        }
    }
};
struct EpiKvup {
    static constexpr bool PERM = true, DUAL = false;
    bf16_t* kvup; const float* ssq_kv;
    DI void operator()(AccRef acc, const Unit& u, int wr, int wc, int fr, int fq) const {
        const int row0 = u.pm * 256 + wr * 64 + fr, col0 = u.pn * 256 + wc * 32 + 8 * fq;
        float rs[2][4];
#pragma unroll
        for (int ai = 0; ai < 2; ++ai)
#pragma unroll
            for (int m = 0; m < 4; ++m) rs[ai][m] = __builtin_amdgcn_rsqf(ssq_kv[row0 + ai * 128 + m * 16] * (1.f / 512.f) + EPS);
#pragma unroll
        for (int ai = 0; ai < 2; ++ai)
#pragma unroll
            for (int m = 0; m < 4; ++m) { int row = row0 + ai * 128 + m * 16; asm volatile("" : "+v"(row));
#pragma unroll
                for (int bj = 0; bj < 2; ++bj) { const f32x4 v0 = acc[ai][bj][m][0] * rs[ai][m], v1 = acc[ai][bj][m][1] * rs[ai][m];
                    u32x4 w; w.x = cvt_pk_bf16(v0[0], v0[1]); w.y = cvt_pk_bf16(v0[2], v0[3]); w.z = cvt_pk_bf16(v1[0], v1[1]); w.w = cvt_pk_bf16(v1[2], v1[3]);
                    *(u32x4*)(kvup + (size_t)row * 4096 + col0 + bj * 128) = w; } }
    }
};
struct EpiDual {
    static constexpr bool PERM = true, DUAL = true;
    const bf16_t *gr, *gm; bf16_t* mixed;
    DI void mid(f32x4 (&acc)[2][2][4][2], const Unit& u, int wr, int wc, int fr, int fq) const {
        const int row0 = u.pm * 256 + wr * 64 + fr, col0 = u.pn * 256 + wc * 32 + 8 * fq;
#pragma unroll
        for (int ai = 0; ai < 2; ++ai)
#pragma unroll
            for (int mp = 0; mp < 2; ++mp) { u32x4 ga[2][2], gb[2][2];
#pragma unroll
                for (int mm = 0; mm < 2; ++mm) { int rowi = row0 + ai * 128 + (mp * 2 + mm) * 16; asm volatile("" : "+v"(rowi));
#pragma unroll
                    for (int bj = 0; bj < 2; ++bj) { const size_t o = (size_t)rowi * 2048 + col0 + bj * 128; ga[mm][bj] = *(const u32x4*)(gr + o); gb[mm][bj] = *(const u32x4*)(gm + o); } }
#pragma unroll
                for (int mm = 0; mm < 2; ++mm)
#pragma unroll
                    for (int bj = 0; bj < 2; ++bj) { const u32x4 a = ga[mm][bj], b = gb[mm][bj]; f32x4 r0, r1;
                        r0[0] = bf_lo(a.x) * __builtin_amdgcn_rcpf(fmaxf(bf_lo(b.x), 1e-30f)); r0[1] = bf_hi(a.x) * __builtin_amdgcn_rcpf(fmaxf(bf_hi(b.x), 1e-30f));
                        r0[2] = bf_lo(a.y) * __builtin_amdgcn_rcpf(fmaxf(bf_lo(b.y), 1e-30f)); r0[3] = bf_hi(a.y) * __builtin_amdgcn_rcpf(fmaxf(bf_hi(b.y), 1e-30f));
                        r1[0] = bf_lo(a.z) * __builtin_amdgcn_rcpf(fmaxf(bf_lo(b.z), 1e-30f)); r1[1] = bf_hi(a.z) * __builtin_amdgcn_rcpf(fmaxf(bf_hi(b.z), 1e-30f));
                        r1[2] = bf_lo(a.w) * __builtin_amdgcn_rcpf(fmaxf(bf_lo(b.w), 1e-30f)); r1[3] = bf_hi(a.w) * __builtin_amdgcn_rcpf(fmaxf(bf_hi(b.w), 1e-30f));
                        acc[ai][bj][mp * 2 + mm][0] *= r0; acc[ai][bj][mp * 2 + mm][1] *= r1; }
                asm volatile("" ::: "memory"); }
    }
    DI void operator()(AccRef acc, const Unit& u, int wr, int wc, int fr, int fq) const {
        const int row0 = u.pm * 256 + wr * 64 + fr, col0 = u.pn * 256 + wc * 32 + 8 * fq;
#pragma unroll
        for (int ai = 0; ai < 2; ++ai) { u32x4 gg[4][2]; size_t off[4];
#pragma unroll
            for (int m = 0; m < 4; ++m) { int rowi = row0 + ai * 128 + m * 16; asm volatile("" : "+v"(rowi)); off[m] = (size_t)rowi * 2048 + col0;
#pragma unroll
                for (int bj = 0; bj < 2; ++bj) gg[m][bj] = *(const u32x4*)(gm + off[m] + bj * 128); }
#pragma unroll
            for (int m = 0; m < 4; ++m)
#pragma unroll
                for (int bj = 0; bj < 2; ++bj) { const u32x4 g = gg[m][bj]; const f32x4 a0 = acc[ai][bj][m][0], a1 = acc[ai][bj][m][1];
                    u32x4 w; w.x = cvt_pk_bf16(a0[0] * bf_lo(g.x), a0[1] * bf_hi(g.x)); w.y = cvt_pk_bf16(a0[2] * bf_lo(g.y), a0[3] * bf_hi(g.y));
                    w.z = cvt_pk_bf16(a1[0] * bf_lo(g.z), a1[1] * bf_hi(g.z)); w.w = cvt_pk_bf16(a1[2] * bf_lo(g.w), a1[3] * bf_hi(g.w));
                    *(u32x4*)(mixed + off[m] + bj * 128) = w; }
            asm volatile("" ::: "memory"); }
    }
};
struct EpiResid {
    static constexpr bool PERM = true, DUAL = false;
    const float* base; float* out; const float* mod; const float* b_ada; int chunk; float gscale;
    DI void operator()(AccRef acc, const Unit& u, int wr, int wc, int fr, int fq) const {
        const int row0 = u.pm * 256 + wr * 64 + fr, col0 = u.pn * 256 + wc * 32 + 8 * fq, b = u.pm >> 3;
        f32x4 gt[2][2];
#pragma unroll
        for (int bj = 0; bj < 2; ++bj)
#pragma unroll
            for (int n = 0; n < 2; ++n) { const int c = chunk * 2048 + col0 + bj * 128 + n * 4; gt[bj][n] = (*(const f32x4*)(mod + b * 12288 + c) + *(const f32x4*)(b_ada + c)) * gscale; }
#pragma unroll
        for (int ai = 0; ai < 2; ++ai)
#pragma unroll
            for (int mp = 0; mp < 2; ++mp) {
                f32x4 bv[2][2][2]; size_t off[2];
#pragma unroll
                for (int mm = 0; mm < 2; ++mm) { int rowi = row0 + ai * 128 + (mp * 2 + mm) * 16; asm volatile("" : "+v"(rowi)); off[mm] = (size_t)rowi * 2048 + col0;
#pragma unroll
                    for (int bj = 0; bj < 2; ++bj)
#pragma unroll
                        for (int n = 0; n < 2; ++n) bv[mm][bj][n] = *(const f32x4*)(base + off[mm] + bj * 128 + n * 4); }
#pragma unroll
                for (int mm = 0; mm < 2; ++mm)
#pragma unroll
                    for (int bj = 0; bj < 2; ++bj)
#pragma unroll
                        for (int n = 0; n < 2; ++n) *(f32x4*)(out + off[mm] + bj * 128 + n * 4) = bv[mm][bj][n] + gt[bj][n] * acc[ai][bj][mp * 2 + mm][n];
                asm volatile("" ::: "memory"); }
    }
};
struct EpiUp {
    static constexpr bool PERM = true, DUAL = false;
    bf16_t *a, *v;
    DI void operator()(AccRef acc, const Unit& u, int wr, int wc, int fr, int fq) const {
        const int row0 = u.pm * 256 + wr * 64 + fr, cw = wc * 32 + 8 * fq;
        if (u.pn < 22) store_plain<0>(acc, a, FFN, row0, u.pn * 256 + cw); else store_plain<0>(acc, v, FFN, row0, (u.pn - 22) * 256 + cw);
    }
};

namespace att {
constexpr int NW = 8, QBLK = 32, KVBLK = 64, NT = TT / KVBLK;
constexpr size_t SHM_V = KVBLK * 128 * 2, SHM_K = KVBLK * 128 * 2, SHM_KR = KVBLK * 64 * 2;
constexpr size_t OFF_K = 2 * SHM_V, OFF_KR = OFF_K + 2 * SHM_K, OFF_WS = OFF_KR + 2 * SHM_KR;
#define KSWZ(row, colB) ((row) * 256 + ((colB) ^ (((row) & 7) << 4)))
#define KRSWZ(row, colB) ((row) * 128 + ((colB) ^ (((row) & 7) << 4)))
#define SBAR() __builtin_amdgcn_sched_barrier(0)
DI int crow(int r, int hi) { return (r & 3) + 8 * (r >> 2) + 4 * hi; }
DI int v_st(int k, int c) { const int kk = (k & ~0xC) | ((k & 4) << 1) | ((k & 8) >> 1); return ((kk >> 3) * 4 + (c >> 5)) * 512 + ((kk & 7) * 32 + (c & 31)) * 2; }
DI int v_rd_base(int lane) { return ((lane & 3) << 3) | (((lane >> 2) & 3) << 6) | (((lane >> 4) & 1) << 5) | (((lane >> 5) & 1) << 8); }
constexpr int v_rd_off(int d0, int ks, int half) { return d0 * 512 + ks * 4096 + half * 2048; }
template <int OFF> DI s16x4 tr_read(int vb) { s16x4 r; asm volatile("ds_read_b64_tr_b16 %0, %1 offset:%2" : "=&v"(r) : "v"(vb), "i"(OFF) : "memory"); return r; }
template <int D0> DI void pv_one(f32x16& od, int vb, bf16x8 pa0, bf16x8 pa1, bf16x8 pa2, bf16x8 pa3) {
    const s16x4 l0 = tr_read<v_rd_off(D0, 0, 0)>(vb), h0 = tr_read<v_rd_off(D0, 0, 1)>(vb), l1 = tr_read<v_rd_off(D0, 1, 0)>(vb), h1 = tr_read<v_rd_off(D0, 1, 1)>(vb);
    const s16x4 l2 = tr_read<v_rd_off(D0, 2, 0)>(vb), h2 = tr_read<v_rd_off(D0, 2, 1)>(vb), l3 = tr_read<v_rd_off(D0, 3, 0)>(vb), h3 = tr_read<v_rd_off(D0, 3, 1)>(vb);
    asm volatile("s_waitcnt lgkmcnt(0)" ::: "memory"); SBAR();
#define PK(L, H) (bf16x8){L[0], L[1], L[2], L[3], H[0], H[1], H[2], H[3]}
    od = __builtin_amdgcn_mfma_f32_32x32x16_bf16(pa0, PK(l0, h0), od, 0, 0, 0);
    od = __builtin_amdgcn_mfma_f32_32x32x16_bf16(pa1, PK(l1, h1), od, 0, 0, 0);
    od = __builtin_amdgcn_mfma_f32_32x32x16_bf16(pa2, PK(l2, h2), od, 0, 0, 0);
    od = __builtin_amdgcn_mfma_f32_32x32x16_bf16(pa3, PK(l3, h3), od, 0, 0, 0);
#undef PK
}
DI void pv_d0(f32x16* o, int vb, bf16x8 pa0, bf16x8 pa1, bf16x8 pa2, bf16x8 pa3) {
    pv_one<0>(o[0], vb, pa0, pa1, pa2, pa3); pv_one<1>(o[1], vb, pa0, pa1, pa2, pa3); pv_one<2>(o[2], vb, pa0, pa1, pa2, pa3); pv_one<3>(o[3], vb, pa0, pa1, pa2, pa3);
}
DI void pack_p(const f32x16& p0, const f32x16& p1, bf16x8& pa0, bf16x8& pa1, bf16x8& pa2, bf16x8& pa3) {
#define PK4(P, BASE, OUT) do { unsigned a0 = cvt_pk_bf16_t(P[BASE + 0], P[BASE + 1]), a1 = cvt_pk_bf16_t(P[BASE + 2], P[BASE + 3]);   \
    unsigned b0 = cvt_pk_bf16_t(P[BASE + 4], P[BASE + 5]), b1 = cvt_pk_bf16_t(P[BASE + 6], P[BASE + 7]);                              \
    auto r0 = __builtin_amdgcn_permlane32_swap(a0, b0, false, false); auto r1 = __builtin_amdgcn_permlane32_swap(a1, b1, false, false); \
    u32x4 w = {r0[0], r1[0], r0[1], r1[1]}; OUT = *reinterpret_cast<bf16x8*>(&w); } while (0)
    PK4(p0, 0, pa0); PK4(p0, 8, pa1); PK4(p1, 0, pa2); PK4(p1, 8, pa3);
#undef PK4
}
constexpr float MLA_SCALE = 0.07216878364870322f;
constexpr float THR = 8.f;
DI void partialSM(f32x16& p0, f32x16& p1, float& m_reg, float& mn, float& alpha) {
    constexpr float C = MLA_SCALE * 1.4426950408889634f;
    float pmax = p0[0];
#pragma unroll
    for (int r = 1; r < 16; ++r) pmax = fmaxf(pmax, p0[r]);
#pragma unroll
    for (int r = 0; r < 16; ++r) pmax = fmaxf(pmax, p1[r]);
    { auto rr = __builtin_amdgcn_permlane32_swap(__float_as_uint(pmax), __float_as_uint(pmax), false, false); pmax = fmaxf(__uint_as_float(rr[0]), __uint_as_float(rr[1])); }
    if (__builtin_expect(__all(pmax - m_reg <= THR / MLA_SCALE), 1)) { mn = m_reg; alpha = 1.f; }
    else { mn = fmaxf(m_reg, pmax); alpha = __builtin_amdgcn_exp2f((m_reg - mn) * C); m_reg = mn; }
    const float mnC = -mn * C;
#pragma unroll
    for (int r = 0; r < 16; ++r) p0[r] = fmaf(p0[r], C, mnC);
#pragma unroll
    for (int r = 0; r < 16; ++r) p1[r] = fmaf(p1[r], C, mnC);
#pragma unroll
    for (int r = 0; r < 16; ++r) p0[r] = __builtin_amdgcn_exp2f(p0[r]);
}
DI void finishSM(f32x16& p0, f32x16& p1, float alpha, float& l_reg, bf16x8& pa0, bf16x8& pa1, bf16x8& pa2, bf16x8& pa3) {
#pragma unroll
    for (int r = 0; r < 16; ++r) p1[r] = __builtin_amdgcn_exp2f(p1[r]);
    float ps = 0;
#pragma unroll
    for (int r = 0; r < 16; ++r) ps += p0[r];
#pragma unroll
    for (int r = 0; r < 16; ++r) ps += p1[r];
    { auto rr = __builtin_amdgcn_permlane32_swap(__float_as_uint(ps), __float_as_uint(ps), false, false); ps = __uint_as_float(rr[0]) + __uint_as_float(rr[1]); }
    l_reg = l_reg * alpha + ps;
    pack_p(p0, p1, pa0, pa1, pa2, pa3);
}
template <int ND0>
DI void qkt(f32x16& p0, f32x16& p1, const char* Ks, const char* Krs, const bf16x8* qr, int r32, int hi, const char* qx = nullptr) {
    p0 = f32x16{}; p1 = f32x16{};
#pragma unroll
    for (int d0 = 0; d0 < 8; ++d0) { const int cb = (d0 * 16 + hi * 8) * 2;
        const bf16x8 b0 = *reinterpret_cast<const bf16x8*>(Ks + KSWZ(r32, cb));
        const bf16x8 b1 = *reinterpret_cast<const bf16x8*>(Ks + KSWZ(32 + r32, cb));
        p0 = __builtin_amdgcn_mfma_f32_32x32x16_bf16(b0, qr[d0], p0, 0, 0, 0);
        p1 = __builtin_amdgcn_mfma_f32_32x32x16_bf16(b1, qr[d0], p1, 0, 0, 0); }
    if (ND0 == 12) {
#pragma unroll
        for (int d0 = 0; d0 < 4; ++d0) { const int cb = (d0 * 16 + hi * 8) * 2;
            const bf16x8 b0 = *reinterpret_cast<const bf16x8*>(Krs + KRSWZ(r32, cb));
            const bf16x8 b1 = *reinterpret_cast<const bf16x8*>(Krs + KRSWZ(32 + r32, cb));
            const bf16x8 qf = *reinterpret_cast<const bf16x8*>(qx + d0 * 1024);
            p0 = __builtin_amdgcn_mfma_f32_32x32x16_bf16(b0, qf, p0, 0, 0, 0);
            p1 = __builtin_amdgcn_mfma_f32_32x32x16_bf16(b1, qf, p1, 0, 0, 0); }
    }
}

DI void mla_body(const bf16_t* __restrict__ Qb, const bf16_t* __restrict__ Kh, const bf16_t* __restrict__ Vh, const bf16_t* __restrict__ Krh, bf16_t* __restrict__ Ob, char* lds) {
    constexpr int LDQ = 3072, LDK = 4096, LDKR = 64, LDO = 2048;
    int tid = threadIdx.x; asm volatile("" : "+v"(tid));
    const int wid = tid >> 6, lane = tid & 63, r32 = lane & 31, hi = lane >> 5;
    char* V_lds = lds; char* K_lds = lds + OFF_K; char* Kr_lds = lds + OFF_KR;
    float* ws = (float*)(lds + OFF_WS) + wid * 64; float* li_l = ws; float* al_l = ws + 32;
    float m_reg = -1e30f, l_reg = 0; f32x16 o[4] = {}; bf16x8 qr[8];
    const bf16_t* Qw = Qb + (long)(wid * QBLK + r32) * LDQ + hi * 8;
    char* qx = lds + OFF_WS + 2048 + wid * 4096 + lane * 16;
#pragma unroll
    for (int d0 = 0; d0 < 8; ++d0) qr[d0] = *reinterpret_cast<const bf16x8*>(Qw + d0 * 16);
#pragma unroll
    for (int d0 = 0; d0 < 4; ++d0) *reinterpret_cast<bf16x8*>(qx + d0 * 1024) = *reinterpret_cast<const bf16x8*>(Qw + (8 + d0) * 16);
    const int sr = tid >> 4, sc = (tid & 15) * 8, vst0 = v_st(sr, sc), vst1 = v_st(32 + sr, sc);
    const int rr = tid >> 3, rc = (tid & 7) * 8;
    const int vb0 = (int)(uintptr_t)V_lds + v_rd_base(lane);
    struct { bf16x8 vs0, vs1, ks0, ks1, kr; } sr_[1];
#define SLOAD(i, k0) do { sr_[i].vs0 = *(const bf16x8*)(&Vh[(long)((k0) + sr) * LDK + sc]); sr_[i].vs1 = *(const bf16x8*)(&Vh[(long)((k0) + 32 + sr) * LDK + sc]); \
    sr_[i].ks0 = *(const bf16x8*)(&Kh[(long)((k0) + sr) * LDK + sc]); sr_[i].ks1 = *(const bf16x8*)(&Kh[(long)((k0) + 32 + sr) * LDK + sc]); \
    sr_[i].kr = *(const bf16x8*)(&Krh[(long)((k0) + rr) * LDKR + rc]); } while (0)
#define SWRITE(b, i) do { *(bf16x8*)(V_lds + (b) * SHM_V + vst0) = sr_[i].vs0; *(bf16x8*)(V_lds + (b) * SHM_V + vst1) = sr_[i].vs1; const int kc = sc * 2; \
    *(bf16x8*)(K_lds + (b) * SHM_K + KSWZ(sr, kc)) = sr_[i].ks0; *(bf16x8*)(K_lds + (b) * SHM_K + KSWZ(32 + sr, kc)) = sr_[i].ks1; \
    *(bf16x8*)(Kr_lds + (b) * SHM_KR + KRSWZ(rr, rc * 2)) = sr_[i].kr; } while (0)
#define SWAIT() asm volatile("s_waitcnt vmcnt(0)" ::: "memory")
#define RESC(a) do { if (__any((a) < 1.f)) { if (hi == 0) al_l[r32] = (a); asm volatile("s_waitcnt lgkmcnt(0)" ::: "memory"); \
    _Pragma("unroll") for (int d = 0; d < 4; ++d) _Pragma("unroll") for (int r = 0; r < 16; ++r) o[d][r] *= al_l[crow(r, hi)]; } } while (0)
    f32x16 pA0, pA1, pB0, pB1; float mnA, mnB, alA, alB; bf16x8 pa0, pa1, pa2, pa3;
    __syncthreads();
    SLOAD(0, 0); SWAIT(); SWRITE(0, 0); __syncthreads();
    qkt<12>(pA0, pA1, K_lds, Kr_lds, qr, r32, hi, qx); partialSM(pA0, pA1, m_reg, mnA, alA);
    SLOAD(0, KVBLK); SWAIT(); SWRITE(1, 0); __syncthreads();
    for (int j = 1; j + 1 < NT; j += 2) {
        SBAR(); qkt<12>(pB0, pB1, K_lds + SHM_K, Kr_lds + SHM_KR, qr, r32, hi, qx);
        finishSM(pA0, pA1, alA, l_reg, pa0, pa1, pa2, pa3); SBAR();
        SLOAD(0, (j + 1) * KVBLK); SBAR();
        pv_d0(o, vb0, pa0, pa1, pa2, pa3); partialSM(pB0, pB1, m_reg, mnB, alB);
        __syncthreads(); SWAIT(); SWRITE(0, 0);
        RESC(alB); __syncthreads();
        SBAR(); qkt<12>(pA0, pA1, K_lds, Kr_lds, qr, r32, hi, qx);
        finishSM(pB0, pB1, alB, l_reg, pa0, pa1, pa2, pa3); SBAR();
        SLOAD(0, (j + 2) * KVBLK); SBAR();
        pv_d0(o, vb0 + (int)SHM_V, pa0, pa1, pa2, pa3); partialSM(pA0, pA1, m_reg, mnA, alA);
        __syncthreads(); SWAIT(); SWRITE(1, 0);
        RESC(alA); __syncthreads();
    }
    SBAR(); qkt<12>(pB0, pB1, K_lds + SHM_K, Kr_lds + SHM_KR, qr, r32, hi, qx);
    finishSM(pA0, pA1, alA, l_reg, pa0, pa1, pa2, pa3); SBAR();
    pv_d0(o, vb0, pa0, pa1, pa2, pa3); partialSM(pB0, pB1, m_reg, mnB, alB);
    __syncthreads(); RESC(alB);
    finishSM(pB0, pB1, alB, l_reg, pa0, pa1, pa2, pa3); SBAR();
    pv_d0(o, vb0 + (int)SHM_V, pa0, pa1, pa2, pa3);
    if (hi == 0) li_l[r32] = l_reg; asm volatile("s_waitcnt lgkmcnt(0)" ::: "memory");
    float rli[16];
#pragma unroll
    for (int r = 0; r < 16; ++r) rli[r] = __builtin_amdgcn_rcpf(li_l[crow(r, hi)]);
    bf16_t* Ow = Ob + (long)(wid * QBLK) * LDO;
    int hio = hi, r32o = r32; asm volatile("" : "+v"(Ow), "+v"(hio), "+v"(r32o));
#pragma unroll
    for (int r = 0; r < 16; ++r) { const int orow = crow(r, hio);
#pragma unroll
        for (int d0 = 0; d0 < 4; ++d0) Ow[(long)orow * LDO + d0 * 32 + r32o] = (bf16_t)(cvt_pk_bf16(o[d0][r] * rli[r], 0.f) & 0xffffu); }
#undef SLOAD
#undef SWRITE
#undef SWAIT
#undef RESC
}

#define UNI(x) __int_as_float(__builtin_amdgcn_readfirstlane(__float_as_int(x)))
struct DecayTab { float af[4], bf[4], ab[4], bb[4], c32f, c32b; };
DI void decayP(f32x16& p0, f32x16& p1, int kt, int irow, int imin, int hi, float lf2, float lb2, const DecayTab& T) {
    if (kt < 4) {
        const float ff = (float)(irow + LC - kt * 64 - 4 * hi), fb = (float)(SEQ + kt * 64 + 4 * hi - irow);
#pragma unroll
        for (int r = 0; r < 16; ++r) { const float kf = (float)((r & 3) + 8 * (r >> 2));
            p0[r] *= __builtin_amdgcn_exp2f(lf2 * (ff - kf)) + __builtin_amdgcn_exp2f(lb2 * (fb + kf));
            p1[r] *= __builtin_amdgcn_exp2f(lf2 * (ff - kf - 32.f)) + __builtin_amdgcn_exp2f(lb2 * (fb + kf + 32.f)); }
    } else {
        const int j0 = (kt - 4) * 64;
        const float fd = (float)(irow - j0 - 4 * hi);
        if (j0 + 63 < imin) {
            const float A = __builtin_amdgcn_exp2f(lf2 * fd); float Ab[4];
#pragma unroll
            for (int q = 0; q < 4; ++q) Ab[q] = A * T.bf[q];
#pragma unroll
            for (int r = 0; r < 16; ++r) { const float w = Ab[r >> 2] * T.af[r & 3]; p0[r] *= w; p1[r] *= w * T.c32f; }
        } else if (j0 > imin + 31) {
            const float A = __builtin_amdgcn_exp2f(-lb2 * fd); float Ab[4];
#pragma unroll
            for (int q = 0; q < 4; ++q) Ab[q] = A * T.bb[q];
#pragma unroll
            for (int r = 0; r < 16; ++r) { const float w = Ab[r >> 2] * T.ab[r & 3]; p0[r] *= w; p1[r] *= w * T.c32b; }
        } else {
#pragma unroll
            for (int r = 0; r < 16; ++r) { const float kf = (float)((r & 3) + 8 * (r >> 2));
                const float d0 = fd - kf, d1 = d0 - 32.f;
                const float e0 = __builtin_amdgcn_exp2f(d0 >= 0.f ? lf2 * d0 : -lb2 * d0), e1 = __builtin_amdgcn_exp2f(d1 >= 0.f ? lf2 * d1 : -lb2 * d1);
                p0[r] *= (d0 == 0.f) ? 2.f : e0; p1[r] *= (d1 == 0.f) ? 2.f : e1; }
        }
    }
}
DI void ret_body(const bf16_t* __restrict__ Qb, const bf16_t* __restrict__ Kh, const bf16_t* __restrict__ Vh, bf16_t* __restrict__ Ob, float* __restrict__ ssq, int irow0, float lf2, float lb2, char* lds) {
    constexpr int LDQ = 1024, LDK = 1024, LDV = 2048, LDO = 2048;
    int tid = threadIdx.x; asm volatile("" : "+v"(tid));
    const int wid = __builtin_amdgcn_readfirstlane(tid >> 6), lane = tid & 63, r32 = lane & 31, hi = lane >> 5;
    char* V_lds = lds; char* K_lds = lds + OFF_K;
    DecayTab T;
#pragma unroll
    for (int m = 0; m < 4; ++m) { T.af[m] = UNI(__builtin_amdgcn_exp2f(-lf2 * (float)m)); T.bf[m] = UNI(__builtin_amdgcn_exp2f(-lf2 * (float)(8 * m))); T.ab[m] = UNI(__builtin_amdgcn_exp2f(lb2 * (float)m)); T.bb[m] = UNI(__builtin_amdgcn_exp2f(lb2 * (float)(8 * m))); }
    T.c32f = UNI(__builtin_amdgcn_exp2f(-lf2 * 32.f)); T.c32b = UNI(__builtin_amdgcn_exp2f(lb2 * 32.f));
    const int imin = irow0 + wid * QBLK;
    f32x16 o[4] = {}; bf16x8 qr[8];
    const bf16_t* Qw = Qb + (long)(wid * QBLK + r32) * LDQ + hi * 8;
#pragma unroll
    for (int d0 = 0; d0 < 8; ++d0) qr[d0] = *reinterpret_cast<const bf16x8*>(Qw + d0 * 16);
    const int irow = irow0 + wid * QBLK + r32;
    const int sr = tid >> 4, sc = (tid & 15) * 8, vst0 = v_st(sr, sc), vst1 = v_st(32 + sr, sc);
    const int vb0 = (int)(uintptr_t)V_lds + v_rd_base(lane);
    struct { bf16x8 vs0, vs1, ks0, ks1; } sr_[1];
#define SLOAD(i, k0) do { sr_[i].vs0 = *(const bf16x8*)(&Vh[(long)((k0) + sr) * LDV + sc]); sr_[i].vs1 = *(const bf16x8*)(&Vh[(long)((k0) + 32 + sr) * LDV + sc]); \
    sr_[i].ks0 = *(const bf16x8*)(&Kh[(long)((k0) + sr) * LDK + sc]); sr_[i].ks1 = *(const bf16x8*)(&Kh[(long)((k0) + 32 + sr) * LDK + sc]); } while (0)
#define SWRITE(b, i) do { *(bf16x8*)(V_lds + (b) * SHM_V + vst0) = sr_[i].vs0; *(bf16x8*)(V_lds + (b) * SHM_V + vst1) = sr_[i].vs1; const int kc = sc * 2; \
    *(bf16x8*)(K_lds + (b) * SHM_K + KSWZ(sr, kc)) = sr_[i].ks0; *(bf16x8*)(K_lds + (b) * SHM_K + KSWZ(32 + sr, kc)) = sr_[i].ks1; } while (0)
#define SWAIT() asm volatile("s_waitcnt vmcnt(0)" ::: "memory")
    f32x16 pA0, pA1, pB0, pB1; bf16x8 pa0, pa1, pa2, pa3;
    __syncthreads();
    SLOAD(0, 0); SWAIT(); SWRITE(0, 0); __syncthreads();
    qkt<8>(pA0, pA1, K_lds, K_lds, qr, r32, hi); decayP(pA0, pA1, 0, irow, imin, hi, lf2, lb2, T);
    SLOAD(0, KVBLK); SWAIT(); SWRITE(1, 0); __syncthreads();
    for (int j = 1; j + 1 < NT; j += 2) {
        SBAR(); qkt<8>(pB0, pB1, K_lds + SHM_K, K_lds, qr, r32, hi);
        pack_p(pA0, pA1, pa0, pa1, pa2, pa3); SBAR();
        SLOAD(0, (j + 1) * KVBLK); SBAR();
        pv_d0(o, vb0, pa0, pa1, pa2, pa3); decayP(pB0, pB1, j, irow, imin, hi, lf2, lb2, T);
        __syncthreads(); SWAIT(); SWRITE(0, 0);
        __syncthreads();
        SBAR(); qkt<8>(pA0, pA1, K_lds, K_lds, qr, r32, hi);
        pack_p(pB0, pB1, pa0, pa1, pa2, pa3); SBAR();
        SLOAD(0, (j + 2) * KVBLK); SBAR();
        pv_d0(o, vb0 + (int)SHM_V, pa0, pa1, pa2, pa3); decayP(pA0, pA1, j + 1, irow, imin, hi, lf2, lb2, T);
        __syncthreads(); SWAIT(); SWRITE(1, 0);
        __syncthreads();
    }
    SBAR(); qkt<8>(pB0, pB1, K_lds + SHM_K, K_lds, qr, r32, hi);
    pack_p(pA0, pA1, pa0, pa1, pa2, pa3); SBAR();
    pv_d0(o, vb0, pa0, pa1, pa2, pa3); decayP(pB0, pB1, NT - 1, irow, imin, hi, lf2, lb2, T);
    __syncthreads();
    pack_p(pB0, pB1, pa0, pa1, pa2, pa3); SBAR();
    pv_d0(o, vb0 + (int)SHM_V, pa0, pa1, pa2, pa3);
    bf16_t* Ow = Ob + (long)(wid * QBLK) * LDO; float* ssw = ssq + (long)(wid * QBLK) * 8;
    int hio = hi, r32o = r32; asm volatile("" : "+v"(Ow), "+v"(ssw), "+v"(hio), "+v"(r32o));
#pragma unroll
    for (int r = 0; r < 16; ++r) { const int orow = crow(r, hio);
        float s = 0.f;
#pragma unroll
        for (int d0 = 0; d0 < 4; ++d0) { s += o[d0][r] * o[d0][r]; Ow[(long)orow * LDO + d0 * 32 + r32o] = (bf16_t)(cvt_pk_bf16(o[d0][r], 0.f) & 0xffffu); }
#pragma unroll
        for (int x = 1; x < 32; x <<= 1) s += __shfl_xor(s, x);
        if (r32o == 0) ssw[(long)orow * 8] = s; }
#undef SLOAD
#undef SWRITE
#undef SWAIT
}
DI void decay32(f32x16& p0, int kt, int irow, int imin, int hi, float lf2, float lb2, const DecayTab& T) {
    if (kt < 8) {
        const float ff = (float)(irow + LC - kt * 32 - 4 * hi), fb = (float)(SEQ + kt * 32 + 4 * hi - irow);
#pragma unroll
        for (int r = 0; r < 16; ++r) { const float kf = (float)((r & 3) + 8 * (r >> 2)); p0[r] *= __builtin_amdgcn_exp2f(lf2 * (ff - kf)) + __builtin_amdgcn_exp2f(lb2 * (fb + kf)); }
    } else {
        const int j0 = (kt - 8) * 32; const float fd = (float)(irow - j0 - 4 * hi);
        if (j0 < imin) {
            const float A = __builtin_amdgcn_exp2f(lf2 * fd); float Ab[4];
#pragma unroll
            for (int q = 0; q < 4; ++q) Ab[q] = A * T.bf[q];
#pragma unroll
            for (int r = 0; r < 16; ++r) p0[r] *= Ab[r >> 2] * T.af[r & 3];
        } else if (j0 > imin) {
            const float A = __builtin_amdgcn_exp2f(-lb2 * fd); float Ab[4];
#pragma unroll
            for (int q = 0; q < 4; ++q) Ab[q] = A * T.bb[q];
#pragma unroll
            for (int r = 0; r < 16; ++r) p0[r] *= Ab[r >> 2] * T.ab[r & 3];
        } else {
#pragma unroll
            for (int r = 0; r < 16; ++r) { const float d0 = fd - (float)((r & 3) + 8 * (r >> 2));
                const float e0 = __builtin_amdgcn_exp2f(d0 >= 0.f ? lf2 * d0 : -lb2 * d0); p0[r] *= (d0 == 0.f) ? 2.f : e0; }
        }
    }
}
template <int D0> DI void pv32_one(f32x16& od, int vb, bf16x8 pa0, bf16x8 pa1) {
    const s16x4 l0 = tr_read<v_rd_off(D0, 0, 0)>(vb), h0 = tr_read<v_rd_off(D0, 0, 1)>(vb), l1 = tr_read<v_rd_off(D0, 1, 0)>(vb), h1 = tr_read<v_rd_off(D0, 1, 1)>(vb);
    asm volatile("s_waitcnt lgkmcnt(0)" ::: "memory"); SBAR();
#define PK(L, H) (bf16x8){L[0], L[1], L[2], L[3], H[0], H[1], H[2], H[3]}
    od = __builtin_amdgcn_mfma_f32_32x32x16_bf16(pa0, PK(l0, h0), od, 0, 0, 0);
    od = __builtin_amdgcn_mfma_f32_32x32x16_bf16(pa1, PK(l1, h1), od, 0, 0, 0);
#undef PK
}
DI void ret_body3(const bf16_t* __restrict__ Qb, const bf16_t* __restrict__ Kh, const bf16_t* __restrict__ Vh, bf16_t* __restrict__ Ob, float* __restrict__ ssq, int irow0, float lf2, float lb2, char* lds) {
    constexpr int LDQ = 1024, LDK = 1024, LDV = 2048, LDO = 2048, KB = 32, NT3 = TT / KB, VIMG = 8192, VBUF = 2 * VIMG, KBUF = 8192, OFFK3 = 2 * VBUF;
    int tid = threadIdx.x; asm volatile("" : "+v"(tid));
    const int wid = __builtin_amdgcn_readfirstlane(tid >> 6), lane = tid & 63, r32 = lane & 31, hi = lane >> 5;
    char* V_lds = lds; char* K_lds = lds + OFFK3;
    DecayTab T;
#pragma unroll
    for (int m = 0; m < 4; ++m) { T.af[m] = UNI(__builtin_amdgcn_exp2f(-lf2 * (float)m)); T.bf[m] = UNI(__builtin_amdgcn_exp2f(-lf2 * (float)(8 * m))); T.ab[m] = UNI(__builtin_amdgcn_exp2f(lb2 * (float)m)); T.bb[m] = UNI(__builtin_amdgcn_exp2f(lb2 * (float)(8 * m))); }
    T.c32f = 0.f; T.c32b = 0.f;
    const int imin = irow0 + wid * QBLK;
    f32x16 o[8] = {}; bf16x8 qr[8];
    const bf16_t* Qw = Qb + (long)(wid * QBLK + r32) * LDQ + hi * 8;
#pragma unroll
    for (int d0 = 0; d0 < 8; ++d0) qr[d0] = *reinterpret_cast<const bf16x8*>(Qw + d0 * 16);
    const int irow = irow0 + wid * QBLK + r32;
    const int sr = tid >> 4, sc = (tid & 15) * 8, vst0 = v_st(sr, sc), kst0 = KSWZ(sr, sc * 2);
    const int vb0 = (int)(uintptr_t)V_lds + v_rd_base(lane);
    bf16x8 vsa, vsb, ks;
#define SLOAD3(k0) do { vsa = *(const bf16x8*)(&Vh[(long)((k0) + sr) * LDV + sc]); vsb = *(const bf16x8*)(&Vh[(long)((k0) + sr) * LDV + 128 + sc]); ks = *(const bf16x8*)(&Kh[(long)((k0) + sr) * LDK + sc]); } while (0)
#define SWRITE3(b) do { *(bf16x8*)(V_lds + (b) * VBUF + vst0) = vsa; *(bf16x8*)(V_lds + (b) * VBUF + VIMG + vst0) = vsb; *(bf16x8*)(K_lds + (b) * KBUF + kst0) = ks; } while (0)
    f32x16 p0; bf16x8 pa0, pa1;
    __syncthreads();
    SLOAD3(0); asm volatile("s_waitcnt vmcnt(0)" ::: "memory"); SWRITE3(0); __syncthreads();
    for (int j = 0; j < NT3; ++j) {
        const int bsel = j & 1;
        if (j + 1 < NT3) SLOAD3((j + 1) * KB);
        SBAR();
        { const char* Ks = K_lds + bsel * KBUF; p0 = f32x16{};
#pragma unroll
          for (int d0 = 0; d0 < 8; ++d0) { const bf16x8 b0 = *reinterpret_cast<const bf16x8*>(Ks + KSWZ(r32, (d0 * 16 + hi * 8) * 2)); p0 = __builtin_amdgcn_mfma_f32_32x32x16_bf16(b0, qr[d0], p0, 0, 0, 0); } }
        decay32(p0, j, irow, imin, hi, lf2, lb2, T);
        {
#define PK4(P, BASE, OUT) do { unsigned a0 = cvt_pk_bf16(P[BASE + 0], P[BASE + 1]), a1 = cvt_pk_bf16(P[BASE + 2], P[BASE + 3]);   \
    unsigned b0 = cvt_pk_bf16(P[BASE + 4], P[BASE + 5]), b1 = cvt_pk_bf16(P[BASE + 6], P[BASE + 7]);                              \
    auto r0 = __builtin_amdgcn_permlane32_swap(a0, b0, false, false); auto r1 = __builtin_amdgcn_permlane32_swap(a1, b1, false, false); \
    u32x4 w = {r0[0], r1[0], r0[1], r1[1]}; OUT = *reinterpret_cast<bf16x8*>(&w); } while (0)
          PK4(p0, 0, pa0); PK4(p0, 8, pa1);
#undef PK4
        }
        SBAR();
        { const int vb = vb0 + bsel * VBUF;
          pv32_one<0>(o[0], vb, pa0, pa1); pv32_one<1>(o[1], vb, pa0, pa1); pv32_one<2>(o[2], vb, pa0, pa1); pv32_one<3>(o[3], vb, pa0, pa1);
          pv32_one<0>(o[4], vb + VIMG, pa0, pa1); pv32_one<1>(o[5], vb + VIMG, pa0, pa1); pv32_one<2>(o[6], vb + VIMG, pa0, pa1); pv32_one<3>(o[7], vb + VIMG, pa0, pa1); }
        if (j + 1 < NT3) { asm volatile("s_waitcnt vmcnt(0)" ::: "memory"); SWRITE3(bsel ^ 1); }
        __syncthreads();
    }
    bf16_t* Ow = Ob + (long)(wid * QBLK) * LDO; float* ssw = ssq + (long)(wid * QBLK) * 8;
    int hio = hi, r32o = r32; asm volatile("" : "+v"(Ow), "+v"(ssw), "+v"(hio), "+v"(r32o));
#pragma unroll
    for (int r = 0; r < 16; ++r) { const int orow = crow(r, hio);
        float s = 0.f;
#pragma unroll
        for (int d0 = 0; d0 < 8; ++d0) { s += o[d0][r] * o[d0][r]; Ow[(long)orow * LDO + d0 * 32 + r32o] = (bf16_t)(cvt_pk_bf16(o[d0][r], 0.f) & 0xffffu); }
#pragma unroll
        for (int x = 1; x < 32; x <<= 1) s += __shfl_xor(s, x);
        if (r32o == 0) ssw[(long)orow * 8] = s; }
#undef SLOAD3
#undef SWRITE3
}
}

DI int rope128perm(int vv) { const int wc = vv >> 5, fq = (vv >> 3) & 3, n = (vv >> 2) & 1, j = vv & 3; const int p = (wc * 4 + fq) * 4 + j; return (p >> 5) * 64 + n * 32 + (p & 31); }
DI int rope32perm(int vv) { const int fq = vv >> 3, n = (vv >> 2) & 1, j = vv & 3; return n * 16 + fq * 4 + j; }
DI int src_col(int mode, int v) {
    if (mode == 0) return v;
    if (mode == 1) {
        if (v < 1024) return (v & ~127) + rope128perm(v & 127);
        if (v < 3584) return v;
        if (v < 3840) { const int vv = v - 3584; return vv < 64 ? 3584 + (vv & ~31) + rope32perm(vv & 31) : -1; }
        if (v < 4864) { const int vv = v - 3840; return 3648 + (vv & ~127) + rope128perm(vv & 127); }
        return v - 192;
    }
    const int g = v >> 5, gi = g % 6; return gi < 4 ? v : (v & ~31) + rope32perm(v & 31);
}
DI void conv_weight(const float* __restrict__ W, int ldw, bf16_t* __restrict__ Bt, int K, int N, int mode, const float* __restrict__ kscale, int rot, unsigned* lds32) {
    int tid = threadIdx.x; asm volatile("" : "+v"(tid));
    const int G = gridDim.x, nkt = K / 128, ntiles = (N / 128) * nkt;
    for (int t = (int)((blockIdx.x + G - (rot % G)) % G); t < ntiles; t += G) {
        const int n0 = (t / nkt) * 128, k0 = (t % nkt) * 128;
        { const int nn = tid & 127, kq = tid >> 7; const int scol = src_col(mode, n0 + nn);
#pragma unroll 4
          for (int i = 0; i < 16; ++i) { const int kp = kq + 4 * i, k = k0 + 2 * kp; float a = 0.f, b = 0.f;
              if (scol >= 0) { a = W[(size_t)k * ldw + scol]; b = W[(size_t)(k + 1) * ldw + scol]; }
              if (kscale) { a *= kscale[k]; b *= kscale[k + 1]; }
              lds32[nn * 68 + kp] = cvt_pk_bf16(a, b); } }
        __syncthreads();
        { const int n = tid >> 2, seg = tid & 3;
#pragma unroll
          for (int q = 0; q < 4; ++q) { const u32x4 w = *(const u32x4*)(lds32 + n * 68 + seg * 16 + q * 4); *(u32x4*)(Bt + (size_t)(n0 + n) * K + k0 + seg * 32 + q * 8) = w; } }
        __syncthreads();
    }
}

template <int MODE>
DI void rows_norm(const Params& p, const float* mod) {
    int tid = threadIdx.x; asm volatile("" : "+v"(tid));
    const int lane = tid & 63, gw = blockIdx.x * 8 + (tid >> 6), nw = gridDim.x * 8;
    const int nrows = MODE == 0 ? MROWS : SROWS; const int per = (nrows + nw - 1) / nw;
    float sc[32], sh[32]; int cur = -1;
    if (MODE == 2) {
#pragma unroll
        for (int i = 0; i < 8; ++i) { const f32x4 w = *(const f32x4*)(p.final_norm + i * 256 + lane * 4); sc[i * 4] = w[0]; sc[i * 4 + 1] = w[1]; sc[i * 4 + 2] = w[2]; sc[i * 4 + 3] = w[3]; }
    }
    auto rowsrc = [&](int row, int& mr) -> const float* {
        if (MODE == 0) { const int b = row / TT, t = row % TT; if (t < LC) { mr = 8; return p.ctx + ((size_t)b * LC + t) * DM; } mr = b; return p.x + ((size_t)b * SEQ + t - LC) * DM; }
        mr = row / SEQ; return p.out + (size_t)row * DM; };
    const int rbeg = gw * per, rend = ((gw + 1) * per < nrows) ? (gw + 1) * per : nrows;
    f32x4 vn[8];
    if (rbeg < rend) { int mr0; const float* s0 = rowsrc(rbeg, mr0);
#pragma unroll
        for (int i = 0; i < 8; ++i) vn[i] = *(const f32x4*)(s0 + i * 256 + lane * 4); }
    for (int row = rbeg; row < rend; ++row) {
        int mr; (void)rowsrc(row, mr);
        if (MODE != 2 && mr != cur) { cur = mr; const int csh = MODE == 0 ? 0 : 3, csc = csh + 1;
#pragma unroll
            for (int i = 0; i < 8; ++i) { const int c = i * 256 + lane * 4;
                const f32x4 a = *(const f32x4*)(mod + mr * 12288 + csc * 2048 + c) + *(const f32x4*)(p.b_ada + csc * 2048 + c);
                const f32x4 s = *(const f32x4*)(mod + mr * 12288 + csh * 2048 + c) + *(const f32x4*)(p.b_ada + csh * 2048 + c);
#pragma unroll
                for (int j = 0; j < 4; ++j) { sc[i * 4 + j] = 1.f + a[j]; sh[i * 4 + j] = s[j]; } } }
        f32x4 v[8]; float ss = 0.f;
#pragma unroll
        for (int i = 0; i < 8; ++i) { v[i] = vn[i]; ss += v[i][0] * v[i][0] + v[i][1] * v[i][1] + v[i][2] * v[i][2] + v[i][3] * v[i][3]; }
        if (row + 1 < rend) { int mrn; const float* sn = rowsrc(row + 1, mrn);
#pragma unroll
            for (int i = 0; i < 8; ++i) vn[i] = *(const f32x4*)(sn + i * 256 + lane * 4); }
        ss = wave_sum(ss); float rstd = __builtin_amdgcn_rsqf(ss * (1.f / DM) + EPS);
#if MK_DEBUG
        if (MODE == 2) { const float* dbg = (const float*)(p.ws + WS_DBG); int first = -1; for (int k = 15; k >= 0; --k) if (dbg[k] > 0.08f) first = k; rstd *= 1.f + 0.1f * (float)(first + 1); }
#endif
        if (MODE == 2) {
#pragma unroll
            for (int i = 0; i < 8; ++i) { f32x4 o; o[0] = v[i][0] * rstd * sc[i * 4]; o[1] = v[i][1] * rstd * sc[i * 4 + 1]; o[2] = v[i][2] * rstd * sc[i * 4 + 2]; o[3] = v[i][3] * rstd * sc[i * 4 + 3];
                *(f32x4*)(p.out + (size_t)row * DM + i * 256 + lane * 4) = o; }
        } else {
            bf16_t* dst = (bf16_t*)(p.ws + (MODE == 0 ? WS_HBUF : WS_H2)) + (size_t)row * DM;
#pragma unroll
            for (int i = 0; i < 8; ++i) { u32x2 w; w.x = cvt_pk_bf16(v[i][0] * rstd * sc[i * 4] + sh[i * 4], v[i][1] * rstd * sc[i * 4 + 1] + sh[i * 4 + 1]);
                w.y = cvt_pk_bf16(v[i][2] * rstd * sc[i * 4 + 2] + sh[i * 4 + 2], v[i][3] * rstd * sc[i * 4 + 3] + sh[i * 4 + 3]);
                *(u32x2*)(dst + i * 256 + lane * 4) = w; }
        }
    }
}


#if MK_DEBUG
DI unsigned hsh(unsigned x) { x ^= x >> 16; x *= 0x7feb352dU; x ^= x >> 15; x *= 0x846ca68bU; x ^= x >> 16; return x; }
DI void dbg_report(float* dbg, int k, float err) { if ((threadIdx.x & 63) == 0) atomicMax((int*)dbg + k, __float_as_int(fabsf(err))); }
DI float bfr(float x) { return bf_lo(cvt_pk_bf16(x, 0.f)); }
DI float bfv(const bf16_t* p, size_t i) { return __uint_as_float(((unsigned)p[i]) << 16); }
DI int samp_s(int si) { const int q = (si >> 3) & 7; return si < 64 ? (q == 0 ? 0 : q == 1 ? 1 : q == 2 ? 63 : q == 3 ? 64 : q == 4 ? 255 : q == 5 ? 256 : q == 6 ? 1024 : 2047) : (int)(hsh(si * 77 + 5) & 2047); }
DI float relerr(float ref, float got, float floor_) { return fabsf(ref - got) / (fabsf(ref) + floor_); }
DI float wdot(const bf16_t* A, int K, const float* W, int ldw, int col, const float* ks) {
    const int lane = threadIdx.x & 63; float a = 0.f;
    for (int k = lane; k < K; k += 64) a += bfv(A, k) * bfr(W[(size_t)k * ldw + col] * (ks ? ks[k] : 1.f));
    return wave_sum(a);
}
DI void rope_ref(float t1, float t2, float pos, int f, float q4, bool on, float& o1, float& o2) {
    const float ang = pos * __builtin_amdgcn_exp2f(-(float)f * 13.287712379549449f / q4); const float c = on ? __cosf(ang) : 1.f, sn = on ? __sinf(ang) : 0.f;
    o1 = t1 * c - t2 * sn; o2 = t2 * c + t1 * sn;
}
__global__ __launch_bounds__(512) void dbg_kernel(Params p, int ph) {
    const int bid = blockIdx.x;
    unsigned char* ws = p.ws; float* dbg = (float*)(ws + WS_DBG); const float* mod = (const float*)(ws + WS_MOD);
    float* sav = (float*)(ws + 655360);
    const int lane = threadIdx.x & 63, wid = threadIdx.x >> 6;
    for (int rnd = 0; rnd < 9; ++rnd) {
    const int si = rnd * 2048 + bid * 8 + wid;
    const unsigned hh = hsh(si * 2654435761u + ph * 97u);
    const bool okS = si < SROWS;
    const int b = (si >> 11) & 7, s = si & 2047;
    const int bT = si / TT, t = si % TT;
    if (ph == 1 && rnd == 0) {
        for (int q = 0; q < 54; ++q) { const int e = (si * 54 + q); if (e < 9 * 12288) { const int r = e / 12288, n = e % 12288; float a = 0.f;
            for (int k = lane; k < 2048; k += 64) { const float xv = r < 8 ? p.c[r * 2048 + k] : p.c_ctx[k]; a += xv / (1.f + expf(-xv)) * p.w_ada[(size_t)k * 12288 + n]; }
            a = wave_sum(a); dbg_report(dbg, 0, relerr(a, mod[r * 12288 + n], 0.05f)); } }
    }
    if (ph == 2 || (ph == 9 && okS)) {
        const bool isH = ph == 2;
        const float* src; int mr; size_t drow; const bf16_t* dst;
        if (isH) { if (t < LC) { src = p.ctx + ((size_t)bT * LC + t) * DM; mr = 8; } else { src = p.x + ((size_t)bT * SEQ + t - LC) * DM; mr = bT; } drow = (size_t)si; dst = (const bf16_t*)(ws + WS_HBUF); }
        else { src = p.out + (size_t)si * DM; mr = b; drow = (size_t)si; dst = (const bf16_t*)(ws + WS_H2); }
        float ss = 0.f; for (int k = lane; k < DM; k += 64) ss += src[k] * src[k]; ss = wave_sum(ss); const float rstd = 1.f / sqrtf(ss / DM + EPS);
        const int csh = isH ? 0 : 3, csc = csh + 1; float e = 0.f;
        for (int k = lane; k < DM; k += 64) { const float ref = src[k] * rstd * (1.f + mod[mr * 12288 + csc * 2048 + k] + p.b_ada[csc * 2048 + k]) + mod[mr * 12288 + csh * 2048 + k] + p.b_ada[csh * 2048 + k];
            e = fmaxf(e, relerr(ref, bfv(dst, drow * DM + k), 1.f)); }
        for (int o = 32; o > 0; o >>= 1) e = fmaxf(e, __shfl_xor(e, o));
        dbg_report(dbg, isH ? 1 : 8, e);
    }
    if (ph == 3) {
      for (int rep = 0; rep < 2; ++rep) {
        const unsigned hr = hsh(hh + rep * 1234567u);
        const bool latent = t >= LC; const int seg = latent ? (int)((hr >> 8) % 9u) : (int)((hr >> 8) % 4u);
        const size_t trow = (size_t)si, srow = (size_t)bT * SEQ + (t - LC); const int sp = t - LC;
        const bf16_t* hrow = (const bf16_t*)(ws + WS_HBUF) + trow * DM; const unsigned h2 = hsh(hr);
        float e = 0.f;
        if (seg == 0 || seg == 4) { const int head = h2 & 7, half = (h2 >> 3) & 1, f = (h2 >> 4) & 31, base = (seg == 0 ? 0 : 3648) + head * 128 + half * 64 + f;
            const float t1 = wdot(hrow, DM, p.w_in, INCOLS, base, nullptr), t2 = wdot(hrow, DM, p.w_in, INCOLS, base + 32, nullptr); float o1, o2;
            rope_ref(t1, t2, (float)(half ? (sp & 63) : (sp >> 6)), f, 32.f, latent, o1, o2); const float sc = seg == 0 ? 0.08838834764831845f : 1.f;
            const bf16_t* dst = seg == 0 ? (const bf16_t*)(ws + WS_RK) + trow * 1024 : (const bf16_t*)(ws + WS_RQ) + srow * 1024; const int dc = head * 128 + half * 64 + f;
            e = fmaxf(relerr(o1 * sc, bfv(dst, dc), 0.05f * sc), relerr(o2 * sc, bfv(dst, dc + 32), 0.05f * sc)); }
        else if (seg == 3) { const int g = h2 & 1, f = (h2 >> 1) & 15, base = 3584 + g * 32 + f;
            const float t1 = wdot(hrow, DM, p.w_in, INCOLS, base, nullptr), t2 = wdot(hrow, DM, p.w_in, INCOLS, base + 16, nullptr); float o1, o2;
            rope_ref(t1, t2, (float)(g ? (sp & 63) : (sp >> 6)), f, 16.f, latent, o1, o2); const bf16_t* dst = (const bf16_t*)(ws + WS_KR) + trow * 64 + g * 32 + f;
            e = fmaxf(relerr(o1, bfv(dst, 0), 0.05f), relerr(o2, bfv(dst, 16), 0.05f)); }
        else { int oc, dc; const bf16_t* dst; size_t ld; size_t row; int act = 0;
            if (seg == 1) { dc = h2 % 2048u; oc = 1024 + dc; dst = (const bf16_t*)(ws + WS_RV); ld = 2048; row = trow; }
            else if (seg == 2) { dc = h2 % 512u; oc = 3072 + dc; dst = (const bf16_t*)(ws + WS_KVD); ld = 512; row = trow; }
            else if (seg == 5) { dc = h2 % 2048u; oc = 4672 + dc; dst = (const bf16_t*)(ws + WS_RG); ld = 2048; row = srow; act = 1; }
            else if (seg == 6) { dc = h2 % 512u; oc = 6720 + dc; dst = (const bf16_t*)(ws + WS_QD); ld = 512; row = srow; }
            else if (seg == 7) { dc = h2 % 2048u; oc = 7232 + dc; dst = (const bf16_t*)p.out; ld = 2048; row = srow; act = 2; }
            else { dc = h2 % 2048u; oc = 9280 + dc; dst = (const bf16_t*)p.out + (size_t)SROWS * 2048; ld = 2048; row = srow; act = 2; }
            float z = wdot(hrow, DM, p.w_in, INCOLS, oc, nullptr); if (act == 1) z = z / (1.f + expf(-z)); if (act == 2) z = 1.f / (1.f + expf(-z));
            e = relerr(z, bfv(dst, row * ld + dc), 0.05f); }
        dbg_report(dbg, 16 + seg + (latent ? 0 : 9), e);
        if (seg == 7 && latent && e > 0.08f && lane == 0) { atomicAdd((int*)dbg + 40, 1); atomicMax((int*)dbg + 41, 1000 - (int)(srow >> 8)); atomicMax((int*)dbg + 42, (int)(srow >> 8)); }
      }
    }
    if (ph == 4 && okS) {
        const int h = (hh >> 4) & 7, ecol = (hh >> 8) & 255; const size_t srow = (size_t)si;
        const bf16_t* q = (const bf16_t*)(ws + WS_RQ) + srow * 1024 + h * 128; const bf16_t* K = (const bf16_t*)(ws + WS_RK) + (size_t)b * TT * 1024 + h * 128; const bf16_t* V = (const bf16_t*)(ws + WS_RV) + (size_t)b * TT * 2048 + h * 256 + ecol;
        const float xf = p.dec_f[h], xb = p.dec_b[h]; const float lf = fminf(xf, 0.f) - log1pf(expf(-fabsf(xf))), lb = fminf(xb, 0.f) - log1pf(expf(-fabsf(xb)));
        float acc = 0.f, nrm = 0.f;
        for (int tt = lane; tt < TT; tt += 64) { float d = 0.f; for (int k = 0; k < 128; ++k) d += bfv(q, k) * bfv(K, (size_t)tt * 1024 + k);
            float w; if (tt < LC) w = expf(lf * (float)(s + LC - tt)) + expf(lb * (float)(SEQ + tt - s)); else { const int j = tt - LC; w = j < s ? expf(lf * (float)(s - j)) : j > s ? expf(lb * (float)(j - s)) : 2.f; }
            const float term = w * d * bfv(V, (size_t)tt * 2048); acc += term; nrm += term * term; }
        acc = wave_sum(acc); nrm = wave_sum(nrm);
        dbg_report(dbg, 3, fabsf(acc - bfv((const bf16_t*)(ws + WS_ORET), srow * 2048 + h * 256 + ecol)) / (fabsf(acc) + 0.25f * sqrtf(nrm) + 1e-6f));
        const bf16_t* o = (const bf16_t*)(ws + WS_ORET) + srow * 2048 + h * 256;
        float ss = 0.f; for (int k = lane; k < 256; k += 64) ss += bfv(o, k) * bfv(o, k); ss = wave_sum(ss);
        const float ref = bfv(o, ecol) / sqrtf(ss / 256.f + EPS) * p.ret_gn[h * 256 + ecol] * bfv((const bf16_t*)(ws + WS_RG), srow * 2048 + h * 256 + ecol);
        if (lane == 0) sav[si] = ref;
    }
    if (ph == 5) {
        if (okS) { const size_t srow = (size_t)si; const bf16_t* qd = (const bf16_t*)(ws + WS_QD) + srow * 512; float ss = 0.f; for (int k = lane; k < 512; k += 64) ss += bfv(qd, k) * bfv(qd, k); ss = wave_sum(ss); const float rstd = 1.f / sqrtf(ss / 512.f + EPS);
            const int head = (hh >> 4) & 15; const bf16_t* dst = (const bf16_t*)(ws + WS_QM) + srow * 3072 + head * 192; float e;
            if (hh & 1) { const int d = (hh >> 8) & 127; e = relerr(rstd * wdot(qd, 512, p.w_q_up, 3072, head * 192 + d, p.q_norm), bfv(dst, d), 0.05f); }
            else { const int g = (hh >> 8) & 1, f = (hh >> 9) & 15, base = head * 192 + 128 + g * 32 + f; float o1, o2;
                rope_ref(rstd * wdot(qd, 512, p.w_q_up, 3072, base, p.q_norm), rstd * wdot(qd, 512, p.w_q_up, 3072, base + 16, p.q_norm), (float)(g ? (s & 63) : (s >> 6)), f, 16.f, true, o1, o2);
                e = fmaxf(relerr(o1, bfv(dst, 128 + g * 32 + f), 0.05f), relerr(o2, bfv(dst, 128 + g * 32 + 16 + f), 0.05f)); }
            dbg_report(dbg, 4, e);
            const unsigned h4 = hsh(si * 2654435761u + 4 * 97u); const int hq = (h4 >> 4) & 7, eq = (h4 >> 8) & 255;
            dbg_report(dbg, 10, relerr(sav[si], bfv((const bf16_t*)(ws + WS_ORET), srow * 2048 + hq * 256 + eq), 0.03f)); }
        { const size_t trow = (size_t)si; const bf16_t* kd = (const bf16_t*)(ws + WS_KVD) + trow * 512; float ss = 0.f; for (int k = lane; k < 512; k += 64) ss += bfv(kd, k) * bfv(kd, k); ss = wave_sum(ss); const float rstd = 1.f / sqrtf(ss / 512.f + EPS);
            const int c = (hh >> 14) & 4095; dbg_report(dbg, 4, relerr(rstd * wdot(kd, 512, p.w_kv_up, 4096, c, p.kv_norm), bfv((const bf16_t*)(ws + WS_KVUP), trow * 4096 + c), 0.05f)); }
    }
    if (ph == 6 && okS) {
        const int h = (hh >> 4) & 15, ecol = (hh >> 8) & 127; const size_t srow = (size_t)si;
        const bf16_t* q = (const bf16_t*)(ws + WS_QM) + srow * 3072 + h * 192; const bf16_t* KV = (const bf16_t*)(ws + WS_KVUP) + (size_t)b * TT * 4096 + h * 256; const bf16_t* KR = (const bf16_t*)(ws + WS_KR) + (size_t)b * TT * 64;
        float mx = -1e30f;
        for (int i = 0; i < 36; ++i) { const int tt = lane + 64 * i; float d = 0.f; for (int k = 0; k < 128; ++k) d += bfv(q, k) * bfv(KV, (size_t)tt * 4096 + k); for (int k = 0; k < 64; ++k) d += bfv(q, 128 + k) * bfv(KR, (size_t)tt * 64 + k);
            mx = fmaxf(mx, d * 0.07216878364870322f); }
        for (int o = 32; o > 0; o >>= 1) mx = fmaxf(mx, __shfl_xor(mx, o));
        float l = 0.f, acc = 0.f;
        for (int i = 0; i < 36; ++i) { const int tt = lane + 64 * i; float d = 0.f; for (int k = 0; k < 128; ++k) d += bfv(q, k) * bfv(KV, (size_t)tt * 4096 + k); for (int k = 0; k < 64; ++k) d += bfv(q, 128 + k) * bfv(KR, (size_t)tt * 64 + k);
            const float pe = expf(d * 0.07216878364870322f - mx); l += pe; acc += pe * bfv(KV, (size_t)tt * 4096 + 128 + ecol); }
        l = wave_sum(l); acc = wave_sum(acc);
        dbg_report(dbg, 5, relerr(acc / l, bfv((const bf16_t*)(ws + WS_MLAO), srow * 2048 + h * 128 + ecol), 0.02f));
    }
    if (ph == 7 && okS) {
        const size_t srow = (size_t)si; const int c = (hh >> 4) & 2047;
        const float r1 = wdot((const bf16_t*)(ws + WS_ORET) + srow * 2048, 2048, p.w_ret_o, 2048, c, nullptr), r2 = wdot((const bf16_t*)(ws + WS_MLAO) + srow * 2048, 2048, p.w_mla_o, 2048, c, nullptr);
        const float ref = bfv((const bf16_t*)p.out, srow * 2048 + c) * r1 + bfv((const bf16_t*)p.out + (size_t)SROWS * 2048, srow * 2048 + c) * r2;
        dbg_report(dbg, 6, relerr(ref, bfv((const bf16_t*)(ws + WS_MIXED), srow * 2048 + c), 0.03f));
    }
    if (ph == 8 && okS) {
        const size_t srow = (size_t)si; const int c = (hh >> 4) & 2047;
        const float r = wdot((const bf16_t*)(ws + WS_MIXED) + srow * 2048, 2048, p.w_out, 2048, c, nullptr);
        const float refd = (mod[b * 12288 + 2 * 2048 + c] + p.b_ada[2 * 2048 + c]) * r;
        dbg_report(dbg, 7, relerr(refd, p.out[srow * 2048 + c] - p.x[srow * 2048 + c], 0.01f));
    }
    if (ph == 10 && okS) {
        const size_t srow = (size_t)si; const int c = (int)((hh >> 4) % 11264u);
        const float r = wdot((const bf16_t*)(ws + WS_H2) + srow * 2048, 2048, p.w_up, 2 * FFN, c, nullptr);
        const float got = c < FFN ? bfv((const bf16_t*)(ws + WS_ABUF), srow * FFN + c) : bfv((const bf16_t*)(ws + WS_VBUF), srow * FFN + c - FFN);
        dbg_report(dbg, 9, relerr(r, got, 0.05f));
        const int cu = (int)((hh >> 8) % 5632u); const bf16_t* ab = (const bf16_t*)(ws + WS_ABUF);
        const float am = s > 0 ? bfv(ab, (srow - 1) * FFN + cu) : 0.f, a0 = bfv(ab, srow * FFN + cu), ap = s < SEQ - 1 ? bfv(ab, (srow + 1) * FFN + cu) : 0.f;
        const float z = p.conv_b[cu] + p.conv_w[cu] * am + p.conv_w[FFN + cu] * a0 + p.conv_w[2 * FFN + cu] * ap;
        if (lane == 0) sav[16384 + si] = z / (1.f + expf(-z)) * bfv((const bf16_t*)(ws + WS_VBUF), srow * FFN + cu);
    }
    if (ph == 11 && okS) {
        const size_t srow = (size_t)si; const unsigned h10 = hsh(si * 2654435761u + 10 * 97u); const int c10 = (int)((h10 >> 8) % 5632u);
        dbg_report(dbg, 11, relerr(sav[16384 + si], bfv((const bf16_t*)(ws + WS_VBUF), srow * FFN + c10), 0.03f));
        const int c = (hh >> 4) & 2047; const float r = wdot((const bf16_t*)(ws + WS_VBUF) + srow * FFN, FFN, p.w_down, 2048, c, nullptr);
        if (lane == 0) { sav[2 * 16384 + si] = (mod[b * 12288 + 5 * 2048 + c] + p.b_ada[5 * 2048 + c]) * r; sav[3 * 16384 + si] = p.out[srow * 2048 + c]; }
    }
    if (ph == 12 && okS) {
        const size_t srow = (size_t)si; const unsigned h11 = hsh(si * 2654435761u + 11 * 97u); const int c11 = (h11 >> 4) & 2047;
        dbg_report(dbg, 12, relerr(sav[2 * 16384 + si], p.out[srow * 2048 + c11] - sav[3 * 16384 + si], 0.02f));
        const float* xr = p.out + srow * 2048; float ss = 0.f; for (int k = lane; k < DM; k += 64) ss += xr[k] * xr[k]; ss = wave_sum(ss);
        (void)ss;
        dbg_report(dbg, 14, 1.0f);
    }
    }
}
#endif

__global__ __launch_bounds__(512, 2) void fwd_megakernel(Params p) {
    extern __shared__ __attribute__((aligned(16))) unsigned char shm[];
    LAS unsigned char* lds = (LAS unsigned char*)shm;
    unsigned char* ws = p.ws;
    const int G = gridDim.x;
    float* mod = (float*)(ws + WS_MOD); float* ssq_kv = (float*)(ws + WS_SSQKV); float* ssq_q = (float*)(ws + WS_SSQQ); float* ssq_ret = (float*)(ws + WS_SSQRET);
    volatile LAS unsigned* xst = (volatile LAS unsigned*)(lds + pg8::STAGE_BYTES);
    if (threadIdx.x < 2) xst[threadIdx.x] = 0u;
    __syncthreads();
    const XcdBarrier xb = xcd_barrier_post((unsigned*)(ws + WS_BAR), xst);
    for (int ph = p.ph_lo; ph < p.ph_hi; ++ph) {
        if (ph > p.ph_lo) { if (ph > 1000) cg::this_grid().sync(); else xcd_barrier(xb); }
        for (int rep = 0; rep < (ph == MK_REP ? 2 : 1); ++rep) {
        int bid = blockIdx.x; asm volatile("" : "+s"(bid));
#define LOCAL_TID int tid = threadIdx.x; asm volatile("" : "+v"(tid))
        switch (ph) {
        case 0: if (PH_ON(0)) {
            unsigned* l32 = (unsigned*)shm; int rot = 0;
            conv_weight(p.w_in, INCOLS, (bf16_t*)(ws + WS_WIN), 2048, NIN, 1, nullptr, rot, l32); rot += (NIN / 128) * 16;
            conv_weight(p.w_q_up, 3072, (bf16_t*)(ws + WS_WQUP), 512, 3072, 2, p.q_norm, rot, l32); rot += 24 * 4;
            conv_weight(p.w_kv_up, 4096, (bf16_t*)(ws + WS_WKVUP), 512, 4096, 0, p.kv_norm, rot, l32); rot += 32 * 4;
            conv_weight(p.w_ret_o, 2048, (bf16_t*)(ws + WS_WRETO), 2048, 2048, 0, nullptr, rot, l32); rot += 256;
            conv_weight(p.w_mla_o, 2048, (bf16_t*)(ws + WS_WMLAO), 2048, 2048, 0, nullptr, rot, l32); rot += 256;
            conv_weight(p.w_out, 2048, (bf16_t*)(ws + WS_WOUT), 2048, 2048, 0, nullptr, rot, l32);
            float* sl = (float*)shm;
            LOCAL_TID;
            for (int it = bid; it < 768; it += G) {
                const int k0 = (it / 24) * 64, n = (it % 24) * 512 + tid;
                __syncthreads();
                for (int e = tid; e < 576; e += 512) { const int r = e >> 6, kk = e & 63; const float xv = r < 8 ? p.c[r * 2048 + k0 + kk] : p.c_ctx[k0 + kk]; sl[e] = siluf_(xv); }
                __syncthreads();
                float a[9];
#pragma unroll
                for (int r = 0; r < 9; ++r) a[r] = 0.f;
#pragma unroll 8
                for (int kk = 0; kk < 64; ++kk) { const float w = p.w_ada[(size_t)(k0 + kk) * 12288 + n];
#pragma unroll
                    for (int r = 0; r < 9; ++r) a[r] += sl[r * 64 + kk] * w; }
#pragma unroll
                for (int r = 0; r < 9; ++r) atomicAdd(mod + r * 12288 + n, a[r]);
            }
        } break;
        case 1: if (PH_ON(1)) rows_norm<0>(p, mod); break;
        case 2: if (PH_ON(2)) {
            pg8::Gemm g{(const bf16_t*)(ws + WS_HBUF), (const bf16_t*)(ws + WS_WIN), 2048};
            pg8::Sched<2> S{0, 0, G, bid};
            EpiInProj E{(bf16_t*)(ws + WS_RK), (bf16_t*)(ws + WS_RV), (bf16_t*)(ws + WS_KVD), (bf16_t*)(ws + WS_KR), (bf16_t*)(ws + WS_RQ), (bf16_t*)(ws + WS_RG), (bf16_t*)(ws + WS_QD),
                        (bf16_t*)p.out, (bf16_t*)p.out + (size_t)SROWS * 2048, ssq_kv, ssq_q, (bf16_t*)(ws + WS_ORET)};
            pg8::gemm_phase(lds, g, S, E);
        } break;
        case 3: if (PH_ON(3)) {
            const bf16_t* rq = (const bf16_t*)(ws + WS_RQ); const bf16_t* rk = (const bf16_t*)(ws + WS_RK); const bf16_t* rv = (const bf16_t*)(ws + WS_RV); bf16_t* oret = (bf16_t*)(ws + WS_ORET);
            for (int it = bid; it < 512; it += G) {
                const int qb = it & 7, h = (it >> 3) & 7, b = it >> 6;
                const float xf = p.dec_f[h], xb = p.dec_b[h];
                const float lf2 = (fminf(xf, 0.f) - log1pf(__expf(-fabsf(xf)))) * 1.4426950408889634f, lb2 = (fminf(xb, 0.f) - log1pf(__expf(-fabsf(xb)))) * 1.4426950408889634f;
                const size_t srow0 = (size_t)b * SEQ + qb * 256, trow0 = (size_t)b * TT;
                att::ret_body3(rq + srow0 * 1024 + h * 128, rk + trow0 * 1024 + h * 128, rv + trow0 * 2048 + h * 256, oret + srow0 * 2048 + h * 256,
                               ssq_ret + srow0 * 8 + h, qb * 256, lf2, lb2, (char*)shm);
            }
        } break;
        case 4: if (PH_ON(4)) {
            { LOCAL_TID; bf16_t* oret = (bf16_t*)(ws + WS_ORET); const bf16_t* rg = (const bf16_t*)(ws + WS_RG);
              for (size_t i = (size_t)bid * 512 + tid; i < (size_t)SROWS * 256; i += (size_t)G * 512) {
                  const size_t r = i >> 8; const int col = (int)(i & 255) * 8, h = col >> 8;
                  const float rs = __builtin_amdgcn_rsqf(ssq_ret[r * 8 + h] * (1.f / 256.f) + EPS);
                  const u32x4 o = *(const u32x4*)(oret + r * 2048 + col), g = *(const u32x4*)(rg + r * 2048 + col);
                  const f32x4 n0 = *(const f32x4*)(p.ret_gn + col), n1 = *(const f32x4*)(p.ret_gn + col + 4);
                  u32x4 w; w.x = cvt_pk_bf16(bf_lo(o.x) * rs * n0[0] * bf_lo(g.x), bf_hi(o.x) * rs * n0[1] * bf_hi(g.x)); w.y = cvt_pk_bf16(bf_lo(o.y) * rs * n0[2] * bf_lo(g.y), bf_hi(o.y) * rs * n0[3] * bf_hi(g.y));
                  w.z = cvt_pk_bf16(bf_lo(o.z) * rs * n1[0] * bf_lo(g.z), bf_hi(o.z) * rs * n1[1] * bf_hi(g.z)); w.w = cvt_pk_bf16(bf_lo(o.w) * rs * n1[2] * bf_lo(g.w), bf_hi(o.w) * rs * n1[3] * bf_hi(g.w));
                  *(u32x4*)(oret + r * 2048 + col) = w; } }
            __syncthreads();
            { pg8::Gemm g{(const bf16_t*)(ws + WS_QD), (const bf16_t*)(ws + WS_WQUP), 512}; pg8::Sched<0> S{64, 12, G, bid}; EpiQup E{(bf16_t*)(ws + WS_QM), ssq_q}; pg8::gemm_phase(lds, g, S, E); }
            __syncthreads();
            { pg8::Gemm g{(const bf16_t*)(ws + WS_KVD), (const bf16_t*)(ws + WS_WKVUP), 512}; pg8::Sched<0> S{72, 16, G, (bid + 128) % G}; EpiKvup E{(bf16_t*)(ws + WS_KVUP), ssq_kv}; pg8::gemm_phase(lds, g, S, E); }
        } break;
        case 5: if (PH_ON(5)) {
            conv_weight(p.w_up, 2 * FFN, (bf16_t*)(ws + WS_WUP), 2048, 2 * FFN, 0, nullptr, 0, (unsigned*)shm);
            const bf16_t* qm = (const bf16_t*)(ws + WS_QM); const bf16_t* kvup = (const bf16_t*)(ws + WS_KVUP); const bf16_t* kr = (const bf16_t*)(ws + WS_KR); bf16_t* mo = (bf16_t*)(ws + WS_MLAO);
            for (int it = bid; it < 1024; it += G) {
                const int qb = it & 7, h = (it >> 3) & 15, b = it >> 7;
                const size_t srow0 = (size_t)b * SEQ + qb * 256, trow0 = (size_t)b * TT;
                att::mla_body(qm + srow0 * 3072 + h * 192, kvup + trow0 * 4096 + h * 256, kvup + trow0 * 4096 + h * 256 + 128, kr + trow0 * 64, mo + srow0 * 2048 + h * 128, (char*)shm);
            }
        } break;
        case 6: if (PH_ON(6)) {
            const bf16_t* gr = (const bf16_t*)p.out; const bf16_t* gm = gr + (size_t)SROWS * 2048;
            pg8::Gemm g{(const bf16_t*)(ws + WS_ORET), (const bf16_t*)(ws + WS_WRETO), 2048, (const bf16_t*)(ws + WS_MLAO), (const bf16_t*)(ws + WS_WMLAO)}; pg8::Sched<0> S{64, 8, G, bid}; EpiDual E{gr, gm, (bf16_t*)(ws + WS_MIXED)}; pg8::gemm_phase(lds, g, S, E);
        } break;
        case 7: if (PH_ON(7)) {
            pg8::Gemm g{(const bf16_t*)(ws + WS_MIXED), (const bf16_t*)(ws + WS_WOUT), 2048}; pg8::Sched<0> S{64, 8, G, bid}; EpiResid E{p.x, p.out, mod, p.b_ada, 2, 1.f}; pg8::gemm_phase(lds, g, S, E);
        } break;
        case 8: if (PH_ON(8)) rows_norm<1>(p, mod); break;
        case 9: if (PH_ON(9)) {
            pg8::Gemm g{(const bf16_t*)(ws + WS_H2), (const bf16_t*)(ws + WS_WUP), 2048}; pg8::Sched<0> S{64, 44, G, bid}; EpiUp E{(bf16_t*)(ws + WS_ABUF), (bf16_t*)(ws + WS_VBUF)}; pg8::gemm_phase(lds, g, S, E);
        } break;
        case 10: if (PH_ON(10)) {
            conv_weight(p.w_down, 2048, (bf16_t*)(ws + WS_WDOWN), FFN, 2048, 0, nullptr, 0, (unsigned*)shm);
            const bf16_t* ab = (const bf16_t*)(ws + WS_ABUF); bf16_t* vb = (bf16_t*)(ws + WS_VBUF);
            constexpr int CV = FFN / 8, RCH = 16;
            LOCAL_TID;
            for (int i = bid * 512 + tid; i < (SROWS / RCH) * CV; i += G * 512) {
                const int cv = i % CV, r0 = (i / CV) * RCH, col = cv * 8;
                float w0[8], w1[8], w2[8], bb[8];
#pragma unroll
                for (int j = 0; j < 8; ++j) { w0[j] = p.conv_w[col + j]; w1[j] = p.conv_w[FFN + col + j]; w2[j] = p.conv_w[2 * FFN + col + j]; bb[j] = p.conv_b[col + j]; }
                u32x4 prev = (r0 & (SEQ - 1)) ? *(const u32x4*)(ab + (size_t)(r0 - 1) * FFN + col) : (u32x4){0, 0, 0, 0};
                u32x4 curv = *(const u32x4*)(ab + (size_t)r0 * FFN + col);
#pragma unroll 4
                for (int rr = 0; rr < RCH; ++rr) { const int r = r0 + rr;
                    const u32x4 nxt = ((r & (SEQ - 1)) != SEQ - 1) ? *(const u32x4*)(ab + (size_t)(r + 1) * FFN + col) : (u32x4){0, 0, 0, 0};
                    const u32x4 vv = *(const u32x4*)(vb + (size_t)r * FFN + col);
                    float o[8];
#pragma unroll
                    for (int q = 0; q < 4; ++q) { const unsigned pw = prev[q], cw = curv[q], nw = nxt[q], vw = vv[q];
                        const float a0 = bb[2 * q] + w0[2 * q] * bf_lo(pw) + w1[2 * q] * bf_lo(cw) + w2[2 * q] * bf_lo(nw);
                        const float a1 = bb[2 * q + 1] + w0[2 * q + 1] * bf_hi(pw) + w1[2 * q + 1] * bf_hi(cw) + w2[2 * q + 1] * bf_hi(nw);
                        o[2 * q] = siluf_(a0) * bf_lo(vw); o[2 * q + 1] = siluf_(a1) * bf_hi(vw); }
                    u32x4 w; w.x = cvt_pk_bf16(o[0], o[1]); w.y = cvt_pk_bf16(o[2], o[3]); w.z = cvt_pk_bf16(o[4], o[5]); w.w = cvt_pk_bf16(o[6], o[7]);
                    *(u32x4*)(vb + (size_t)r * FFN + col) = w; prev = curv; curv = nxt; }
            }
        } break;
        case 11: if (PH_ON(11)) {
            pg8::Gemm g{(const bf16_t*)(ws + WS_VBUF), (const bf16_t*)(ws + WS_WDOWN), FFN}; pg8::Sched<0> S{64, 8, G, bid}; EpiResid E{p.out, p.out, mod, p.b_ada, 5, 1.f}; pg8::gemm_phase(lds, g, S, E);
        } break;
        case 12: if (PH_ON(12)) rows_norm<2>(p, mod); break;
        default: break;
        }
        }
    }
}

constexpr int LDS_BYTES = pg8::STAGE_BYTES + 16;
extern "C" void kernel_launch(void* const* d_in, const int* in_sizes, int n_in, void* d_out, int out_size, void* d_ws, size_t ws_size, hipStream_t stream) {
    static int grid = 0;
    if (grid == 0) {
        if (n_in != 22 || out_size != SROWS * DM || ws_size < WS_END) { fprintf(stderr, "kernel_launch: unexpected shapes (n_in %d out %d ws %zu need %zu)\n", n_in, out_size, ws_size, (size_t)WS_END); grid = -1; return; }
        int dev = 0, cus = 0, per_cu = 0;
        hipGetDevice(&dev); hipDeviceGetAttribute(&cus, hipDeviceAttributeMultiprocessorCount, dev);
        if (hipFuncSetAttribute((const void*)fwd_megakernel, hipFuncAttributeMaxDynamicSharedMemorySize, LDS_BYTES) != hipSuccess) { fprintf(stderr, "kernel_launch: hipFuncSetAttribute failed\n"); grid = -1; return; }
        hipOccupancyMaxActiveBlocksPerMultiprocessor(&per_cu, (const void*)fwd_megakernel, 512, LDS_BYTES);
        (void)hipGetLastError();
        if (per_cu < 1) per_cu = 1;
        grid = cus * per_cu; if (grid > 256) grid = 256; grid &= ~7; if (grid < 8) grid = 8;
    }
    if (grid < 0) return;
    hipMemsetAsync(d_ws, 0, WS_ZERO_BYTES, stream);
    Params p{};
    const float** pp = (const float**)&p;
    for (int i = 0; i < 22; ++i) pp[i] = (const float*)d_in[i];
    p.out = (float*)d_out; p.ws = (unsigned char*)d_ws;
#if MK_MULTI
    for (int ph = 0; ph < NPHASE; ++ph) {
#if MK_DEBUG
        hipLaunchKernelGGL(dbg_kernel, dim3(256), dim3(512), 0, stream, p, ph);
#endif
        p.ph_lo = ph; p.ph_hi = ph + 1; hipLaunchKernelGGL(fwd_megakernel, dim3(grid), dim3(512), LDS_BYTES, stream, p); }
#if MK_DEBUG
    hipLaunchKernelGGL(dbg_kernel, dim3(256), dim3(512), 0, stream, p, 13);
#endif
#else
    p.ph_lo = 0; p.ph_hi = NPHASE;
    void* args[] = {&p};
    hipError_t e = hipLaunchCooperativeKernel((const void*)fwd_megakernel, dim3(grid), dim3(512), args, LDS_BYTES, stream);
    if (e != hipSuccess) fprintf(stderr, "cooperative launch failed: %s (grid %d)\n", hipGetErrorString(e), grid);
#endif
}
```

```cpp
#include <hip/hip_runtime.h>
#include <hip/hip_cooperative_groups.h>
#include <cstdio>
#include <cstdint>
namespace cg = cooperative_groups;

#ifndef MK_ONLY
#define MK_ONLY -1
#endif
#define PH_ON(k) (MK_ONLY < 0 || MK_ONLY == (k))
#ifndef MK_DEBUG
#define MK_DEBUG 0
#endif
#ifndef MK_REP
#define MK_REP -1
#endif
#ifndef MK_MULTI
#define MK_MULTI 0
#endif

typedef unsigned short bf16_t;
typedef short bf16x8 __attribute__((ext_vector_type(8)));
typedef short s16x4 __attribute__((ext_vector_type(4)));
typedef float f32x2 __attribute__((ext_vector_type(2)));
typedef float f32x4 __attribute__((ext_vector_type(4)));
typedef float f32x16 __attribute__((ext_vector_type(16)));
typedef unsigned u32x2 __attribute__((ext_vector_type(2)));
typedef unsigned u32x4 __attribute__((ext_vector_type(4)));
#define LAS __attribute__((address_space(3)))
#define DI __device__ __forceinline__

constexpr int NB = 8, SEQ = 2048, DM = 2048, LC = 256, TT = LC + SEQ  , MROWS = NB * TT  , SROWS = NB * SEQ  ;
constexpr int FFN = 5632, INCOLS = 11328, NIN = 11520  ;
constexpr float EPS = 1e-6f;
constexpr int NPHASE = 13;

constexpr size_t MB = 1024 * 1024;
constexpr size_t WS_MOD = 0;
constexpr size_t WS_SSQKV = WS_MOD + 9 * 12288 * 4;
constexpr size_t WS_SSQQ = WS_SSQKV + MROWS * 4;
constexpr size_t WS_DBG = WS_SSQQ + SROWS * 4;
constexpr size_t WS_BAR = WS_DBG + 4096;
constexpr size_t WS_ZERO_BYTES = WS_BAR + 3456 * 4;
constexpr size_t WS_SSQRET = 1 * MB;
constexpr size_t WS_WQUP = 2 * MB;
constexpr size_t WS_WKVUP = WS_WQUP + 3072ull * 512 * 2;
constexpr size_t WS_WRETO = WS_WKVUP + 4096ull * 512 * 2;
constexpr size_t WS_WMLAO = WS_WRETO + 2048ull * 2048 * 2;
constexpr size_t WS_WOUT = WS_WMLAO + 2048ull * 2048 * 2;
constexpr size_t WS_ARENA = WS_WOUT + 2048ull * 2048 * 2;
constexpr size_t WS_WIN = WS_ARENA;
constexpr size_t WS_WUP = WS_ARENA;
constexpr size_t SLOTA = (size_t)NIN * 2048 * 2;
constexpr size_t WS_ORET = WS_ARENA + SLOTA;
constexpr size_t WS_H2 = WS_ORET;
constexpr size_t WS_WDOWN = WS_ORET;
constexpr size_t SLOTB = (size_t)SROWS * 2048 * 2;
constexpr size_t WS_C = WS_ORET + SLOTB;
constexpr size_t WS_RG = WS_C;
constexpr size_t WS_MLAO = WS_C;
constexpr size_t WS_KVD = WS_RG + (size_t)SROWS * 2048 * 2;
constexpr size_t WS_QD = WS_KVD + (size_t)MROWS * 512 * 2;
constexpr size_t WS_KR = WS_QD + (size_t)SROWS * 512 * 2;
constexpr size_t WS_C2 = WS_KR + (size_t)MROWS * 64 * 2;
constexpr size_t WS_HBUF = WS_C2;
constexpr size_t WS_RK = WS_HBUF + (size_t)MROWS * 2048 * 2;
constexpr size_t WS_RV = WS_RK + (size_t)MROWS * 1024 * 2;
constexpr size_t WS_RQ = WS_RV + (size_t)MROWS * 2048 * 2;
constexpr size_t WS_QM = WS_C2;
constexpr size_t WS_KVUP = WS_QM + (size_t)SROWS * 3072 * 2;
constexpr size_t WS_TMP1 = WS_C2;
constexpr size_t WS_MIXED = WS_TMP1 + (size_t)SROWS * 2048 * 4;
constexpr size_t WS_ABUF = WS_C;
constexpr size_t WS_ASIDE = WS_ABUF;
constexpr size_t WS_VSIDE = WS_ASIDE + (size_t)1024 * FFN * 2;
constexpr size_t WS_VBUF = WS_ABUF + (size_t)SROWS * FFN * 2;
constexpr size_t WS_END = WS_VBUF + (size_t)SROWS * FFN * 2;
static_assert(WS_KVUP + (size_t)MROWS * 4096 * 2 <= WS_END, "region C overflow");
static_assert(WS_RQ + (size_t)SROWS * 1024 * 2 <= WS_END, "region C overflow");
static_assert(WS_ZERO_BYTES <= WS_SSQRET, "zero region overflow");

struct Params {
    const float *x, *c, *ctx, *c_ctx, *w_ada, *b_ada, *w_in, *dec_f, *dec_b, *ret_gn, *w_ret_o, *q_norm, *w_q_up, *kv_norm, *w_kv_up, *w_mla_o, *w_out, *w_up, *conv_w, *conv_b, *w_down, *final_norm;
    float* out; unsigned char* ws;
    int ph_lo, ph_hi;
};

DI unsigned cvt_pk_bf16(float lo, float hi) { unsigned r; asm volatile("v_cvt_pk_bf16_f32 %0, %1, %2" : "=v"(r) : "v"(lo), "v"(hi)); return r; }
DI unsigned cvt_pk_bf16_t(float lo, float hi) { unsigned r; asm volatile("s_nop 1\n\tv_cvt_pk_bf16_f32 %0, %1, %2" : "=v"(r) : "v"(lo), "v"(hi)); return r; }
DI float bf_lo(unsigned w) { return __uint_as_float(w << 16); }
DI float bf_hi(unsigned w) { return __uint_as_float(w & 0xffff0000u); }
DI float sigmoidf_(float x) { return __builtin_amdgcn_rcpf(1.f + __expf(-x)); }
DI float siluf_(float x) { return x * sigmoidf_(x); }
DI float wave_sum(float v) {
#pragma unroll
    for (int o = 32; o > 0; o >>= 1) v += __shfl_xor(v, o);
    return v;
}


#define XB_TMO      128
#define XB_XCNT(j)  (256  + 64 * (j))
#define XB_XSUB(j)  (1280 + 64 * (j))
#define XB_XGEN(j)  (2304 + 64 * (j))
#define XB_TOP      3328
#define XB_TOPGEN   3392
#define XCD_BAR_WORDS 3456
#define XB_SPIN_CAP (1u << 20)
DI unsigned xb_ld(unsigned* p)              { return __hip_atomic_load(p, __ATOMIC_RELAXED, __HIP_MEMORY_SCOPE_AGENT); }
DI unsigned xb_add(unsigned* p, unsigned v) { return __hip_atomic_fetch_add(p, v, __ATOMIC_RELAXED, __HIP_MEMORY_SCOPE_AGENT); }
DI unsigned xb_xcc_id() { return (unsigned)__builtin_amdgcn_s_getreg((3 << 11) | 20) & 0xFu; }
#define XB_SPIN(cond, bar) do { unsigned _sp = 0; while (cond) { __builtin_amdgcn_s_sleep(1); \
    if ((++_sp & 255u) == 0u) { if (xb_ld(&(bar)[XB_TMO])) break; if (_sp > XB_SPIN_CAP) { atomicAdd(&(bar)[XB_TMO], 1u); break; } } } } while (0)
struct XcdBarrier { unsigned* bar; unsigned x; volatile LAS unsigned* st; };
DI XcdBarrier xcd_barrier_post(unsigned* bar, volatile LAS unsigned* st) {
    XcdBarrier b; b.bar = bar; b.x = xb_xcc_id(); b.st = st;
    if (threadIdx.x == 0) (void)xb_add(&bar[XB_XCNT(b.x)], 1u);
    return b;
}
DI void xcd_barrier_complete(unsigned* bar, unsigned x, unsigned& nloc, unsigned& nx) {
    const unsigned G = gridDim.x * gridDim.y * gridDim.z;
    unsigned sum, cnt, mine, sp = 0u;
    for (;;) {
        sum = 0u; cnt = 0u; mine = 0u;
#pragma unroll
        for (unsigned j = 0; j < 16; ++j) { const unsigned c = xb_ld(&bar[XB_XCNT(j)]); sum += c; cnt += (c > 0u) ? 1u : 0u; mine = (j == x) ? c : mine; }
        if (sum == G) break;
        __builtin_amdgcn_s_sleep(1);
        if ((++sp & 255u) == 0u) { if (xb_ld(&bar[XB_TMO])) break; if (sp > XB_SPIN_CAP) { atomicAdd(&bar[XB_TMO], 1u); break; } }
    }
    nloc = mine > 0u ? mine : 1u; nx = cnt > 0u ? cnt : 1u;
}
DI void xcd_barrier(const XcdBarrier& b) {
    asm volatile("s_waitcnt vmcnt(0)" ::: "memory");
    __syncthreads();
    if (threadIdx.x == 0) {
        unsigned* bar = b.bar;
        __builtin_amdgcn_s_waitcnt(0);
        unsigned nloc = b.st[0], nx = b.st[1];
        if (nloc == 0u) { xcd_barrier_complete(bar, b.x, nloc, nx); b.st[0] = nloc; b.st[1] = nx; }
        const unsigned old = xb_add(&bar[XB_XSUB(b.x)], 1u);
        const unsigned gen = old / nloc;
        if (old + 1u == (gen + 1u) * nloc) {
            __builtin_amdgcn_fence(__ATOMIC_RELEASE, "agent");
            asm volatile("s_waitcnt vmcnt(0)" ::: "memory");
            const unsigned og = xb_add(&bar[XB_TOP], 1u);
            const unsigned tg = og / nx;
            if (og + 1u == (tg + 1u) * nx) xb_add(&bar[XB_TOPGEN], 1u);
            else XB_SPIN(xb_ld(&bar[XB_TOPGEN]) == tg, bar);
            __builtin_amdgcn_fence(__ATOMIC_ACQUIRE, "agent");
            xb_add(&bar[XB_XGEN(b.x)], 1u);
            asm volatile("s_waitcnt vmcnt(0)" ::: "memory");
        } else {
            XB_SPIN(xb_ld(&bar[XB_XGEN(b.x)]) == gen, bar);
            __builtin_amdgcn_fence(__ATOMIC_ACQUIRE, "agent");
            asm volatile("s_waitcnt vmcnt(0)" ::: "memory");
        }
    }
    __syncthreads();
}

namespace pg8 {
constexpr int BM = 256, BK = 64, HALF = 128, HTB = HALF * BK * 2, STAGE_BYTES = 8 * HTB, NXCD = 8, WGM = 8;
DI int lds_byte(int r, int c) { const int st = (r >> 4) * 2 + (c >> 5), rr = r & 15, cc = c & 31, ob = rr * 64 + cc * 2; return st * 1024 + (ob ^ (((ob >> 9) & 1) << 5)); }
DI void stage_rc(int b, int& R, int& C) { const int st = b / 1024, sb = b % 1024, swz = sb ^ (((sb >> 9) & 1) << 5); R = (st >> 1) * 16 + swz / 64; C = (st & 1) * 32 + (swz % 64) / 2; }
DI int perm32(int rho) { const int n = rho >> 4, i = rho & 15; return 8 * (i >> 2) + 4 * n + (i & 3); }
struct Unit { int pm, pn; };
struct Gemm { const bf16_t* A; const bf16_t* Bt; int K; const bf16_t* A2; const bf16_t* Bt2; };

DI void tile_map(int L, int nM, int nN, int& pm, int& pn) {
    const int nwg = nM * nN; int wgid = L;
    { const int q = nwg / NXCD, r = nwg % NXCD, xcd = wgid % NXCD, off = wgid / NXCD; wgid = (xcd < r ? xcd * (q + 1) : r * (q + 1) + (xcd - r) * q) + off; }
    const int nig = WGM * nN, gid = wgid / nig, fm = gid * WGM, gsz = (nM - fm) < WGM ? (nM - fm) : WGM;
    pm = fm + ((wgid % nig) % gsz); pn = (wgid % nig) / gsz;
}
template <int KIND> struct Sched {
    int nM, nN, G, c;
    DI bool next(int i, Unit& u) const {
        const int L = i * G + c;
        if (KIND == 0) { if (L >= nM * nN) return false; tile_map(L, nM, nN, u.pm, u.pn); return true; }
        else {
            if (L < 2880) { int lm, ln; tile_map(L, 64, 45, lm, ln); u.pm = (lm >> 3) * 9 + 1 + (lm & 7); u.pn = ln; return true; }
            if (L < 3000) { int lm, ln; tile_map(L - 2880, 8, 15, lm, ln); u.pm = lm * 9; u.pn = ln; return true; }
            return false;
        }
    }
    DI void a_ready(const Unit&) const {}
    DI void done(const Unit&) const {}
};

template <class Epi, class SchedT>
DI void gemm_phase(LAS unsigned char* lds, const Gemm g, const SchedT& S, const Epi& E) {
    int tid = threadIdx.x; asm volatile("" : "+v"(tid));
    const int wid = __builtin_amdgcn_readfirstlane(tid >> 6), lane = tid & 63, wr = wid >> 2, wc = wid & 3, fr = lane & 15, fq = lane >> 4;
    constexpr bool DUAL = Epi::DUAL;
    const int K = g.K, nth = K / BK, nt = DUAL ? 2 * nth : nth;
    unsigned voffA[2], voffB[2];
#pragma unroll
    for (int i = 0; i < 2; ++i) { int R, C; stage_rc(tid * 16 + i * 8192, R, C); const int Rb = Epi::PERM ? ((R & ~31) + perm32(R & 31)) : R;
        voffA[i] = (unsigned)(R * K + C) * 2u; voffB[i] = (unsigned)(Rb * K + C) * 2u; }
    const size_t kstep = (size_t)(BK * 2);
    const size_t hstep = (size_t)HALF * K * 2;
    const size_t tstep = 2 * hstep;
    const unsigned ldsw = (unsigned)wid * 1024u;
    const int aoff = lds_byte(wr * 64 + fr, fq * 8), boff = lds_byte(wc * 32 + fr, fq * 8);
#define PG8_SA(b, h) (((b) * 2 + (h)) * HTB)
#define PG8_SB(b, h) ((4 + (b) * 2 + (h)) * HTB)
#define PG8_STAGE(bufoff, gbase, voff) do { _Pragma("unroll") for (int _i = 0; _i < 2; ++_i) \
        __builtin_amdgcn_global_load_lds((const unsigned*)((const char*)(gbase) + (voff)[_i]), (LAS unsigned*)(lds + (bufoff) + ldsw + _i * 8192), 16, 0, 0); } while (0)
#define PG8_LDA(dst, b, h) do { _Pragma("unroll") for (int m = 0; m < 4; ++m) _Pragma("unroll") for (int k = 0; k < 2; ++k) dst[m][k] = *(const LAS bf16x8*)(lds + PG8_SA(b, h) + aoff + m * 2048 + k * 1024); } while (0)
#define PG8_LDB(dst, b, h) do { _Pragma("unroll") for (int n = 0; n < 2; ++n) _Pragma("unroll") for (int k = 0; k < 2; ++k) dst[n][k] = *(const LAS bf16x8*)(lds + PG8_SB(b, h) + boff + n * 2048 + k * 1024); } while (0)
#define PG8_MMA(ai, bj, At, Bt) do { __builtin_amdgcn_s_setprio(1); _Pragma("unroll") for (int m = 0; m < 4; ++m) _Pragma("unroll") for (int n = 0; n < 2; ++n) _Pragma("unroll") for (int k = 0; k < 2; ++k) \
        acc[ai][bj][m][n] = __builtin_amdgcn_mfma_f32_16x16x32_bf16(Bt[n][k], At[m][k], acc[ai][bj][m][n], 0, 0, 0); __builtin_amdgcn_s_setprio(0); } while (0)
#define PG8_WAIT_V(n) asm volatile("s_waitcnt vmcnt(" #n ")" ::: "memory")
#define PG8_WAIT_L(n) asm volatile("s_waitcnt lgkmcnt(" #n ")" ::: "memory")
#define PG8_BAR __builtin_amdgcn_s_barrier()
#define PG8_SCHED __builtin_amdgcn_sched_barrier(0)
    Unit cur, nxt; int ui = 0;
    if (!S.next(0, cur)) return;
    f32x4 acc[2][2][4][2];
#pragma unroll
    for (int a = 0; a < 2; ++a)
#pragma unroll
        for (int b = 0; b < 2; ++b)
#pragma unroll
            for (int m = 0; m < 4; ++m)
#pragma unroll
                for (int n = 0; n < 2; ++n) acc[a][b][m][n] = (f32x4){0.f, 0.f, 0.f, 0.f};
    bf16x8 At[4][2], B0[2][2], B1[2][2];
    const char* cA = (const char*)g.A + (size_t)cur.pm * tstep; const char* cB = (const char*)g.Bt + (size_t)cur.pn * tstep;
    const char* cA2 = DUAL ? (const char*)g.A2 + (size_t)cur.pm * tstep : cA; const char* cB2 = DUAL ? (const char*)g.Bt2 + (size_t)cur.pn * tstep : cB;
    S.a_ready(cur);
    PG8_STAGE(PG8_SB(0, 0), cB, voffB); PG8_STAGE(PG8_SA(0, 0), cA, voffA); PG8_STAGE(PG8_SB(0, 1), cB + hstep, voffB); PG8_STAGE(PG8_SA(0, 1), cA + hstep, voffA);
    if (wr == 1) PG8_BAR;
    PG8_WAIT_V(4); PG8_BAR;
    PG8_STAGE(PG8_SB(1, 0), cB + kstep, voffB); PG8_STAGE(PG8_SA(1, 0), cA + kstep, voffA); PG8_STAGE(PG8_SB(1, 1), cB + hstep + kstep, voffB);
    PG8_WAIT_V(6); PG8_BAR;
    for (;;) {
        const bool has_next = S.next(ui + 1, nxt);
        const char* nA = has_next ? (const char*)g.A + (size_t)nxt.pm * tstep : cA; const char* nB = has_next ? (const char*)g.Bt + (size_t)nxt.pn * tstep : cB;
        for (int t = 0; t < nt; t += 2) {
            const bool last = (t == nt - 2);
            const bool h2a = DUAL && (t + 1 >= nth), h2b = DUAL && (t + 2 >= nth);
            const char* a1 = (h2a ? cA2 - (size_t)nth * kstep : cA) + (size_t)(t + 1) * kstep;
            const char* a2 = last ? nA : (h2b ? cA2 - (size_t)nth * kstep : cA) + (size_t)(t + 2) * kstep; const char* b2 = last ? nB : (h2b ? cB2 - (size_t)nth * kstep : cB) + (size_t)(t + 2) * kstep;
            const char* a3 = a2 + kstep; const char* b3 = b2 + kstep;
            if (last && has_next) S.a_ready(nxt);
            if constexpr (DUAL) { if (t == nth) { int fr_ = fr, fq_ = fq; asm volatile("" : "+v"(fr_), "+v"(fq_)); E.mid(acc, cur, wr, wc, fr_, fq_); } }
            PG8_LDB(B0, 0, 0); PG8_SCHED; PG8_LDA(At, 0, 0); PG8_STAGE(PG8_SA(1, 1), a1 + hstep, voffA);
            PG8_WAIT_L(8); PG8_BAR; PG8_WAIT_L(0); PG8_MMA(0, 0, At, B0); PG8_BAR; PG8_SCHED;
            PG8_LDB(B1, 0, 1); PG8_STAGE(PG8_SB(0, 0), b2, voffB);
            PG8_BAR; PG8_WAIT_L(0); PG8_MMA(0, 1, At, B1); PG8_BAR;
            PG8_LDA(At, 0, 1); PG8_STAGE(PG8_SA(0, 0), a2, voffA);
            PG8_BAR; PG8_WAIT_L(0); PG8_MMA(1, 0, At, B0); PG8_BAR; PG8_SCHED;
            PG8_STAGE(PG8_SB(0, 1), b2 + hstep, voffB);
            PG8_WAIT_V(6); PG8_BAR; PG8_MMA(1, 1, At, B1); PG8_BAR;
            PG8_LDB(B0, 1, 0); PG8_SCHED; PG8_LDA(At, 1, 0); PG8_STAGE(PG8_SA(0, 1), a2 + hstep, voffA);
            PG8_WAIT_L(8); PG8_BAR; PG8_WAIT_L(0); PG8_MMA(0, 0, At, B0); PG8_BAR; PG8_SCHED;
            PG8_LDB(B1, 1, 1); PG8_STAGE(PG8_SB(1, 0), b3, voffB);
            PG8_BAR; PG8_WAIT_L(0); PG8_MMA(0, 1, At, B1); PG8_BAR;
            PG8_LDA(At, 1, 1); PG8_STAGE(PG8_SA(1, 0), a3, voffA);
            PG8_BAR; PG8_WAIT_L(0); PG8_MMA(1, 0, At, B0); PG8_BAR; PG8_SCHED;
            PG8_STAGE(PG8_SB(1, 1), b3 + hstep, voffB);
            PG8_WAIT_V(6); PG8_BAR; PG8_MMA(1, 1, At, B1); PG8_BAR;
        }
        { int fr_ = fr, fq_ = fq; asm volatile("" : "+v"(fr_), "+v"(fq_)); E(acc, cur, wr, wc, fr_, fq_); } S.done(cur);
        if (!has_next) break;
#pragma unroll
        for (int a = 0; a < 2; ++a)
#pragma unroll
            for (int b = 0; b < 2; ++b)
#pragma unroll
                for (int m = 0; m < 4; ++m)
#pragma unroll
                    for (int n = 0; n < 2; ++n) acc[a][b][m][n] = (f32x4){0.f, 0.f, 0.f, 0.f};
        cur = nxt; cA = nA; cB = nB; ++ui;
        if constexpr (DUAL) { cA2 = (const char*)g.A2 + (size_t)cur.pm * tstep; cB2 = (const char*)g.Bt2 + (size_t)cur.pn * tstep; }
    }
    PG8_WAIT_V(0);
    if (wr == 0) PG8_BAR;
    PG8_BAR;
#undef PG8_SA
#undef PG8_SB
#undef PG8_STAGE
#undef PG8_LDA
#undef PG8_LDB
#undef PG8_MMA
#undef PG8_WAIT_V
#undef PG8_WAIT_L
#undef PG8_BAR
#undef PG8_SCHED
}
}
using pg8::Unit;
typedef const f32x4 (&AccRef)[2][2][4][2];

template <int ACT  >
DI void store_plain(AccRef acc, bf16_t* dst, size_t ld, int row0, int col0) {
#pragma unroll
    for (int ai = 0; ai < 2; ++ai)
#pragma unroll
        for (int m = 0; m < 4; ++m) { int rowi = row0 + ai * 128 + m * 16; asm volatile("" : "+v"(rowi)); bf16_t* rowp = dst + (size_t)rowi * ld + col0;
#pragma unroll
            for (int bj = 0; bj < 2; ++bj) { f32x4 v0 = acc[ai][bj][m][0], v1 = acc[ai][bj][m][1];
                if (ACT == 1) {
#pragma unroll
                    for (int j = 0; j < 4; ++j) { v0[j] = siluf_(v0[j]); v1[j] = siluf_(v1[j]); } }
                if (ACT == 2) {
#pragma unroll
                    for (int j = 0; j < 4; ++j) { v0[j] = sigmoidf_(v0[j]); v1[j] = sigmoidf_(v1[j]); } }
                u32x4 w;
                if (ACT == 0) { w.x = cvt_pk_bf16(v0[0], v0[1]); w.y = cvt_pk_bf16(v0[2], v0[3]); w.z = cvt_pk_bf16(v1[0], v1[1]); w.w = cvt_pk_bf16(v1[2], v1[3]); }
                else { w.x = cvt_pk_bf16_t(v0[0], v0[1]); w.y = cvt_pk_bf16_t(v0[2], v0[3]); w.z = cvt_pk_bf16_t(v1[0], v1[1]); w.w = cvt_pk_bf16_t(v1[2], v1[3]); }
                *(u32x4*)(rowp + bj * 128) = w; } }
}
DI void add_ssq(AccRef acc, float* ssq, int row0, int fq) {
#pragma unroll
    for (int ai = 0; ai < 2; ++ai)
#pragma unroll
        for (int m = 0; m < 4; ++m) { float s = 0.f;
#pragma unroll
            for (int bj = 0; bj < 2; ++bj)
#pragma unroll
                for (int n = 0; n < 2; ++n)
#pragma unroll
                    for (int j = 0; j < 4; ++j) { const float v = acc[ai][bj][m][n][j]; s += v * v; }
            s += __shfl_xor(s, 16); s += __shfl_xor(s, 32);
            if (fq == 0) atomicAdd(ssq + row0 + ai * 128 + m * 16, s); }
}
DI void store_rope128(AccRef acc, bf16_t* dst, int row0, int head0, int s0, bool do_rope, float scale, int wc, int fq) {
    const int half = wc >> 1, f0 = ((wc & 1) * 4 + fq) * 4;
    float inv[4];
#pragma unroll
    for (int j = 0; j < 4; ++j) inv[j] = __builtin_amdgcn_exp2f(-(float)(f0 + j) * 0.41524101186f) * 0.15915494309f;
#pragma unroll
    for (int ai = 0; ai < 2; ++ai)
#pragma unroll
        for (int m = 0; m < 4; ++m) { const int s = s0 + ai * 128 + m * 16; const float pos = (float)(half ? (s & 63) : (s >> 6));
            float cs[4], sn[4];
#pragma unroll
            for (int j = 0; j < 4; ++j) { const float rev = pos * inv[j]; cs[j] = do_rope ? __builtin_amdgcn_cosf(rev) : 1.f; sn[j] = do_rope ? __builtin_amdgcn_sinf(rev) : 0.f; }
#pragma unroll
            for (int bj = 0; bj < 2; ++bj) { const f32x4 t1 = acc[ai][bj][m][0], t2 = acc[ai][bj][m][1]; float o1[4], o2[4];
#pragma unroll
                for (int j = 0; j < 4; ++j) { o1[j] = (t1[j] * cs[j] - t2[j] * sn[j]) * scale; o2[j] = (t2[j] * cs[j] + t1[j] * sn[j]) * scale; }
                int rowi = row0 + ai * 128 + m * 16; asm volatile("" : "+v"(rowi)); bf16_t* p = dst + (size_t)rowi * 1024 + (head0 + bj) * 128 + half * 64 + f0;
                u32x2 w1, w2; w1.x = cvt_pk_bf16(o1[0], o1[1]); w1.y = cvt_pk_bf16(o1[2], o1[3]); w2.x = cvt_pk_bf16(o2[0], o2[1]); w2.y = cvt_pk_bf16(o2[2], o2[3]);
                *(u32x2*)p = w1; *(u32x2*)(p + 32) = w2; } }
}
DI void store_rope32(AccRef acc, int bj, const float (&rs)[2][4], bf16_t* dst, size_t ld, int row0, int colbase, int g, int s0, bool do_rope, int fq) {
    const int f0 = 4 * fq; float inv[4];
#pragma unroll
    for (int j = 0; j < 4; ++j) inv[j] = __builtin_amdgcn_exp2f(-(float)(f0 + j) * 0.83048202372f) * 0.15915494309f;
#pragma unroll
    for (int ai = 0; ai < 2; ++ai)
#pragma unroll
        for (int m = 0; m < 4; ++m) { const int s = s0 + ai * 128 + m * 16; const float pos = (float)(g ? (s & 63) : (s >> 6));
            const f32x4 t1 = (bj ? acc[ai][1][m][0] : acc[ai][0][m][0]) * rs[ai][m], t2 = (bj ? acc[ai][1][m][1] : acc[ai][0][m][1]) * rs[ai][m]; float o1[4], o2[4];
#pragma unroll
            for (int j = 0; j < 4; ++j) { const float rev = pos * inv[j]; const float cs = do_rope ? __builtin_amdgcn_cosf(rev) : 1.f, sn = do_rope ? __builtin_amdgcn_sinf(rev) : 0.f;
                o1[j] = t1[j] * cs - t2[j] * sn; o2[j] = t2[j] * cs + t1[j] * sn; }
            int rowi = row0 + ai * 128 + m * 16; asm volatile("" : "+v"(rowi)); bf16_t* p = dst + (size_t)rowi * ld + colbase + f0;
            u32x2 w1, w2; w1.x = cvt_pk_bf16(o1[0], o1[1]); w1.y = cvt_pk_bf16(o1[2], o1[3]); w2.x = cvt_pk_bf16(o2[0], o2[1]); w2.y = cvt_pk_bf16(o2[2], o2[3]);
            *(u32x2*)p = w1; *(u32x2*)(p + 16) = w2; }
}

struct EpiInProj {
    static constexpr bool PERM = true, DUAL = false;
    bf16_t *rk, *rv, *kvd, *kr, *rq, *rg, *qd, *gr, *gm; float *ssq_kv, *ssq_q; bf16_t* dcopy;
    DI void operator()(AccRef acc, const Unit& u, int wr, int wc, int fr, int fq) const {
        const int pn = u.pn, b = u.pm / 9, jt = u.pm % 9; const bool latent = jt != 0;
        const int trow0 = u.pm * 256 + wr * 64 + fr;
        const int srow0 = (b * 8 + jt - 1) * 256 + wr * 64 + fr;
        const int s0 = (jt - 1) * 256 + wr * 64 + fr;
        const int cw = wc * 32 + 8 * fq;
        if (pn < 4) store_rope128(acc, rk, trow0, pn * 2, s0, latent, 0.08838834764831845f, wc, fq);
        else if (pn < 12) store_plain<0>(acc, rv, 2048, trow0, (pn - 4) * 256 + cw);
        else if (pn < 14) { store_plain<0>(acc, kvd, 512, trow0, (pn - 12) * 256 + cw); add_ssq(acc, ssq_kv, trow0, fq); }
        else if (pn == 14) { if (wc < 2) { const float one[2][4] = {{1.f, 1.f, 1.f, 1.f}, {1.f, 1.f, 1.f, 1.f}}; store_rope32(acc, 0, one, kr, 64, trow0, wc * 32, wc, s0, latent, fq); } }
        else if (pn < 19) store_rope128(acc, rq, srow0, (pn - 15) * 2, s0, true, 1.f, wc, fq);
        else if (pn < 27) store_plain<1>(acc, rg, 2048, srow0, (pn - 19) * 256 + cw);
        else if (pn < 29) { store_plain<0>(acc, qd, 512, srow0, (pn - 27) * 256 + cw); add_ssq(acc, ssq_q, srow0, fq); }
        else if (pn < 37) store_plain<2>(acc, gr, 2048, srow0, (pn - 29) * 256 + cw);
        else store_plain<2>(acc, gm, 2048, srow0, (pn - 37) * 256 + cw);
    }
};
struct EpiQup {
    static constexpr bool PERM = true, DUAL = false;
    bf16_t* qm; const float* ssq_q;
    DI void operator()(AccRef acc, const Unit& u, int wr, int wc, int fr, int fq) const {
        const int row0 = u.pm * 256 + wr * 64 + fr; const int s0 = (u.pm & 7) * 256 + wr * 64 + fr;
        float rs[2][4];
#pragma unroll
        for (int ai = 0; ai < 2; ++ai)
#pragma unroll
            for (int m = 0; m < 4; ++m) rs[ai][m] = __builtin_amdgcn_rsqf(ssq_q[row0 + ai * 128 + m * 16] * (1.f / 512.f) + EPS);
#pragma unroll
        for (int bj = 0; bj < 2; ++bj) {
            const int gidx = u.pn * 8 + bj * 4 + wc, head = gidx / 6, gi = gidx % 6;
            if (gi < 4) {
#pragma unroll
                for (int ai = 0; ai < 2; ++ai)
#pragma unroll
                    for (int m = 0; m < 4; ++m) { const f32x4 v0 = acc[ai][bj][m][0] * rs[ai][m], v1 = acc[ai][bj][m][1] * rs[ai][m];
                        u32x4 w; w.x = cvt_pk_bf16(v0[0], v0[1]); w.y = cvt_pk_bf16(v0[2], v0[3]); w.z = cvt_pk_bf16(v1[0], v1[1]); w.w = cvt_pk_bf16(v1[2], v1[3]);
                        int rowi = row0 + ai * 128 + m * 16; asm volatile("" : "+v"(rowi));
                        *(u32x4*)(qm + (size_t)rowi * 3072 + head * 192 + gi * 32 + 8 * fq) = w; }
            } else store_rope32(acc, bj, rs, qm, 3072, row0, head * 192 + 128 + (gi - 4) * 32, gi - 4, s0, true, fq);
        }
    }
};
struct EpiKvup {
    static constexpr bool PERM = true, DUAL = false;
    bf16_t* kvup; const float* ssq_kv;
    DI void operator()(AccRef acc, const Unit& u, int wr, int wc, int fr, int fq) const {
        const int row0 = u.pm * 256 + wr * 64 + fr, col0 = u.pn * 256 + wc * 32 + 8 * fq;
        float rs[2][4];
#pragma unroll
        for (int ai = 0; ai < 2; ++ai)
#pragma unroll
            for (int m = 0; m < 4; ++m) rs[ai][m] = __builtin_amdgcn_rsqf(ssq_kv[row0 + ai * 128 + m * 16] * (1.f / 512.f) + EPS);
#pragma unroll
        for (int ai = 0; ai < 2; ++ai)
#pragma unroll
            for (int m = 0; m < 4; ++m) { int row = row0 + ai * 128 + m * 16; asm volatile("" : "+v"(row));
#pragma unroll
                for (int bj = 0; bj < 2; ++bj) { const f32x4 v0 = acc[ai][bj][m][0] * rs[ai][m], v1 = acc[ai][bj][m][1] * rs[ai][m];
                    u32x4 w; w.x = cvt_pk_bf16(v0[0], v0[1]); w.y = cvt_pk_bf16(v0[2], v0[3]); w.z = cvt_pk_bf16(v1[0], v1[1]); w.w = cvt_pk_bf16(v1[2], v1[3]);
                    *(u32x4*)(kvup + (size_t)row * 4096 + col0 + bj * 128) = w; } }
    }
};
struct EpiDual {
    static constexpr bool PERM = true, DUAL = true;
    const bf16_t *gr, *gm; bf16_t* mixed;
    DI void mid(f32x4 (&acc)[2][2][4][2], const Unit& u, int wr, int wc, int fr, int fq) const {
        const int row0 = u.pm * 256 + wr * 64 + fr, col0 = u.pn * 256 + wc * 32 + 8 * fq;
#pragma unroll
        for (int ai = 0; ai < 2; ++ai)
#pragma unroll
            for (int mp = 0; mp < 2; ++mp) { u32x4 ga[2][2], gb[2][2];
#pragma unroll
                for (int mm = 0; mm < 2; ++mm) { int rowi = row0 + ai * 128 + (mp * 2 + mm) * 16; asm volatile("" : "+v"(rowi));
#pragma unroll
                    for (int bj = 0; bj < 2; ++bj) { const size_t o = (size_t)rowi * 2048 + col0 + bj * 128; ga[mm][bj] = *(const u32x4*)(gr + o); gb[mm][bj] = *(const u32x4*)(gm + o); } }
#pragma unroll
                for (int mm = 0; mm < 2; ++mm)
#pragma unroll
                    for (int bj = 0; bj < 2; ++bj) { const u32x4 a = ga[mm][bj], b = gb[mm][bj]; f32x4 r0, r1;
                        r0[0] = bf_lo(a.x) * __builtin_amdgcn_rcpf(fmaxf(bf_lo(b.x), 1e-30f)); r0[1] = bf_hi(a.x) * __builtin_amdgcn_rcpf(fmaxf(bf_hi(b.x), 1e-30f));
                        r0[2] = bf_lo(a.y) * __builtin_amdgcn_rcpf(fmaxf(bf_lo(b.y), 1e-30f)); r0[3] = bf_hi(a.y) * __builtin_amdgcn_rcpf(fmaxf(bf_hi(b.y), 1e-30f));
                        r1[0] = bf_lo(a.z) * __builtin_amdgcn_rcpf(fmaxf(bf_lo(b.z), 1e-30f)); r1[1] = bf_hi(a.z) * __builtin_amdgcn_rcpf(fmaxf(bf_hi(b.z), 1e-30f));
                        r1[2] = bf_lo(a.w) * __builtin_amdgcn_rcpf(fmaxf(bf_lo(b.w), 1e-30f)); r1[3] = bf_hi(a.w) * __builtin_amdgcn_rcpf(fmaxf(bf_hi(b.w), 1e-30f));
                        acc[ai][bj][mp * 2 + mm][0] *= r0; acc[ai][bj][mp * 2 + mm][1] *= r1; }
                asm volatile("" ::: "memory"); }
    }
    DI void operator()(AccRef acc, const Unit& u, int wr, int wc, int fr, int fq) const {
        const int row0 = u.pm * 256 + wr * 64 + fr, col0 = u.pn * 256 + wc * 32 + 8 * fq;
#pragma unroll
        for (int ai = 0; ai < 2; ++ai) { u32x4 gg[4][2]; size_t off[4];
#pragma unroll
            for (int m = 0; m < 4; ++m) { int rowi = row0 + ai * 128 + m * 16; asm volatile("" : "+v"(rowi)); off[m] = (size_t)rowi * 2048 + col0;
#pragma unroll
                for (int bj = 0; bj < 2; ++bj) gg[m][bj] = *(const u32x4*)(gm + off[m] + bj * 128); }
#pragma unroll
            for (int m = 0; m < 4; ++m)
#pragma unroll
                for (int bj = 0; bj < 2; ++bj) { const u32x4 g = gg[m][bj]; const f32x4 a0 = acc[ai][bj][m][0], a1 = acc[ai][bj][m][1];
                    u32x4 w; w.x = cvt_pk_bf16(a0[0] * bf_lo(g.x), a0[1] * bf_hi(g.x)); w.y = cvt_pk_bf16(a0[2] * bf_lo(g.y), a0[3] * bf_hi(g.y));
                    w.z = cvt_pk_bf16(a1[0] * bf_lo(g.z), a1[1] * bf_hi(g.z)); w.w = cvt_pk_bf16(a1[2] * bf_lo(g.w), a1[3] * bf_hi(g.w));
                    *(u32x4*)(mixed + off[m] + bj * 128) = w; }
            asm volatile("" ::: "memory"); }
    }
};
struct EpiResid {
    static constexpr bool PERM = true, DUAL = false;
    const float* base; float* out; const float* mod; const float* b_ada; int chunk; float gscale;
    DI void operator()(AccRef acc, const Unit& u, int wr, int wc, int fr, int fq) const {
        const int row0 = u.pm * 256 + wr * 64 + fr, col0 = u.pn * 256 + wc * 32 + 8 * fq, b = u.pm >> 3;
        f32x4 gt[2][2];
#pragma unroll
        for (int bj = 0; bj < 2; ++bj)
#pragma unroll
            for (int n = 0; n < 2; ++n) { const int c = chunk * 2048 + col0 + bj * 128 + n * 4; gt[bj][n] = (*(const f32x4*)(mod + b * 12288 + c) + *(const f32x4*)(b_ada + c)) * gscale; }
#pragma unroll
        for (int ai = 0; ai < 2; ++ai)
#pragma unroll
            for (int mp = 0; mp < 2; ++mp) {
                f32x4 bv[2][2][2]; size_t off[2];
#pragma unroll
                for (int mm = 0; mm < 2; ++mm) { int rowi = row0 + ai * 128 + (mp * 2 + mm) * 16; asm volatile("" : "+v"(rowi)); off[mm] = (size_t)rowi * 2048 + col0;
#pragma unroll
                    for (int bj = 0; bj < 2; ++bj)
#pragma unroll
                        for (int n = 0; n < 2; ++n) bv[mm][bj][n] = *(const f32x4*)(base + off[mm] + bj * 128 + n * 4); }
#pragma unroll
                for (int mm = 0; mm < 2; ++mm)
#pragma unroll
                    for (int bj = 0; bj < 2; ++bj)
#pragma unroll
                        for (int n = 0; n < 2; ++n) *(f32x4*)(out + off[mm] + bj * 128 + n * 4) = bv[mm][bj][n] + gt[bj][n] * acc[ai][bj][mp * 2 + mm][n];
                asm volatile("" ::: "memory"); }
    }
};
DI float dpp_prev(float x) { return __int_as_float(__builtin_amdgcn_update_dpp(0, __float_as_int(x), 0x121, 0xf, 0xf, false)); }
DI float dpp_next(float x) { return __int_as_float(__builtin_amdgcn_update_dpp(0, __float_as_int(x), 0x12F, 0xf, 0xf, false)); }
struct EpiUp {
    static constexpr bool PERM = true, DUAL = false;
    bf16_t *u, *aside, *vside; const float *cw, *cb;
    DI void operator()(AccRef acc, const Unit& un, int wr, int wc, int fr, int fq) const {
        const int ch0 = un.pn * 128 + wc * 32 + 8 * fq;
        f32x4 w0[2], w1[2], w2[2], bb[2];
#pragma unroll
        for (int n = 0; n < 2; ++n) { w0[n] = *(const f32x4*)(cw + ch0 + 4 * n); w1[n] = *(const f32x4*)(cw + FFN + ch0 + 4 * n); w2[n] = *(const f32x4*)(cw + 2 * FFN + ch0 + 4 * n); bb[n] = *(const f32x4*)(cb + ch0 + 4 * n); }
#pragma unroll
        for (int ai = 0; ai < 2; ++ai) {
            int rowb = un.pm * 256 + ai * 128 + wr * 64; asm volatile("" : "+s"(rowb));
            u32x2 pu[4][2], pa[4][2], pv[4][2];
#pragma unroll
            for (int n = 0; n < 2; ++n) {
                f32x4 rd[4], ru[4];
#pragma unroll
                for (int m = 0; m < 4; ++m)
#pragma unroll
                    for (int j = 0; j < 4; ++j) { rd[m][j] = dpp_prev(acc[ai][0][m][n][j]); ru[m][j] = dpp_next(acc[ai][0][m][n][j]); }
#pragma unroll
                for (int m = 0; m < 4; ++m) { const f32x4 a = acc[ai][0][m][n], vv = acc[ai][1][m][n]; float uu[4];
#pragma unroll
                    for (int j = 0; j < 4; ++j) {
                        const float prev = (fr == 0) ? (m > 0 ? rd[m > 0 ? m - 1 : 0][j] : 0.f) : rd[m][j];
                        const float next = (fr == 15) ? (m < 3 ? ru[m < 3 ? m + 1 : 3][j] : 0.f) : ru[m][j];
                        const float z = bb[n][j] + w0[n][j] * prev + w1[n][j] * a[j] + w2[n][j] * next;
                        uu[j] = siluf_(z) * vv[j]; }
                    pu[m][n].x = cvt_pk_bf16(uu[0], uu[1]); pu[m][n].y = cvt_pk_bf16(uu[2], uu[3]);
                    if (m == 0 || m == 3) { pa[m][n].x = cvt_pk_bf16(a[0], a[1]); pa[m][n].y = cvt_pk_bf16(a[2], a[3]); pv[m][n].x = cvt_pk_bf16(vv[0], vv[1]); pv[m][n].y = cvt_pk_bf16(vv[2], vv[3]); } }
            }
#pragma unroll
            for (int m = 0; m < 4; ++m) { int rowi = rowb + m * 16 + fr; asm volatile("" : "+v"(rowi));
                u32x4 w; w.x = pu[m][0].x; w.y = pu[m][0].y; w.z = pu[m][1].x; w.w = pu[m][1].y;
                *(u32x4*)(u + (size_t)rowi * FFN + ch0) = w; }
            const int kb = rowb >> 6;
            if (fr < 2) { u32x4 w; w.x = pa[0][0].x; w.y = pa[0][0].y; w.z = pa[0][1].x; w.w = pa[0][1].y; *(u32x4*)(aside + (size_t)(kb * 4 + fr) * FFN + ch0) = w; }
            if (fr >= 14) { u32x4 w; w.x = pa[3][0].x; w.y = pa[3][0].y; w.z = pa[3][1].x; w.w = pa[3][1].y; *(u32x4*)(aside + (size_t)(kb * 4 + fr - 12) * FFN + ch0) = w; }
            if (fr == 0) { u32x4 w; w.x = pv[0][0].x; w.y = pv[0][0].y; w.z = pv[0][1].x; w.w = pv[0][1].y; *(u32x4*)(vside + (size_t)(kb * 2) * FFN + ch0) = w; }
            if (fr == 15) { u32x4 w; w.x = pv[3][0].x; w.y = pv[3][0].y; w.z = pv[3][1].x; w.w = pv[3][1].y; *(u32x4*)(vside + (size_t)(kb * 2 + 1) * FFN + ch0) = w; }
            asm volatile("" ::: "memory");
        }
    }
};

namespace att {
constexpr int NW = 8, QBLK = 32, KVBLK = 64, NT = TT / KVBLK;
constexpr size_t SHM_V = KVBLK * 128 * 2, SHM_K = KVBLK * 128 * 2, SHM_KR = KVBLK * 64 * 2;
constexpr size_t OFF_K = 2 * SHM_V, OFF_KR = OFF_K + 2 * SHM_K, OFF_WS = OFF_KR + 2 * SHM_KR;
#define KSWZ(row, colB) ((row) * 256 + ((colB) ^ (((row) & 7) << 4)))
#define KRSWZ(row, colB) ((row) * 128 + ((colB) ^ (((row) & 7) << 4)))
#define SBAR() __builtin_amdgcn_sched_barrier(0)
DI int crow(int r, int hi) { return (r & 3) + 8 * (r >> 2) + 4 * hi; }
DI int v_st(int k, int c) { const int kk = (k & ~0xC) | ((k & 4) << 1) | ((k & 8) >> 1); return ((kk >> 3) * 4 + (c >> 5)) * 512 + ((kk & 7) * 32 + (c & 31)) * 2; }
DI int v_rd_base(int lane) { return ((lane & 3) << 3) | (((lane >> 2) & 3) << 6) | (((lane >> 4) & 1) << 5) | (((lane >> 5) & 1) << 8); }
constexpr int v_rd_off(int d0, int ks, int half) { return d0 * 512 + ks * 4096 + half * 2048; }
template <int OFF> DI s16x4 tr_read(int vb) { s16x4 r; asm volatile("ds_read_b64_tr_b16 %0, %1 offset:%2" : "=&v"(r) : "v"(vb), "i"(OFF) : "memory"); return r; }
template <int D0> DI void pv_one(f32x16& od, int vb, bf16x8 pa0, bf16x8 pa1, bf16x8 pa2, bf16x8 pa3) {
    const s16x4 l0 = tr_read<v_rd_off(D0, 0, 0)>(vb), h0 = tr_read<v_rd_off(D0, 0, 1)>(vb), l1 = tr_read<v_rd_off(D0, 1, 0)>(vb), h1 = tr_read<v_rd_off(D0, 1, 1)>(vb);
    const s16x4 l2 = tr_read<v_rd_off(D0, 2, 0)>(vb), h2 = tr_read<v_rd_off(D0, 2, 1)>(vb), l3 = tr_read<v_rd_off(D0, 3, 0)>(vb), h3 = tr_read<v_rd_off(D0, 3, 1)>(vb);
    asm volatile("s_waitcnt lgkmcnt(0)" ::: "memory"); SBAR();
#define PK(L, H) (bf16x8){L[0], L[1], L[2], L[3], H[0], H[1], H[2], H[3]}
    od = __builtin_amdgcn_mfma_f32_32x32x16_bf16(pa0, PK(l0, h0), od, 0, 0, 0);
    od = __builtin_amdgcn_mfma_f32_32x32x16_bf16(pa1, PK(l1, h1), od, 0, 0, 0);
    od = __builtin_amdgcn_mfma_f32_32x32x16_bf16(pa2, PK(l2, h2), od, 0, 0, 0);
    od = __builtin_amdgcn_mfma_f32_32x32x16_bf16(pa3, PK(l3, h3), od, 0, 0, 0);
#undef PK
}
DI void pv_d0(f32x16* o, int vb, bf16x8 pa0, bf16x8 pa1, bf16x8 pa2, bf16x8 pa3) {
    pv_one<0>(o[0], vb, pa0, pa1, pa2, pa3); pv_one<1>(o[1], vb, pa0, pa1, pa2, pa3); pv_one<2>(o[2], vb, pa0, pa1, pa2, pa3); pv_one<3>(o[3], vb, pa0, pa1, pa2, pa3);
}
DI void pack_p(const f32x16& p0, const f32x16& p1, bf16x8& pa0, bf16x8& pa1, bf16x8& pa2, bf16x8& pa3) {
#define PK4(P, BASE, OUT) do { unsigned a0 = cvt_pk_bf16_t(P[BASE + 0], P[BASE + 1]), a1 = cvt_pk_bf16_t(P[BASE + 2], P[BASE + 3]);   \
    unsigned b0 = cvt_pk_bf16_t(P[BASE + 4], P[BASE + 5]), b1 = cvt_pk_bf16_t(P[BASE + 6], P[BASE + 7]);                              \
    auto r0 = __builtin_amdgcn_permlane32_swap(a0, b0, false, false); auto r1 = __builtin_amdgcn_permlane32_swap(a1, b1, false, false); \
    u32x4 w = {r0[0], r1[0], r0[1], r1[1]}; OUT = *reinterpret_cast<bf16x8*>(&w); } while (0)
    PK4(p0, 0, pa0); PK4(p0, 8, pa1); PK4(p1, 0, pa2); PK4(p1, 8, pa3);
#undef PK4
}
constexpr float MLA_SCALE = 0.07216878364870322f;
constexpr float THR = 8.f;
DI void partialSM(f32x16& p0, f32x16& p1, float& m_reg, float& mn, float& alpha) {
    constexpr float C = MLA_SCALE * 1.4426950408889634f;
    float pmax = p0[0];
#pragma unroll
    for (int r = 1; r < 16; ++r) pmax = fmaxf(pmax, p0[r]);
#pragma unroll
    for (int r = 0; r < 16; ++r) pmax = fmaxf(pmax, p1[r]);
    { auto rr = __builtin_amdgcn_permlane32_swap(__float_as_uint(pmax), __float_as_uint(pmax), false, false); pmax = fmaxf(__uint_as_float(rr[0]), __uint_as_float(rr[1])); }
    if (__builtin_expect(__all(pmax - m_reg <= THR / MLA_SCALE), 1)) { mn = m_reg; alpha = 1.f; }
    else { mn = fmaxf(m_reg, pmax); alpha = __builtin_amdgcn_exp2f((m_reg - mn) * C); m_reg = mn; }
    const float mnC = -mn * C;
#pragma unroll
    for (int r = 0; r < 16; ++r) p0[r] = fmaf(p0[r], C, mnC);
#pragma unroll
    for (int r = 0; r < 16; ++r) p1[r] = fmaf(p1[r], C, mnC);
#pragma unroll
    for (int r = 0; r < 16; ++r) p0[r] = __builtin_amdgcn_exp2f(p0[r]);
}
DI void finishSM(f32x16& p0, f32x16& p1, float alpha, float& l_reg, bf16x8& pa0, bf16x8& pa1, bf16x8& pa2, bf16x8& pa3) {
#pragma unroll
    for (int r = 0; r < 16; ++r) p1[r] = __builtin_amdgcn_exp2f(p1[r]);
    float ps = 0;
#pragma unroll
    for (int r = 0; r < 16; ++r) ps += p0[r];
#pragma unroll
    for (int r = 0; r < 16; ++r) ps += p1[r];
    { auto rr = __builtin_amdgcn_permlane32_swap(__float_as_uint(ps), __float_as_uint(ps), false, false); ps = __uint_as_float(rr[0]) + __uint_as_float(rr[1]); }
    l_reg = l_reg * alpha + ps;
    pack_p(p0, p1, pa0, pa1, pa2, pa3);
}
template <int ND0>
DI void qkt(f32x16& p0, f32x16& p1, const char* Ks, const char* Krs, const bf16x8* qr, int r32, int hi, const char* qx = nullptr) {
    p0 = f32x16{}; p1 = f32x16{};
#pragma unroll
    for (int d0 = 0; d0 < 8; ++d0) { const int cb = (d0 * 16 + hi * 8) * 2;
        const bf16x8 b0 = *reinterpret_cast<const bf16x8*>(Ks + KSWZ(r32, cb));
        const bf16x8 b1 = *reinterpret_cast<const bf16x8*>(Ks + KSWZ(32 + r32, cb));
        p0 = __builtin_amdgcn_mfma_f32_32x32x16_bf16(b0, qr[d0], p0, 0, 0, 0);
        p1 = __builtin_amdgcn_mfma_f32_32x32x16_bf16(b1, qr[d0], p1, 0, 0, 0); }
    if (ND0 == 12) {
#pragma unroll
        for (int d0 = 0; d0 < 4; ++d0) { const int cb = (d0 * 16 + hi * 8) * 2;
            const bf16x8 b0 = *reinterpret_cast<const bf16x8*>(Krs + KRSWZ(r32, cb));
            const bf16x8 b1 = *reinterpret_cast<const bf16x8*>(Krs + KRSWZ(32 + r32, cb));
            const bf16x8 qf = *reinterpret_cast<const bf16x8*>(qx + d0 * 1024);
            p0 = __builtin_amdgcn_mfma_f32_32x32x16_bf16(b0, qf, p0, 0, 0, 0);
            p1 = __builtin_amdgcn_mfma_f32_32x32x16_bf16(b1, qf, p1, 0, 0, 0); }
    }
}

DI void mla_body(const bf16_t* __restrict__ Qb, const bf16_t* __restrict__ Kh, const bf16_t* __restrict__ Vh, const bf16_t* __restrict__ Krh, bf16_t* __restrict__ Ob, char* lds) {
    constexpr int LDQ = 3072, LDK = 4096, LDKR = 64, LDO = 2048;
    int tid = threadIdx.x; asm volatile("" : "+v"(tid));
    const int wid = tid >> 6, lane = tid & 63, r32 = lane & 31, hi = lane >> 5;
    char* V_lds = lds; char* K_lds = lds + OFF_K; char* Kr_lds = lds + OFF_KR;
    float* ws = (float*)(lds + OFF_WS) + wid * 64; float* li_l = ws; float* al_l = ws + 32;
    float m_reg = -1e30f, l_reg = 0; f32x16 o[4] = {}; bf16x8 qr[8];
    const bf16_t* Qw = Qb + (long)(wid * QBLK + r32) * LDQ + hi * 8;
    char* qx = lds + OFF_WS + 2048 + wid * 4096 + lane * 16;
#pragma unroll
    for (int d0 = 0; d0 < 8; ++d0) qr[d0] = *reinterpret_cast<const bf16x8*>(Qw + d0 * 16);
#pragma unroll
    for (int d0 = 0; d0 < 4; ++d0) *reinterpret_cast<bf16x8*>(qx + d0 * 1024) = *reinterpret_cast<const bf16x8*>(Qw + (8 + d0) * 16);
    const int sr = tid >> 4, sc = (tid & 15) * 8, vst0 = v_st(sr, sc), vst1 = v_st(32 + sr, sc);
    const int rr = tid >> 3, rc = (tid & 7) * 8;
    const int vb0 = (int)(uintptr_t)V_lds + v_rd_base(lane);
    struct { bf16x8 vs0, vs1, ks0, ks1, kr; } sr_[1];
#define SLOAD(i, k0) do { sr_[i].vs0 = *(const bf16x8*)(&Vh[(long)((k0) + sr) * LDK + sc]); sr_[i].vs1 = *(const bf16x8*)(&Vh[(long)((k0) + 32 + sr) * LDK + sc]); \
    sr_[i].ks0 = *(const bf16x8*)(&Kh[(long)((k0) + sr) * LDK + sc]); sr_[i].ks1 = *(const bf16x8*)(&Kh[(long)((k0) + 32 + sr) * LDK + sc]); \
    sr_[i].kr = *(const bf16x8*)(&Krh[(long)((k0) + rr) * LDKR + rc]); } while (0)
#define SWRITE(b, i) do { *(bf16x8*)(V_lds + (b) * SHM_V + vst0) = sr_[i].vs0; *(bf16x8*)(V_lds + (b) * SHM_V + vst1) = sr_[i].vs1; const int kc = sc * 2; \
    *(bf16x8*)(K_lds + (b) * SHM_K + KSWZ(sr, kc)) = sr_[i].ks0; *(bf16x8*)(K_lds + (b) * SHM_K + KSWZ(32 + sr, kc)) = sr_[i].ks1; \
    *(bf16x8*)(Kr_lds + (b) * SHM_KR + KRSWZ(rr, rc * 2)) = sr_[i].kr; } while (0)
#define SWAIT() asm volatile("s_waitcnt vmcnt(0)" ::: "memory")
#define RESC(a) do { if (__any((a) < 1.f)) { if (hi == 0) al_l[r32] = (a); asm volatile("s_waitcnt lgkmcnt(0)" ::: "memory"); \
    _Pragma("unroll") for (int d = 0; d < 4; ++d) _Pragma("unroll") for (int r = 0; r < 16; ++r) o[d][r] *= al_l[crow(r, hi)]; } } while (0)
    f32x16 pA0, pA1, pB0, pB1; float mnA, mnB, alA, alB; bf16x8 pa0, pa1, pa2, pa3;
    __syncthreads();
    SLOAD(0, 0); SWAIT(); SWRITE(0, 0); __syncthreads();
    qkt<12>(pA0, pA1, K_lds, Kr_lds, qr, r32, hi, qx); partialSM(pA0, pA1, m_reg, mnA, alA);
    SLOAD(0, KVBLK); SWAIT(); SWRITE(1, 0); __syncthreads();
    for (int j = 1; j + 1 < NT; j += 2) {
        SBAR(); qkt<12>(pB0, pB1, K_lds + SHM_K, Kr_lds + SHM_KR, qr, r32, hi, qx);
        finishSM(pA0, pA1, alA, l_reg, pa0, pa1, pa2, pa3); SBAR();
        SLOAD(0, (j + 1) * KVBLK); SBAR();
        pv_d0(o, vb0, pa0, pa1, pa2, pa3); partialSM(pB0, pB1, m_reg, mnB, alB);
        __syncthreads(); SWAIT(); SWRITE(0, 0);
        RESC(alB); __syncthreads();
        SBAR(); qkt<12>(pA0, pA1, K_lds, Kr_lds, qr, r32, hi, qx);
        finishSM(pB0, pB1, alB, l_reg, pa0, pa1, pa2, pa3); SBAR();
        SLOAD(0, (j + 2) * KVBLK); SBAR();
        pv_d0(o, vb0 + (int)SHM_V, pa0, pa1, pa2, pa3); partialSM(pA0, pA1, m_reg, mnA, alA);
        __syncthreads(); SWAIT(); SWRITE(1, 0);
        RESC(alA); __syncthreads();
    }
    SBAR(); qkt<12>(pB0, pB1, K_lds + SHM_K, Kr_lds + SHM_KR, qr, r32, hi, qx);
    finishSM(pA0, pA1, alA, l_reg, pa0, pa1, pa2, pa3); SBAR();
    pv_d0(o, vb0, pa0, pa1, pa2, pa3); partialSM(pB0, pB1, m_reg, mnB, alB);
    __syncthreads(); RESC(alB);
    finishSM(pB0, pB1, alB, l_reg, pa0, pa1, pa2, pa3); SBAR();
    pv_d0(o, vb0 + (int)SHM_V, pa0, pa1, pa2, pa3);
    if (hi == 0) li_l[r32] = l_reg; asm volatile("s_waitcnt lgkmcnt(0)" ::: "memory");
    float rli[16];
#pragma unroll
    for (int r = 0; r < 16; ++r) rli[r] = __builtin_amdgcn_rcpf(li_l[crow(r, hi)]);
    bf16_t* Ow = Ob + (long)(wid * QBLK) * LDO;
    int hio = hi, r32o = r32; asm volatile("" : "+v"(Ow), "+v"(hio), "+v"(r32o));
#pragma unroll
    for (int r = 0; r < 16; ++r) { const int orow = crow(r, hio);
#pragma unroll
        for (int d0 = 0; d0 < 4; ++d0) Ow[(long)orow * LDO + d0 * 32 + r32o] = (bf16_t)(cvt_pk_bf16(o[d0][r] * rli[r], 0.f) & 0xffffu); }
#undef SLOAD
#undef SWRITE
#undef SWAIT
#undef RESC
}

#define UNI(x) __int_as_float(__builtin_amdgcn_readfirstlane(__float_as_int(x)))
struct DecayTab { float af[4], bf[4], ab[4], bb[4], c32f, c32b; };
DI void decayP(f32x16& p0, f32x16& p1, int kt, int irow, int imin, int hi, float lf2, float lb2, const DecayTab& T) {
    if (kt < 4) {
        const float ff = (float)(irow + LC - kt * 64 - 4 * hi), fb = (float)(SEQ + kt * 64 + 4 * hi - irow);
#pragma unroll
        for (int r = 0; r < 16; ++r) { const float kf = (float)((r & 3) + 8 * (r >> 2));
            p0[r] *= __builtin_amdgcn_exp2f(lf2 * (ff - kf)) + __builtin_amdgcn_exp2f(lb2 * (fb + kf));
            p1[r] *= __builtin_amdgcn_exp2f(lf2 * (ff - kf - 32.f)) + __builtin_amdgcn_exp2f(lb2 * (fb + kf + 32.f)); }
    } else {
        const int j0 = (kt - 4) * 64;
        const float fd = (float)(irow - j0 - 4 * hi);
        if (j0 + 63 < imin) {
            const float A = __builtin_amdgcn_exp2f(lf2 * fd); float Ab[4];
#pragma unroll
            for (int q = 0; q < 4; ++q) Ab[q] = A * T.bf[q];
#pragma unroll
            for (int r = 0; r < 16; ++r) { const float w = Ab[r >> 2] * T.af[r & 3]; p0[r] *= w; p1[r] *= w * T.c32f; }
        } else if (j0 > imin + 31) {
            const float A = __builtin_amdgcn_exp2f(-lb2 * fd); float Ab[4];
#pragma unroll
            for (int q = 0; q < 4; ++q) Ab[q] = A * T.bb[q];
#pragma unroll
            for (int r = 0; r < 16; ++r) { const float w = Ab[r >> 2] * T.ab[r & 3]; p0[r] *= w; p1[r] *= w * T.c32b; }
        } else {
#pragma unroll
            for (int r = 0; r < 16; ++r) { const float kf = (float)((r & 3) + 8 * (r >> 2));
                const float d0 = fd - kf, d1 = d0 - 32.f;
                const float e0 = __builtin_amdgcn_exp2f(d0 >= 0.f ? lf2 * d0 : -lb2 * d0), e1 = __builtin_amdgcn_exp2f(d1 >= 0.f ? lf2 * d1 : -lb2 * d1);
                p0[r] *= (d0 == 0.f) ? 2.f : e0; p1[r] *= (d1 == 0.f) ? 2.f : e1; }
        }
    }
}
DI void ret_body(const bf16_t* __restrict__ Qb, const bf16_t* __restrict__ Kh, const bf16_t* __restrict__ Vh, bf16_t* __restrict__ Ob, float* __restrict__ ssq, int irow0, float lf2, float lb2, char* lds) {
    constexpr int LDQ = 1024, LDK = 1024, LDV = 2048, LDO = 2048;
    int tid = threadIdx.x; asm volatile("" : "+v"(tid));
    const int wid = __builtin_amdgcn_readfirstlane(tid >> 6), lane = tid & 63, r32 = lane & 31, hi = lane >> 5;
    char* V_lds = lds; char* K_lds = lds + OFF_K;
    DecayTab T;
#pragma unroll
    for (int m = 0; m < 4; ++m) { T.af[m] = UNI(__builtin_amdgcn_exp2f(-lf2 * (float)m)); T.bf[m] = UNI(__builtin_amdgcn_exp2f(-lf2 * (float)(8 * m))); T.ab[m] = UNI(__builtin_amdgcn_exp2f(lb2 * (float)m)); T.bb[m] = UNI(__builtin_amdgcn_exp2f(lb2 * (float)(8 * m))); }
    T.c32f = UNI(__builtin_amdgcn_exp2f(-lf2 * 32.f)); T.c32b = UNI(__builtin_amdgcn_exp2f(lb2 * 32.f));
    const int imin = irow0 + wid * QBLK;
    f32x16 o[4] = {}; bf16x8 qr[8];
    const bf16_t* Qw = Qb + (long)(wid * QBLK + r32) * LDQ + hi * 8;
#pragma unroll
    for (int d0 = 0; d0 < 8; ++d0) qr[d0] = *reinterpret_cast<const bf16x8*>(Qw + d0 * 16);
    const int irow = irow0 + wid * QBLK + r32;
    const int sr = tid >> 4, sc = (tid & 15) * 8, vst0 = v_st(sr, sc), vst1 = v_st(32 + sr, sc);
    const int vb0 = (int)(uintptr_t)V_lds + v_rd_base(lane);
    struct { bf16x8 vs0, vs1, ks0, ks1; } sr_[1];
#define SLOAD(i, k0) do { sr_[i].vs0 = *(const bf16x8*)(&Vh[(long)((k0) + sr) * LDV + sc]); sr_[i].vs1 = *(const bf16x8*)(&Vh[(long)((k0) + 32 + sr) * LDV + sc]); \
    sr_[i].ks0 = *(const bf16x8*)(&Kh[(long)((k0) + sr) * LDK + sc]); sr_[i].ks1 = *(const bf16x8*)(&Kh[(long)((k0) + 32 + sr) * LDK + sc]); } while (0)
#define SWRITE(b, i) do { *(bf16x8*)(V_lds + (b) * SHM_V + vst0) = sr_[i].vs0; *(bf16x8*)(V_lds + (b) * SHM_V + vst1) = sr_[i].vs1; const int kc = sc * 2; \
    *(bf16x8*)(K_lds + (b) * SHM_K + KSWZ(sr, kc)) = sr_[i].ks0; *(bf16x8*)(K_lds + (b) * SHM_K + KSWZ(32 + sr, kc)) = sr_[i].ks1; } while (0)
#define SWAIT() asm volatile("s_waitcnt vmcnt(0)" ::: "memory")
    f32x16 pA0, pA1, pB0, pB1; bf16x8 pa0, pa1, pa2, pa3;
    __syncthreads();
    SLOAD(0, 0); SWAIT(); SWRITE(0, 0); __syncthreads();
    qkt<8>(pA0, pA1, K_lds, K_lds, qr, r32, hi); decayP(pA0, pA1, 0, irow, imin, hi, lf2, lb2, T);
    SLOAD(0, KVBLK); SWAIT(); SWRITE(1, 0); __syncthreads();
    for (int j = 1; j + 1 < NT; j += 2) {
        SBAR(); qkt<8>(pB0, pB1, K_lds + SHM_K, K_lds, qr, r32, hi);
        pack_p(pA0, pA1, pa0, pa1, pa2, pa3); SBAR();
        SLOAD(0, (j + 1) * KVBLK); SBAR();
        pv_d0(o, vb0, pa0, pa1, pa2, pa3); decayP(pB0, pB1, j, irow, imin, hi, lf2, lb2, T);
        __syncthreads(); SWAIT(); SWRITE(0, 0);
        __syncthreads();
        SBAR(); qkt<8>(pA0, pA1, K_lds, K_lds, qr, r32, hi);
        pack_p(pB0, pB1, pa0, pa1, pa2, pa3); SBAR();
        SLOAD(0, (j + 2) * KVBLK); SBAR();
        pv_d0(o, vb0 + (int)SHM_V, pa0, pa1, pa2, pa3); decayP(pA0, pA1, j + 1, irow, imin, hi, lf2, lb2, T);
        __syncthreads(); SWAIT(); SWRITE(1, 0);
        __syncthreads();
    }
    SBAR(); qkt<8>(pB0, pB1, K_lds + SHM_K, K_lds, qr, r32, hi);
    pack_p(pA0, pA1, pa0, pa1, pa2, pa3); SBAR();
    pv_d0(o, vb0, pa0, pa1, pa2, pa3); decayP(pB0, pB1, NT - 1, irow, imin, hi, lf2, lb2, T);
    __syncthreads();
    pack_p(pB0, pB1, pa0, pa1, pa2, pa3); SBAR();
    pv_d0(o, vb0 + (int)SHM_V, pa0, pa1, pa2, pa3);
    bf16_t* Ow = Ob + (long)(wid * QBLK) * LDO; float* ssw = ssq + (long)(wid * QBLK) * 8;
    int hio = hi, r32o = r32; asm volatile("" : "+v"(Ow), "+v"(ssw), "+v"(hio), "+v"(r32o));
#pragma unroll
    for (int r = 0; r < 16; ++r) { const int orow = crow(r, hio);
        float s = 0.f;
#pragma unroll
        for (int d0 = 0; d0 < 4; ++d0) { s += o[d0][r] * o[d0][r]; Ow[(long)orow * LDO + d0 * 32 + r32o] = (bf16_t)(cvt_pk_bf16(o[d0][r], 0.f) & 0xffffu); }
#pragma unroll
        for (int x = 1; x < 32; x <<= 1) s += __shfl_xor(s, x);
        if (r32o == 0) ssw[(long)orow * 8] = s; }
#undef SLOAD
#undef SWRITE
#undef SWAIT
}
DI void decay32(f32x16& p0, int kt, int irow, int imin, int hi, float lf2, float lb2, const DecayTab& T) {
    if (kt < 8) {
        const float ff = (float)(irow + LC - kt * 32 - 4 * hi), fb = (float)(SEQ + kt * 32 + 4 * hi - irow);
#pragma unroll
        for (int r = 0; r < 16; ++r) { const float kf = (float)((r & 3) + 8 * (r >> 2)); p0[r] *= __builtin_amdgcn_exp2f(lf2 * (ff - kf)) + __builtin_amdgcn_exp2f(lb2 * (fb + kf)); }
    } else {
        const int j0 = (kt - 8) * 32; const float fd = (float)(irow - j0 - 4 * hi);
        if (j0 < imin) {
            const float A = __builtin_amdgcn_exp2f(lf2 * fd); float Ab[4];
#pragma unroll
            for (int q = 0; q < 4; ++q) Ab[q] = A * T.bf[q];
#pragma unroll
            for (int r = 0; r < 16; ++r) p0[r] *= Ab[r >> 2] * T.af[r & 3];
        } else if (j0 > imin) {
            const float A = __builtin_amdgcn_exp2f(-lb2 * fd); float Ab[4];
#pragma unroll
            for (int q = 0; q < 4; ++q) Ab[q] = A * T.bb[q];
#pragma unroll
            for (int r = 0; r < 16; ++r) p0[r] *= Ab[r >> 2] * T.ab[r & 3];
        } else {
#pragma unroll
            for (int r = 0; r < 16; ++r) { const float d0 = fd - (float)((r & 3) + 8 * (r >> 2));
                const float e0 = __builtin_amdgcn_exp2f(d0 >= 0.f ? lf2 * d0 : -lb2 * d0); p0[r] *= (d0 == 0.f) ? 2.f : e0; }
        }
    }
}
template <int D0> DI void pv32_one(f32x16& od, int vb, bf16x8 pa0, bf16x8 pa1) {
    const s16x4 l0 = tr_read<v_rd_off(D0, 0, 0)>(vb), h0 = tr_read<v_rd_off(D0, 0, 1)>(vb), l1 = tr_read<v_rd_off(D0, 1, 0)>(vb), h1 = tr_read<v_rd_off(D0, 1, 1)>(vb);
    asm volatile("s_waitcnt lgkmcnt(0)" ::: "memory"); SBAR();
#define PK(L, H) (bf16x8){L[0], L[1], L[2], L[3], H[0], H[1], H[2], H[3]}
    od = __builtin_amdgcn_mfma_f32_32x32x16_bf16(pa0, PK(l0, h0), od, 0, 0, 0);
    od = __builtin_amdgcn_mfma_f32_32x32x16_bf16(pa1, PK(l1, h1), od, 0, 0, 0);
#undef PK
}
DI void ret_body3(const bf16_t* __restrict__ Qb, const bf16_t* __restrict__ Kh, const bf16_t* __restrict__ Vh, bf16_t* __restrict__ Ob, float* __restrict__ ssq, int irow0, float lf2, float lb2, char* lds) {
    constexpr int LDQ = 1024, LDK = 1024, LDV = 2048, LDO = 2048, KB = 32, NT3 = TT / KB, VIMG = 8192, VBUF = 2 * VIMG, KBUF = 8192, OFFK3 = 2 * VBUF;
    int tid = threadIdx.x; asm volatile("" : "+v"(tid));
    const int wid = __builtin_amdgcn_readfirstlane(tid >> 6), lane = tid & 63, r32 = lane & 31, hi = lane >> 5;
    char* V_lds = lds; char* K_lds = lds + OFFK3;
    DecayTab T;
#pragma unroll
    for (int m = 0; m < 4; ++m) { T.af[m] = UNI(__builtin_amdgcn_exp2f(-lf2 * (float)m)); T.bf[m] = UNI(__builtin_amdgcn_exp2f(-lf2 * (float)(8 * m))); T.ab[m] = UNI(__builtin_amdgcn_exp2f(lb2 * (float)m)); T.bb[m] = UNI(__builtin_amdgcn_exp2f(lb2 * (float)(8 * m))); }
    T.c32f = 0.f; T.c32b = 0.f;
    const int imin = irow0 + wid * QBLK;
    f32x16 o[8] = {}; bf16x8 qr[8];
    const bf16_t* Qw = Qb + (long)(wid * QBLK + r32) * LDQ + hi * 8;
#pragma unroll
    for (int d0 = 0; d0 < 8; ++d0) qr[d0] = *reinterpret_cast<const bf16x8*>(Qw + d0 * 16);
    const int irow = irow0 + wid * QBLK + r32;
    const int sr = tid >> 4, sc = (tid & 15) * 8, vst0 = v_st(sr, sc), kst0 = KSWZ(sr, sc * 2);
    const int vb0 = (int)(uintptr_t)V_lds + v_rd_base(lane);
    bf16x8 vsa, vsb, ks;
#define SLOAD3(k0) do { vsa = *(const bf16x8*)(&Vh[(long)((k0) + sr) * LDV + sc]); vsb = *(const bf16x8*)(&Vh[(long)((k0) + sr) * LDV + 128 + sc]); ks = *(const bf16x8*)(&Kh[(long)((k0) + sr) * LDK + sc]); } while (0)
#define SWRITE3(b) do { *(bf16x8*)(V_lds + (b) * VBUF + vst0) = vsa; *(bf16x8*)(V_lds + (b) * VBUF + VIMG + vst0) = vsb; *(bf16x8*)(K_lds + (b) * KBUF + kst0) = ks; } while (0)
    f32x16 p0; bf16x8 pa0, pa1;
    __syncthreads();
    SLOAD3(0); asm volatile("s_waitcnt vmcnt(0)" ::: "memory"); SWRITE3(0); __syncthreads();
    for (int j = 0; j < NT3; ++j) {
        const int bsel = j & 1;
        if (j + 1 < NT3) SLOAD3((j + 1) * KB);
        SBAR();
        { const char* Ks = K_lds + bsel * KBUF; p0 = f32x16{};
#pragma unroll
          for (int d0 = 0; d0 < 8; ++d0) { const bf16x8 b0 = *reinterpret_cast<const bf16x8*>(Ks + KSWZ(r32, (d0 * 16 + hi * 8) * 2)); p0 = __builtin_amdgcn_mfma_f32_32x32x16_bf16(b0, qr[d0], p0, 0, 0, 0); } }
        decay32(p0, j, irow, imin, hi, lf2, lb2, T);
        {
#define PK4(P, BASE, OUT) do { unsigned a0 = cvt_pk_bf16(P[BASE + 0], P[BASE + 1]), a1 = cvt_pk_bf16(P[BASE + 2], P[BASE + 3]);   \
    unsigned b0 = cvt_pk_bf16(P[BASE + 4], P[BASE + 5]), b1 = cvt_pk_bf16(P[BASE + 6], P[BASE + 7]);                              \
    auto r0 = __builtin_amdgcn_permlane32_swap(a0, b0, false, false); auto r1 = __builtin_amdgcn_permlane32_swap(a1, b1, false, false); \
    u32x4 w = {r0[0], r1[0], r0[1], r1[1]}; OUT = *reinterpret_cast<bf16x8*>(&w); } while (0)
          PK4(p0, 0, pa0); PK4(p0, 8, pa1);
#undef PK4
        }
        SBAR();
        { const int vb = vb0 + bsel * VBUF;
          pv32_one<0>(o[0], vb, pa0, pa1); pv32_one<1>(o[1], vb, pa0, pa1); pv32_one<2>(o[2], vb, pa0, pa1); pv32_one<3>(o[3], vb, pa0, pa1);
          pv32_one<0>(o[4], vb + VIMG, pa0, pa1); pv32_one<1>(o[5], vb + VIMG, pa0, pa1); pv32_one<2>(o[6], vb + VIMG, pa0, pa1); pv32_one<3>(o[7], vb + VIMG, pa0, pa1); }
        if (j + 1 < NT3) { asm volatile("s_waitcnt vmcnt(0)" ::: "memory"); SWRITE3(bsel ^ 1); }
        __syncthreads();
    }
    bf16_t* Ow = Ob + (long)(wid * QBLK) * LDO; float* ssw = ssq + (long)(wid * QBLK) * 8;
    int hio = hi, r32o = r32; asm volatile("" : "+v"(Ow), "+v"(ssw), "+v"(hio), "+v"(r32o));
#pragma unroll
    for (int r = 0; r < 16; ++r) { const int orow = crow(r, hio);
        float s = 0.f;
#pragma unroll
        for (int d0 = 0; d0 < 8; ++d0) { s += o[d0][r] * o[d0][r]; Ow[(long)orow * LDO + d0 * 32 + r32o] = (bf16_t)(cvt_pk_bf16(o[d0][r], 0.f) & 0xffffu); }
#pragma unroll
        for (int x = 1; x < 32; x <<= 1) s += __shfl_xor(s, x);
        if (r32o == 0) ssw[(long)orow * 8] = s; }
#undef SLOAD3
#undef SWRITE3
}
}

DI int rope128perm(int vv) { const int wc = vv >> 5, fq = (vv >> 3) & 3, n = (vv >> 2) & 1, j = vv & 3; const int p = (wc * 4 + fq) * 4 + j; return (p >> 5) * 64 + n * 32 + (p & 31); }
DI int rope32perm(int vv) { const int fq = vv >> 3, n = (vv >> 2) & 1, j = vv & 3; return n * 16 + fq * 4 + j; }
DI int src_col(int mode, int v) {
    if (mode == 0) return v;
    if (mode == 1) {
        if (v < 1024) return (v & ~127) + rope128perm(v & 127);
        if (v < 3584) return v;
        if (v < 3840) { const int vv = v - 3584; return vv < 64 ? 3584 + (vv & ~31) + rope32perm(vv & 31) : -1; }
        if (v < 4864) { const int vv = v - 3840; return 3648 + (vv & ~127) + rope128perm(vv & 127); }
        return v - 192;
    }
    if (mode == 3) { const int pn = v >> 8, bj = (v >> 7) & 1, i = v & 127; return (bj ? FFN : 0) + pn * 128 + i; }
    const int g = v >> 5, gi = g % 6; return gi < 4 ? v : (v & ~31) + rope32perm(v & 31);
}
DI void conv_weight(const float* __restrict__ W, int ldw, bf16_t* __restrict__ Bt, int K, int N, int mode, const float* __restrict__ kscale, int rot, unsigned* lds32) {
    int tid = threadIdx.x; asm volatile("" : "+v"(tid));
    const int G = gridDim.x, nkt = K / 128, ntiles = (N / 128) * nkt;
    for (int t = (int)((blockIdx.x + G - (rot % G)) % G); t < ntiles; t += G) {
        const int n0 = (t / nkt) * 128, k0 = (t % nkt) * 128;
        { const int nn = tid & 127, kq = tid >> 7; const int scol = src_col(mode, n0 + nn);
#pragma unroll 4
          for (int i = 0; i < 16; ++i) { const int kp = kq + 4 * i, k = k0 + 2 * kp; float a = 0.f, b = 0.f;
              if (scol >= 0) { a = W[(size_t)k * ldw + scol]; b = W[(size_t)(k + 1) * ldw + scol]; }
              if (kscale) { a *= kscale[k]; b *= kscale[k + 1]; }
              lds32[nn * 68 + kp] = cvt_pk_bf16(a, b); } }
        __syncthreads();
        { const int n = tid >> 2, seg = tid & 3;
#pragma unroll
          for (int q = 0; q < 4; ++q) { const u32x4 w = *(const u32x4*)(lds32 + n * 68 + seg * 16 + q * 4); *(u32x4*)(Bt + (size_t)(n0 + n) * K + k0 + seg * 32 + q * 8) = w; } }
        __syncthreads();
    }
}

template <int MODE>
DI void rows_norm(const Params& p, const float* mod) {
    int tid = threadIdx.x; asm volatile("" : "+v"(tid));
    const int lane = tid & 63, gw = blockIdx.x * 8 + (tid >> 6), nw = gridDim.x * 8;
    const int nrows = MODE == 0 ? MROWS : SROWS; const int per = (nrows + nw - 1) / nw;
    float sc[32], sh[32]; int cur = -1;
    if (MODE == 2) {
#pragma unroll
        for (int i = 0; i < 8; ++i) { const f32x4 w = *(const f32x4*)(p.final_norm + i * 256 + lane * 4); sc[i * 4] = w[0]; sc[i * 4 + 1] = w[1]; sc[i * 4 + 2] = w[2]; sc[i * 4 + 3] = w[3]; }
    }
    for (int row = gw * per; row < (gw + 1) * per && row < nrows; ++row) {
        const float* src; int mr;
        if (MODE == 0) { const int b = row / TT, t = row % TT; if (t < LC) { src = p.ctx + ((size_t)b * LC + t) * DM; mr = 8; } else { src = p.x + ((size_t)b * SEQ + t - LC) * DM; mr = b; } }
        else { src = p.out + (size_t)row * DM; mr = row / SEQ; }
        if (MODE != 2 && mr != cur) { cur = mr; const int csh = MODE == 0 ? 0 : 3, csc = csh + 1;
#pragma unroll
            for (int i = 0; i < 8; ++i) { const int c = i * 256 + lane * 4;
                const f32x4 a = *(const f32x4*)(mod + mr * 12288 + csc * 2048 + c) + *(const f32x4*)(p.b_ada + csc * 2048 + c);
                const f32x4 s = *(const f32x4*)(mod + mr * 12288 + csh * 2048 + c) + *(const f32x4*)(p.b_ada + csh * 2048 + c);
#pragma unroll
                for (int j = 0; j < 4; ++j) { sc[i * 4 + j] = 1.f + a[j]; sh[i * 4 + j] = s[j]; } } }
        f32x4 v[8]; float ss = 0.f;
#pragma unroll
        for (int i = 0; i < 8; ++i) { v[i] = *(const f32x4*)(src + i * 256 + lane * 4); ss += v[i][0] * v[i][0] + v[i][1] * v[i][1] + v[i][2] * v[i][2] + v[i][3] * v[i][3]; }
        ss = wave_sum(ss); float rstd = __builtin_amdgcn_rsqf(ss * (1.f / DM) + EPS);
#if MK_DEBUG
        if (MODE == 2) { const float* dbg = (const float*)(p.ws + WS_DBG); int first = -1; for (int k = 15; k >= 0; --k) if (dbg[k] > 0.08f) first = k; rstd *= 1.f + 0.1f * (float)(first + 1); }
#endif
        if (MODE == 2) {
#pragma unroll
            for (int i = 0; i < 8; ++i) { f32x4 o; o[0] = v[i][0] * rstd * sc[i * 4]; o[1] = v[i][1] * rstd * sc[i * 4 + 1]; o[2] = v[i][2] * rstd * sc[i * 4 + 2]; o[3] = v[i][3] * rstd * sc[i * 4 + 3];
                *(f32x4*)(p.out + (size_t)row * DM + i * 256 + lane * 4) = o; }
        } else {
            bf16_t* dst = (bf16_t*)(p.ws + (MODE == 0 ? WS_HBUF : WS_H2)) + (size_t)row * DM;
#pragma unroll
            for (int i = 0; i < 8; ++i) { u32x2 w; w.x = cvt_pk_bf16(v[i][0] * rstd * sc[i * 4] + sh[i * 4], v[i][1] * rstd * sc[i * 4 + 1] + sh[i * 4 + 1]);
                w.y = cvt_pk_bf16(v[i][2] * rstd * sc[i * 4 + 2] + sh[i * 4 + 2], v[i][3] * rstd * sc[i * 4 + 3] + sh[i * 4 + 3]);
                *(u32x2*)(dst + i * 256 + lane * 4) = w; }
        }
    }
}


#if MK_DEBUG
DI unsigned hsh(unsigned x) { x ^= x >> 16; x *= 0x7feb352dU; x ^= x >> 15; x *= 0x846ca68bU; x ^= x >> 16; return x; }
DI void dbg_report(float* dbg, int k, float err) { if ((threadIdx.x & 63) == 0) atomicMax((int*)dbg + k, __float_as_int(fabsf(err))); }
DI float bfr(float x) { return bf_lo(cvt_pk_bf16(x, 0.f)); }
DI float bfv(const bf16_t* p, size_t i) { return __uint_as_float(((unsigned)p[i]) << 16); }
DI int samp_s(int si) { const int q = (si >> 3) & 7; return si < 64 ? (q == 0 ? 0 : q == 1 ? 1 : q == 2 ? 63 : q == 3 ? 64 : q == 4 ? 255 : q == 5 ? 256 : q == 6 ? 1024 : 2047) : (int)(hsh(si * 77 + 5) & 2047); }
DI float relerr(float ref, float got, float floor_) { return fabsf(ref - got) / (fabsf(ref) + floor_); }
DI float wdot(const bf16_t* A, int K, const float* W, int ldw, int col, const float* ks) {
    const int lane = threadIdx.x & 63; float a = 0.f;
    for (int k = lane; k < K; k += 64) a += bfv(A, k) * bfr(W[(size_t)k * ldw + col] * (ks ? ks[k] : 1.f));
    return wave_sum(a);
}
DI void rope_ref(float t1, float t2, float pos, int f, float q4, bool on, float& o1, float& o2) {
    const float ang = pos * __builtin_amdgcn_exp2f(-(float)f * 13.287712379549449f / q4); const float c = on ? __cosf(ang) : 1.f, sn = on ? __sinf(ang) : 0.f;
    o1 = t1 * c - t2 * sn; o2 = t2 * c + t1 * sn;
}
__global__ __launch_bounds__(512) void dbg_kernel(Params p, int ph) {
    const int bid = blockIdx.x;
    unsigned char* ws = p.ws; float* dbg = (float*)(ws + WS_DBG); const float* mod = (const float*)(ws + WS_MOD);
    float* sav = (float*)(ws + 655360);
    const int lane = threadIdx.x & 63, wid = threadIdx.x >> 6;
    for (int rnd = 0; rnd < 9; ++rnd) {
    const int si = rnd * 2048 + bid * 8 + wid;
    const unsigned hh = hsh(si * 2654435761u + ph * 97u);
    const bool okS = si < SROWS;
    const int b = (si >> 11) & 7, s = si & 2047;
    const int bT = si / TT, t = si % TT;
    if (ph == 1 && rnd == 0) {
        for (int q = 0; q < 54; ++q) { const int e = (si * 54 + q); if (e < 9 * 12288) { const int r = e / 12288, n = e % 12288; float a = 0.f;
            for (int k = lane; k < 2048; k += 64) { const float xv = r < 8 ? p.c[r * 2048 + k] : p.c_ctx[k]; a += xv / (1.f + expf(-xv)) * p.w_ada[(size_t)k * 12288 + n]; }
            a = wave_sum(a); dbg_report(dbg, 0, relerr(a, mod[r * 12288 + n], 0.05f)); } }
    }
    if (ph == 2 || (ph == 9 && okS)) {
        const bool isH = ph == 2;
        const float* src; int mr; size_t drow; const bf16_t* dst;
        if (isH) { if (t < LC) { src = p.ctx + ((size_t)bT * LC + t) * DM; mr = 8; } else { src = p.x + ((size_t)bT * SEQ + t - LC) * DM; mr = bT; } drow = (size_t)si; dst = (const bf16_t*)(ws + WS_HBUF); }
        else { src = p.out + (size_t)si * DM; mr = b; drow = (size_t)si; dst = (const bf16_t*)(ws + WS_H2); }
        float ss = 0.f; for (int k = lane; k < DM; k += 64) ss += src[k] * src[k]; ss = wave_sum(ss); const float rstd = 1.f / sqrtf(ss / DM + EPS);
        const int csh = isH ? 0 : 3, csc = csh + 1; float e = 0.f;
        for (int k = lane; k < DM; k += 64) { const float ref = src[k] * rstd * (1.f + mod[mr * 12288 + csc * 2048 + k] + p.b_ada[csc * 2048 + k]) + mod[mr * 12288 + csh * 2048 + k] + p.b_ada[csh * 2048 + k];
            e = fmaxf(e, relerr(ref, bfv(dst, drow * DM + k), 1.f)); }
        for (int o = 32; o > 0; o >>= 1) e = fmaxf(e, __shfl_xor(e, o));
        dbg_report(dbg, isH ? 1 : 8, e);
    }
    if (ph == 3) {
      for (int rep = 0; rep < 2; ++rep) {
        const unsigned hr = hsh(hh + rep * 1234567u);
        const bool latent = t >= LC; const int seg = latent ? (int)((hr >> 8) % 9u) : (int)((hr >> 8) % 4u);
        const size_t trow = (size_t)si, srow = (size_t)bT * SEQ + (t - LC); const int sp = t - LC;
        const bf16_t* hrow = (const bf16_t*)(ws + WS_HBUF) + trow * DM; const unsigned h2 = hsh(hr);
        float e = 0.f;
        if (seg == 0 || seg == 4) { const int head = h2 & 7, half = (h2 >> 3) & 1, f = (h2 >> 4) & 31, base = (seg == 0 ? 0 : 3648) + head * 128 + half * 64 + f;
            const float t1 = wdot(hrow, DM, p.w_in, INCOLS, base, nullptr), t2 = wdot(hrow, DM, p.w_in, INCOLS, base + 32, nullptr); float o1, o2;
            rope_ref(t1, t2, (float)(half ? (sp & 63) : (sp >> 6)), f, 32.f, latent, o1, o2); const float sc = seg == 0 ? 0.08838834764831845f : 1.f;
            const bf16_t* dst = seg == 0 ? (const bf16_t*)(ws + WS_RK) + trow * 1024 : (const bf16_t*)(ws + WS_RQ) + srow * 1024; const int dc = head * 128 + half * 64 + f;
            e = fmaxf(relerr(o1 * sc, bfv(dst, dc), 0.05f * sc), relerr(o2 * sc, bfv(dst, dc + 32), 0.05f * sc)); }
        else if (seg == 3) { const int g = h2 & 1, f = (h2 >> 1) & 15, base = 3584 + g * 32 + f;
            const float t1 = wdot(hrow, DM, p.w_in, INCOLS, base, nullptr), t2 = wdot(hrow, DM, p.w_in, INCOLS, base + 16, nullptr); float o1, o2;
            rope_ref(t1, t2, (float)(g ? (sp & 63) : (sp >> 6)), f, 16.f, latent, o1, o2); const bf16_t* dst = (const bf16_t*)(ws + WS_KR) + trow * 64 + g * 32 + f;
            e = fmaxf(relerr(o1, bfv(dst, 0), 0.05f), relerr(o2, bfv(dst, 16), 0.05f)); }
        else { int oc, dc; const bf16_t* dst; size_t ld; size_t row; int act = 0;
            if (seg == 1) { dc = h2 % 2048u; oc = 1024 + dc; dst = (const bf16_t*)(ws + WS_RV); ld = 2048; row = trow; }
            else if (seg == 2) { dc = h2 % 512u; oc = 3072 + dc; dst = (const bf16_t*)(ws + WS_KVD); ld = 512; row = trow; }
            else if (seg == 5) { dc = h2 % 2048u; oc = 4672 + dc; dst = (const bf16_t*)(ws + WS_RG); ld = 2048; row = srow; act = 1; }
            else if (seg == 6) { dc = h2 % 512u; oc = 6720 + dc; dst = (const bf16_t*)(ws + WS_QD); ld = 512; row = srow; }
            else if (seg == 7) { dc = h2 % 2048u; oc = 7232 + dc; dst = (const bf16_t*)p.out; ld = 2048; row = srow; act = 2; }
            else { dc = h2 % 2048u; oc = 9280 + dc; dst = (const bf16_t*)p.out + (size_t)SROWS * 2048; ld = 2048; row = srow; act = 2; }
            float z = wdot(hrow, DM, p.w_in, INCOLS, oc, nullptr); if (act == 1) z = z / (1.f + expf(-z)); if (act == 2) z = 1.f / (1.f + expf(-z));
            e = relerr(z, bfv(dst, row * ld + dc), 0.05f); }
        dbg_report(dbg, 16 + seg + (latent ? 0 : 9), e);
        if (seg == 7 && latent && e > 0.08f && lane == 0) { atomicAdd((int*)dbg + 40, 1); atomicMax((int*)dbg + 41, 1000 - (int)(srow >> 8)); atomicMax((int*)dbg + 42, (int)(srow >> 8)); }
      }
    }
    if (ph == 4 && okS) {
        const int h = (hh >> 4) & 7, ecol = (hh >> 8) & 255; const size_t srow = (size_t)si;
        const bf16_t* q = (const bf16_t*)(ws + WS_RQ) + srow * 1024 + h * 128; const bf16_t* K = (const bf16_t*)(ws + WS_RK) + (size_t)b * TT * 1024 + h * 128; const bf16_t* V = (const bf16_t*)(ws + WS_RV) + (size_t)b * TT * 2048 + h * 256 + ecol;
        const float xf = p.dec_f[h], xb = p.dec_b[h]; const float lf = fminf(xf, 0.f) - log1pf(expf(-fabsf(xf))), lb = fminf(xb, 0.f) - log1pf(expf(-fabsf(xb)));
        float acc = 0.f, nrm = 0.f;
        for (int tt = lane; tt < TT; tt += 64) { float d = 0.f; for (int k = 0; k < 128; ++k) d += bfv(q, k) * bfv(K, (size_t)tt * 1024 + k);
            float w; if (tt < LC) w = expf(lf * (float)(s + LC - tt)) + expf(lb * (float)(SEQ + tt - s)); else { const int j = tt - LC; w = j < s ? expf(lf * (float)(s - j)) : j > s ? expf(lb * (float)(j - s)) : 2.f; }
            const float term = w * d * bfv(V, (size_t)tt * 2048); acc += term; nrm += term * term; }
        acc = wave_sum(acc); nrm = wave_sum(nrm);
        dbg_report(dbg, 3, fabsf(acc - bfv((const bf16_t*)(ws + WS_ORET), srow * 2048 + h * 256 + ecol)) / (fabsf(acc) + 0.25f * sqrtf(nrm) + 1e-6f));
        const bf16_t* o = (const bf16_t*)(ws + WS_ORET) + srow * 2048 + h * 256;
        float ss = 0.f; for (int k = lane; k < 256; k += 64) ss += bfv(o, k) * bfv(o, k); ss = wave_sum(ss);
        const float ref = bfv(o, ecol) / sqrtf(ss / 256.f + EPS) * p.ret_gn[h * 256 + ecol] * bfv((const bf16_t*)(ws + WS_RG), srow * 2048 + h * 256 + ecol);
        if (lane == 0) sav[si] = ref;
    }
    if (ph == 5) {
        if (okS) { const size_t srow = (size_t)si; const bf16_t* qd = (const bf16_t*)(ws + WS_QD) + srow * 512; float ss = 0.f; for (int k = lane; k < 512; k += 64) ss += bfv(qd, k) * bfv(qd, k); ss = wave_sum(ss); const float rstd = 1.f / sqrtf(ss / 512.f + EPS);
            const int head = (hh >> 4) & 15; const bf16_t* dst = (const bf16_t*)(ws + WS_QM) + srow * 3072 + head * 192; float e;
            if (hh & 1) { const int d = (hh >> 8) & 127; e = relerr(rstd * wdot(qd, 512, p.w_q_up, 3072, head * 192 + d, p.q_norm), bfv(dst, d), 0.05f); }
            else { const int g = (hh >> 8) & 1, f = (hh >> 9) & 15, base = head * 192 + 128 + g * 32 + f; float o1, o2;
                rope_ref(rstd * wdot(qd, 512, p.w_q_up, 3072, base, p.q_norm), rstd * wdot(qd, 512, p.w_q_up, 3072, base + 16, p.q_norm), (float)(g ? (s & 63) : (s >> 6)), f, 16.f, true, o1, o2);
                e = fmaxf(relerr(o1, bfv(dst, 128 + g * 32 + f), 0.05f), relerr(o2, bfv(dst, 128 + g * 32 + 16 + f), 0.05f)); }
            dbg_report(dbg, 4, e);
            const unsigned h4 = hsh(si * 2654435761u + 4 * 97u); const int hq = (h4 >> 4) & 7, eq = (h4 >> 8) & 255;
            dbg_report(dbg, 10, relerr(sav[si], bfv((const bf16_t*)(ws + WS_ORET), srow * 2048 + hq * 256 + eq), 0.03f)); }
        { const size_t trow = (size_t)si; const bf16_t* kd = (const bf16_t*)(ws + WS_KVD) + trow * 512; float ss = 0.f; for (int k = lane; k < 512; k += 64) ss += bfv(kd, k) * bfv(kd, k); ss = wave_sum(ss); const float rstd = 1.f / sqrtf(ss / 512.f + EPS);
            const int c = (hh >> 14) & 4095; dbg_report(dbg, 4, relerr(rstd * wdot(kd, 512, p.w_kv_up, 4096, c, p.kv_norm), bfv((const bf16_t*)(ws + WS_KVUP), trow * 4096 + c), 0.05f)); }
    }
    if (ph == 6 && okS) {
        const int h = (hh >> 4) & 15, ecol = (hh >> 8) & 127; const size_t srow = (size_t)si;
        const bf16_t* q = (const bf16_t*)(ws + WS_QM) + srow * 3072 + h * 192; const bf16_t* KV = (const bf16_t*)(ws + WS_KVUP) + (size_t)b * TT * 4096 + h * 256; const bf16_t* KR = (const bf16_t*)(ws + WS_KR) + (size_t)b * TT * 64;
        float mx = -1e30f;
        for (int i = 0; i < 36; ++i) { const int tt = lane + 64 * i; float d = 0.f; for (int k = 0; k < 128; ++k) d += bfv(q, k) * bfv(KV, (size_t)tt * 4096 + k); for (int k = 0; k < 64; ++k) d += bfv(q, 128 + k) * bfv(KR, (size_t)tt * 64 + k);
            mx = fmaxf(mx, d * 0.07216878364870322f); }
        for (int o = 32; o > 0; o >>= 1) mx = fmaxf(mx, __shfl_xor(mx, o));
        float l = 0.f, acc = 0.f;
        for (int i = 0; i < 36; ++i) { const int tt = lane + 64 * i; float d = 0.f; for (int k = 0; k < 128; ++k) d += bfv(q, k) * bfv(KV, (size_t)tt * 4096 + k); for (int k = 0; k < 64; ++k) d += bfv(q, 128 + k) * bfv(KR, (size_t)tt * 64 + k);
            const float pe = expf(d * 0.07216878364870322f - mx); l += pe; acc += pe * bfv(KV, (size_t)tt * 4096 + 128 + ecol); }
        l = wave_sum(l); acc = wave_sum(acc);
        dbg_report(dbg, 5, relerr(acc / l, bfv((const bf16_t*)(ws + WS_MLAO), srow * 2048 + h * 128 + ecol), 0.02f));
    }
    if (ph == 7 && okS) {
        const size_t srow = (size_t)si; const int c = (hh >> 4) & 2047;
        const float r1 = wdot((const bf16_t*)(ws + WS_ORET) + srow * 2048, 2048, p.w_ret_o, 2048, c, nullptr), r2 = wdot((const bf16_t*)(ws + WS_MLAO) + srow * 2048, 2048, p.w_mla_o, 2048, c, nullptr);
        const float ref = bfv((const bf16_t*)p.out, srow * 2048 + c) * r1 + bfv((const bf16_t*)p.out + (size_t)SROWS * 2048, srow * 2048 + c) * r2;
        dbg_report(dbg, 6, relerr(ref, bfv((const bf16_t*)(ws + WS_MIXED), srow * 2048 + c), 0.03f));
    }
    if (ph == 8 && okS) {
        const size_t srow = (size_t)si; const int c = (hh >> 4) & 2047;
        const float r = wdot((const bf16_t*)(ws + WS_MIXED) + srow * 2048, 2048, p.w_out, 2048, c, nullptr);
        const float refd = (mod[b * 12288 + 2 * 2048 + c] + p.b_ada[2 * 2048 + c]) * r;
        dbg_report(dbg, 7, relerr(refd, p.out[srow * 2048 + c] - p.x[srow * 2048 + c], 0.01f));
    }
    if (ph == 10 && okS) {
        const size_t srow = (size_t)si; const int c = (int)((hh >> 4) % 11264u);
        const float r = wdot((const bf16_t*)(ws + WS_H2) + srow * 2048, 2048, p.w_up, 2 * FFN, c, nullptr);
        const float got = c < FFN ? bfv((const bf16_t*)(ws + WS_ABUF), srow * FFN + c) : bfv((const bf16_t*)(ws + WS_VBUF), srow * FFN + c - FFN);
        dbg_report(dbg, 9, relerr(r, got, 0.05f));
        const int cu = (int)((hh >> 8) % 5632u); const bf16_t* ab = (const bf16_t*)(ws + WS_ABUF);
        const float am = s > 0 ? bfv(ab, (srow - 1) * FFN + cu) : 0.f, a0 = bfv(ab, srow * FFN + cu), ap = s < SEQ - 1 ? bfv(ab, (srow + 1) * FFN + cu) : 0.f;
        const float z = p.conv_b[cu] + p.conv_w[cu] * am + p.conv_w[FFN + cu] * a0 + p.conv_w[2 * FFN + cu] * ap;
        if (lane == 0) sav[16384 + si] = z / (1.f + expf(-z)) * bfv((const bf16_t*)(ws + WS_VBUF), srow * FFN + cu);
    }
    if (ph == 11 && okS) {
        const size_t srow = (size_t)si; const unsigned h10 = hsh(si * 2654435761u + 10 * 97u); const int c10 = (int)((h10 >> 8) % 5632u);
        dbg_report(dbg, 11, relerr(sav[16384 + si], bfv((const bf16_t*)(ws + WS_VBUF), srow * FFN + c10), 0.03f));
        const int c = (hh >> 4) & 2047; const float r = wdot((const bf16_t*)(ws + WS_VBUF) + srow * FFN, FFN, p.w_down, 2048, c, nullptr);
        if (lane == 0) { sav[2 * 16384 + si] = (mod[b * 12288 + 5 * 2048 + c] + p.b_ada[5 * 2048 + c]) * r; sav[3 * 16384 + si] = p.out[srow * 2048 + c]; }
    }
    if (ph == 12 && okS) {
        const size_t srow = (size_t)si; const unsigned h11 = hsh(si * 2654435761u + 11 * 97u); const int c11 = (h11 >> 4) & 2047;
        dbg_report(dbg, 12, relerr(sav[2 * 16384 + si], p.out[srow * 2048 + c11] - sav[3 * 16384 + si], 0.02f));
        const float* xr = p.out + srow * 2048; float ss = 0.f; for (int k = lane; k < DM; k += 64) ss += xr[k] * xr[k]; ss = wave_sum(ss);
        (void)ss;
        dbg_report(dbg, 14, 1.0f);
    }
    }
}
#endif

__global__ __launch_bounds__(512, 2) void fwd_megakernel(Params p) {
    extern __shared__ __attribute__((aligned(16))) unsigned char shm[];
    LAS unsigned char* lds = (LAS unsigned char*)shm;
    unsigned char* ws = p.ws;
    const int G = gridDim.x;
    float* mod = (float*)(ws + WS_MOD); float* ssq_kv = (float*)(ws + WS_SSQKV); float* ssq_q = (float*)(ws + WS_SSQQ); float* ssq_ret = (float*)(ws + WS_SSQRET);
    volatile LAS unsigned* xst = (volatile LAS unsigned*)(lds + pg8::STAGE_BYTES);
    if (threadIdx.x < 2) xst[threadIdx.x] = 0u;
    __syncthreads();
    const XcdBarrier xb = xcd_barrier_post((unsigned*)(ws + WS_BAR), xst);
    for (int ph = p.ph_lo; ph < p.ph_hi; ++ph) {
        if (ph > p.ph_lo) { if (ph > 1000) cg::this_grid().sync(); else xcd_barrier(xb); }
        for (int rep = 0; rep < (ph == MK_REP ? 2 : 1); ++rep) {
        int bid = blockIdx.x; asm volatile("" : "+s"(bid));
#define LOCAL_TID int tid = threadIdx.x; asm volatile("" : "+v"(tid))
        switch (ph) {
        case 0: if (PH_ON(0)) {
            unsigned* l32 = (unsigned*)shm; int rot = 0;
            conv_weight(p.w_in, INCOLS, (bf16_t*)(ws + WS_WIN), 2048, NIN, 1, nullptr, rot, l32); rot += (NIN / 128) * 16;
            conv_weight(p.w_q_up, 3072, (bf16_t*)(ws + WS_WQUP), 512, 3072, 2, p.q_norm, rot, l32); rot += 24 * 4;
            conv_weight(p.w_kv_up, 4096, (bf16_t*)(ws + WS_WKVUP), 512, 4096, 0, p.kv_norm, rot, l32); rot += 32 * 4;
            conv_weight(p.w_ret_o, 2048, (bf16_t*)(ws + WS_WRETO), 2048, 2048, 0, nullptr, rot, l32); rot += 256;
            conv_weight(p.w_mla_o, 2048, (bf16_t*)(ws + WS_WMLAO), 2048, 2048, 0, nullptr, rot, l32); rot += 256;
            conv_weight(p.w_out, 2048, (bf16_t*)(ws + WS_WOUT), 2048, 2048, 0, nullptr, rot, l32);
            float* sl = (float*)shm;
            LOCAL_TID;
            for (int it = bid; it < 768; it += G) {
                const int k0 = (it / 24) * 64, n = (it % 24) * 512 + tid;
                __syncthreads();
                for (int e = tid; e < 576; e += 512) { const int r = e >> 6, kk = e & 63; const float xv = r < 8 ? p.c[r * 2048 + k0 + kk] : p.c_ctx[k0 + kk]; sl[e] = siluf_(xv); }
                __syncthreads();
                float a[9];
#pragma unroll
                for (int r = 0; r < 9; ++r) a[r] = 0.f;
#pragma unroll 8
                for (int kk = 0; kk < 64; ++kk) { const float w = p.w_ada[(size_t)(k0 + kk) * 12288 + n];
#pragma unroll
                    for (int r = 0; r < 9; ++r) a[r] += sl[r * 64 + kk] * w; }
#pragma unroll
                for (int r = 0; r < 9; ++r) atomicAdd(mod + r * 12288 + n, a[r]);
            }
        } break;
        case 1: if (PH_ON(1)) rows_norm<0>(p, mod); break;
        case 2: if (PH_ON(2)) {
            pg8::Gemm g{(const bf16_t*)(ws + WS_HBUF), (const bf16_t*)(ws + WS_WIN), 2048};
            pg8::Sched<2> S{0, 0, G, bid};
            EpiInProj E{(bf16_t*)(ws + WS_RK), (bf16_t*)(ws + WS_RV), (bf16_t*)(ws + WS_KVD), (bf16_t*)(ws + WS_KR), (bf16_t*)(ws + WS_RQ), (bf16_t*)(ws + WS_RG), (bf16_t*)(ws + WS_QD),
                        (bf16_t*)p.out, (bf16_t*)p.out + (size_t)SROWS * 2048, ssq_kv, ssq_q, (bf16_t*)(ws + WS_ORET)};
            pg8::gemm_phase(lds, g, S, E);
        } break;
        case 3: if (PH_ON(3)) {
            const bf16_t* rq = (const bf16_t*)(ws + WS_RQ); const bf16_t* rk = (const bf16_t*)(ws + WS_RK); const bf16_t* rv = (const bf16_t*)(ws + WS_RV); bf16_t* oret = (bf16_t*)(ws + WS_ORET);
            for (int it = bid; it < 512; it += G) {
                const int qb = it & 7, h = (it >> 3) & 7, b = it >> 6;
                const float xf = p.dec_f[h], xb = p.dec_b[h];
                const float lf2 = (fminf(xf, 0.f) - log1pf(__expf(-fabsf(xf)))) * 1.4426950408889634f, lb2 = (fminf(xb, 0.f) - log1pf(__expf(-fabsf(xb)))) * 1.4426950408889634f;
                const size_t srow0 = (size_t)b * SEQ + qb * 256, trow0 = (size_t)b * TT;
                att::ret_body3(rq + srow0 * 1024 + h * 128, rk + trow0 * 1024 + h * 128, rv + trow0 * 2048 + h * 256, oret + srow0 * 2048 + h * 256,
                               ssq_ret + srow0 * 8 + h, qb * 256, lf2, lb2, (char*)shm);
            }
        } break;
        case 4: if (PH_ON(4)) {
            { LOCAL_TID; bf16_t* oret = (bf16_t*)(ws + WS_ORET); const bf16_t* rg = (const bf16_t*)(ws + WS_RG);
              for (size_t i = (size_t)bid * 512 + tid; i < (size_t)SROWS * 256; i += (size_t)G * 512) {
                  const size_t r = i >> 8; const int col = (int)(i & 255) * 8, h = col >> 8;
                  const float rs = __builtin_amdgcn_rsqf(ssq_ret[r * 8 + h] * (1.f / 256.f) + EPS);
                  const u32x4 o = *(const u32x4*)(oret + r * 2048 + col), g = *(const u32x4*)(rg + r * 2048 + col);
                  const f32x4 n0 = *(const f32x4*)(p.ret_gn + col), n1 = *(const f32x4*)(p.ret_gn + col + 4);
                  u32x4 w; w.x = cvt_pk_bf16(bf_lo(o.x) * rs * n0[0] * bf_lo(g.x), bf_hi(o.x) * rs * n0[1] * bf_hi(g.x)); w.y = cvt_pk_bf16(bf_lo(o.y) * rs * n0[2] * bf_lo(g.y), bf_hi(o.y) * rs * n0[3] * bf_hi(g.y));
                  w.z = cvt_pk_bf16(bf_lo(o.z) * rs * n1[0] * bf_lo(g.z), bf_hi(o.z) * rs * n1[1] * bf_hi(g.z)); w.w = cvt_pk_bf16(bf_lo(o.w) * rs * n1[2] * bf_lo(g.w), bf_hi(o.w) * rs * n1[3] * bf_hi(g.w));
                  *(u32x4*)(oret + r * 2048 + col) = w; } }
            __syncthreads();
            { pg8::Gemm g{(const bf16_t*)(ws + WS_QD), (const bf16_t*)(ws + WS_WQUP), 512}; pg8::Sched<0> S{64, 12, G, bid}; EpiQup E{(bf16_t*)(ws + WS_QM), ssq_q}; pg8::gemm_phase(lds, g, S, E); }
            __syncthreads();
            { pg8::Gemm g{(const bf16_t*)(ws + WS_KVD), (const bf16_t*)(ws + WS_WKVUP), 512}; pg8::Sched<0> S{72, 16, G, (bid + 128) % G}; EpiKvup E{(bf16_t*)(ws + WS_KVUP), ssq_kv}; pg8::gemm_phase(lds, g, S, E); }
        } break;
        case 5: if (PH_ON(5)) {
            conv_weight(p.w_up, 2 * FFN, (bf16_t*)(ws + WS_WUP), 2048, 2 * FFN, 3, nullptr, 0, (unsigned*)shm);
            const bf16_t* qm = (const bf16_t*)(ws + WS_QM); const bf16_t* kvup = (const bf16_t*)(ws + WS_KVUP); const bf16_t* kr = (const bf16_t*)(ws + WS_KR); bf16_t* mo = (bf16_t*)(ws + WS_MLAO);
            for (int it = bid; it < 1024; it += G) {
                const int qb = it & 7, h = (it >> 3) & 15, b = it >> 7;
                const size_t srow0 = (size_t)b * SEQ + qb * 256, trow0 = (size_t)b * TT;
                att::mla_body(qm + srow0 * 3072 + h * 192, kvup + trow0 * 4096 + h * 256, kvup + trow0 * 4096 + h * 256 + 128, kr + trow0 * 64, mo + srow0 * 2048 + h * 128, (char*)shm);
            }
        } break;
        case 6: if (PH_ON(6)) {
            const bf16_t* gr = (const bf16_t*)p.out; const bf16_t* gm = gr + (size_t)SROWS * 2048;
            pg8::Gemm g{(const bf16_t*)(ws + WS_ORET), (const bf16_t*)(ws + WS_WRETO), 2048, (const bf16_t*)(ws + WS_MLAO), (const bf16_t*)(ws + WS_WMLAO)}; pg8::Sched<0> S{64, 8, G, bid}; EpiDual E{gr, gm, (bf16_t*)(ws + WS_MIXED)}; pg8::gemm_phase(lds, g, S, E);
        } break;
        case 7: if (PH_ON(7)) {
            pg8::Gemm g{(const bf16_t*)(ws + WS_MIXED), (const bf16_t*)(ws + WS_WOUT), 2048}; pg8::Sched<0> S{64, 8, G, bid}; EpiResid E{p.x, p.out, mod, p.b_ada, 2, 1.f}; pg8::gemm_phase(lds, g, S, E);
        } break;
        case 8: if (PH_ON(8)) rows_norm<1>(p, mod); break;
        case 9: if (PH_ON(9)) {
            pg8::Gemm g{(const bf16_t*)(ws + WS_H2), (const bf16_t*)(ws + WS_WUP), 2048}; pg8::Sched<0> S{64, 44, G, bid}; EpiUp E{(bf16_t*)(ws + WS_VBUF), (bf16_t*)(ws + WS_ASIDE), (bf16_t*)(ws + WS_VSIDE), p.conv_w, p.conv_b}; pg8::gemm_phase(lds, g, S, E);
        } break;
        case 10: if (PH_ON(10)) {
            conv_weight(p.w_down, 2048, (bf16_t*)(ws + WS_WDOWN), FFN, 2048, 0, nullptr, 0, (unsigned*)shm);
            const bf16_t* as_ = (const bf16_t*)(ws + WS_ASIDE); const bf16_t* vs_ = (const bf16_t*)(ws + WS_VSIDE); bf16_t* vb = (bf16_t*)(ws + WS_VBUF);
            constexpr int CV = FFN / 8;
            LOCAL_TID;
            for (int i = bid * 512 + tid; i < 512 * CV; i += G * 512) {
                const int cv = i % CV, sr = i / CV, kb = sr >> 1, last = sr & 1, col = cv * 8, r = kb * 64 + (last ? 63 : 0), sq = r & (SEQ - 1);
                const u32x4 zero4 = {0, 0, 0, 0}; u32x4 prev, curv, nxt, vv;
                if (!last) { prev = sq ? *(const u32x4*)(as_ + (size_t)((kb - 1) * 4 + 3) * FFN + col) : zero4; curv = *(const u32x4*)(as_ + (size_t)(kb * 4) * FFN + col);
                             nxt = *(const u32x4*)(as_ + (size_t)(kb * 4 + 1) * FFN + col); vv = *(const u32x4*)(vs_ + (size_t)(kb * 2) * FFN + col); }
                else { prev = *(const u32x4*)(as_ + (size_t)(kb * 4 + 2) * FFN + col); curv = *(const u32x4*)(as_ + (size_t)(kb * 4 + 3) * FFN + col);
                       nxt = (sq != SEQ - 1) ? *(const u32x4*)(as_ + (size_t)((kb + 1) * 4) * FFN + col) : zero4; vv = *(const u32x4*)(vs_ + (size_t)(kb * 2 + 1) * FFN + col); }
                float o[8];
#pragma unroll
                for (int q = 0; q < 4; ++q) { const unsigned pw = prev[q], cw = curv[q], nw = nxt[q], vw = vv[q]; const int c = col + 2 * q;
                    const float a0 = p.conv_b[c] + p.conv_w[c] * bf_lo(pw) + p.conv_w[FFN + c] * bf_lo(cw) + p.conv_w[2 * FFN + c] * bf_lo(nw);
                    const float a1 = p.conv_b[c + 1] + p.conv_w[c + 1] * bf_hi(pw) + p.conv_w[FFN + c + 1] * bf_hi(cw) + p.conv_w[2 * FFN + c + 1] * bf_hi(nw);
                    o[2 * q] = siluf_(a0) * bf_lo(vw); o[2 * q + 1] = siluf_(a1) * bf_hi(vw); }
                u32x4 w; w.x = cvt_pk_bf16(o[0], o[1]); w.y = cvt_pk_bf16(o[2], o[3]); w.z = cvt_pk_bf16(o[4], o[5]); w.w = cvt_pk_bf16(o[6], o[7]);
                *(u32x4*)(vb + (size_t)r * FFN + col) = w;
            }
        } break;
        case 11: if (PH_ON(11)) {
            pg8::Gemm g{(const bf16_t*)(ws + WS_VBUF), (const bf16_t*)(ws + WS_WDOWN), FFN}; pg8::Sched<0> S{64, 8, G, bid}; EpiResid E{p.out, p.out, mod, p.b_ada, 5, 1.f}; pg8::gemm_phase(lds, g, S, E);
        } break;
        case 12: if (PH_ON(12)) rows_norm<2>(p, mod); break;
        default: break;
        }
        }
    }
}

constexpr int LDS_BYTES = pg8::STAGE_BYTES + 16;
extern "C" void kernel_launch(void* const* d_in, const int* in_sizes, int n_in, void* d_out, int out_size, void* d_ws, size_t ws_size, hipStream_t stream) {
    static int grid = 0;
    if (grid == 0) {
        if (n_in != 22 || out_size != SROWS * DM || ws_size < WS_END) { fprintf(stderr, "kernel_launch: unexpected shapes (n_in %d out %d ws %zu need %zu)\n", n_in, out_size, ws_size, (size_t)WS_END); grid = -1; return; }
        int dev = 0, cus = 0, per_cu = 0;
        hipGetDevice(&dev); hipDeviceGetAttribute(&cus, hipDeviceAttributeMultiprocessorCount, dev);
        if (hipFuncSetAttribute((const void*)fwd_megakernel, hipFuncAttributeMaxDynamicSharedMemorySize, LDS_BYTES) != hipSuccess) { fprintf(stderr, "kernel_launch: hipFuncSetAttribute failed\n"); grid = -1; return; }
        hipOccupancyMaxActiveBlocksPerMultiprocessor(&per_cu, (const void*)fwd_megakernel, 512, LDS_BYTES);
        (void)hipGetLastError();
        if (per_cu < 1) per_cu = 1;
        grid = cus * per_cu; if (grid > 256) grid = 256; grid &= ~7; if (grid < 8) grid = 8;
    }
    if (grid < 0) return;
    hipMemsetAsync(d_ws, 0, WS_ZERO_BYTES, stream);
    Params p{};
    const float** pp = (const float**)&p;
    for (int i = 0; i < 22; ++i) pp[i] = (const float*)d_in[i];
    p.out = (float*)d_out; p.ws = (unsigned char*)d_ws;
#if MK_MULTI
    for (int ph = 0; ph < NPHASE; ++ph) {
#if MK_DEBUG
        hipLaunchKernelGGL(dbg_kernel, dim3(256), dim3(512), 0, stream, p, ph);
#endif
        p.ph_lo = ph; p.ph_hi = ph + 1; hipLaunchKernelGGL(fwd_megakernel, dim3(grid), dim3(512), LDS_BYTES, stream, p); }
#if MK_DEBUG
    hipLaunchKernelGGL(dbg_kernel, dim3(256), dim3(512), 0, stream, p, 13);
#endif
#else
    p.ph_lo = 0; p.ph_hi = NPHASE;
    void* args[] = {&p};
    hipError_t e = hipLaunchCooperativeKernel((const void*)fwd_megakernel, dim3(grid), dim3(512), args, LDS_BYTES, stream);
    if (e != hipSuccess) fprintf(stderr, "cooperative launch failed: %s (grid %d)\n", hipGetErrorString(e), grid);
#endif
}
```

```cpp
#include <hip/hip_runtime.h>
#include <hip/hip_cooperative_groups.h>
#include <cstdio>
#include <cstdint>
namespace cg = cooperative_groups;

#ifndef MK_ONLY
#define MK_ONLY -1
#endif
#define PH_ON(k) (MK_ONLY < 0 || MK_ONLY == (k))
#ifndef MK_DEBUG
#define MK_DEBUG 0
#endif
#ifndef MK_REP
#define MK_REP -1
#endif
#ifndef MK_MULTI
#define MK_MULTI 0
#endif

typedef unsigned short bf16_t;
typedef short bf16x8 __attribute__((ext_vector_type(8)));
typedef short s16x4 __attribute__((ext_vector_type(4)));
typedef float f32x2 __attribute__((ext_vector_type(2)));
typedef float f32x4 __attribute__((ext_vector_type(4)));
typedef float f32x16 __attribute__((ext_vector_type(16)));
typedef unsigned u32x2 __attribute__((ext_vector_type(2)));
typedef unsigned u32x4 __attribute__((ext_vector_type(4)));
#define LAS __attribute__((address_space(3)))
#define DI __device__ __forceinline__

constexpr int NB = 8, SEQ = 2048, DM = 2048, LC = 256, TT = LC + SEQ  , MROWS = NB * TT  , SROWS = NB * SEQ  ;
constexpr int FFN = 5632, INCOLS = 11328, NIN = 11520  ;
constexpr float EPS = 1e-6f;
constexpr int NPHASE = 13;

constexpr size_t MB = 1024 * 1024;
constexpr size_t WS_MOD = 0;
constexpr size_t WS_SSQKV = WS_MOD + 9 * 12288 * 4;
constexpr size_t WS_SSQQ = WS_SSQKV + MROWS * 4;
constexpr size_t WS_DBG = WS_SSQQ + SROWS * 4;
constexpr size_t WS_BAR = WS_DBG + 4096;
constexpr size_t WS_ZERO_BYTES = WS_BAR + 3456 * 4;
constexpr size_t WS_SSQRET = 1 * MB;
constexpr size_t WS_WQUP = 2 * MB;
constexpr size_t WS_WKVUP = WS_WQUP + 3072ull * 512 * 2;
constexpr size_t WS_WRETO = WS_WKVUP + 4096ull * 512 * 2;
constexpr size_t WS_WMLAO = WS_WRETO + 2048ull * 2048 * 2;
constexpr size_t WS_WOUT = WS_WMLAO + 2048ull * 2048 * 2;
constexpr size_t WS_ARENA = WS_WOUT + 2048ull * 2048 * 2;
constexpr size_t WS_WIN = WS_ARENA;
constexpr size_t WS_WUP = WS_ARENA;
constexpr size_t SLOTA = (size_t)NIN * 2048 * 2;
constexpr size_t WS_ORET = WS_ARENA + SLOTA;
constexpr size_t WS_H2 = WS_ORET;
constexpr size_t WS_WDOWN = WS_ORET;
constexpr size_t SLOTB = (size_t)SROWS * 2048 * 2;
constexpr size_t WS_C = WS_ORET + SLOTB;
constexpr size_t WS_RG = WS_C;
constexpr size_t WS_MLAO = WS_C;
constexpr size_t WS_KVD = WS_RG + (size_t)SROWS * 2048 * 2;
constexpr size_t WS_QD = WS_KVD + (size_t)MROWS * 512 * 2;
constexpr size_t WS_KR = WS_QD + (size_t)SROWS * 512 * 2;
constexpr size_t WS_C2 = WS_KR + (size_t)MROWS * 64 * 2;
constexpr size_t WS_HBUF = WS_C2;
constexpr size_t WS_RK = WS_HBUF + (size_t)MROWS * 2048 * 2;
constexpr size_t WS_RV = WS_RK + (size_t)MROWS * 1024 * 2;
constexpr size_t WS_RQ = WS_RV + (size_t)MROWS * 2048 * 2;
constexpr size_t WS_QM = WS_C2;
constexpr size_t WS_KVUP = WS_QM + (size_t)SROWS * 3072 * 2;
constexpr size_t WS_TMP1 = WS_C2;
constexpr size_t WS_MIXED = WS_TMP1 + (size_t)SROWS * 2048 * 4;
constexpr size_t WS_ABUF = WS_C;
constexpr size_t WS_ASIDE = WS_ABUF;
constexpr size_t WS_VSIDE = WS_ASIDE + (size_t)1024 * FFN * 2;
constexpr size_t WS_VBUF = WS_ABUF + (size_t)SROWS * FFN * 2;
constexpr size_t WS_END = WS_VBUF + (size_t)SROWS * FFN * 2;
static_assert(WS_KVUP + (size_t)MROWS * 4096 * 2 <= WS_END, "region C overflow");
static_assert(WS_RQ + (size_t)SROWS * 1024 * 2 <= WS_END, "region C overflow");
static_assert(WS_ZERO_BYTES <= WS_SSQRET, "zero region overflow");

struct Params {
    const float *x, *c, *ctx, *c_ctx, *w_ada, *b_ada, *w_in, *dec_f, *dec_b, *ret_gn, *w_ret_o, *q_norm, *w_q_up, *kv_norm, *w_kv_up, *w_mla_o, *w_out, *w_up, *conv_w, *conv_b, *w_down, *final_norm;
    float* out; unsigned char* ws;
    int ph_lo, ph_hi;
};

DI unsigned cvt_pk_bf16(float lo, float hi) { unsigned r; asm volatile("v_cvt_pk_bf16_f32 %0, %1, %2" : "=v"(r) : "v"(lo), "v"(hi)); return r; }
DI unsigned cvt_pk_bf16_t(float lo, float hi) { unsigned r; asm volatile("s_nop 1\n\tv_cvt_pk_bf16_f32 %0, %1, %2" : "=v"(r) : "v"(lo), "v"(hi)); return r; }
DI float bf_lo(unsigned w) { return __uint_as_float(w << 16); }
DI float bf_hi(unsigned w) { return __uint_as_float(w & 0xffff0000u); }
DI float sigmoidf_(float x) { return __builtin_amdgcn_rcpf(1.f + __expf(-x)); }
DI float siluf_(float x) { return x * sigmoidf_(x); }
DI float wave_sum(float v) {
#pragma unroll
    for (int o = 32; o > 0; o >>= 1) v += __shfl_xor(v, o);
    return v;
}


#define XB_TMO      128
#define XB_XCNT(j)  (256  + 64 * (j))
#define XB_XSUB(j)  (1280 + 64 * (j))
#define XB_XGEN(j)  (2304 + 64 * (j))
#define XB_TOP      3328
#define XB_TOPGEN   3392
#define XCD_BAR_WORDS 3456
#define XB_SPIN_CAP (1u << 20)
DI unsigned xb_ld(unsigned* p)              { return __hip_atomic_load(p, __ATOMIC_RELAXED, __HIP_MEMORY_SCOPE_AGENT); }
DI unsigned xb_add(unsigned* p, unsigned v) { return __hip_atomic_fetch_add(p, v, __ATOMIC_RELAXED, __HIP_MEMORY_SCOPE_AGENT); }
DI unsigned xb_xcc_id() { return (unsigned)__builtin_amdgcn_s_getreg((3 << 11) | 20) & 0xFu; }
#define XB_SPIN(cond, bar) do { unsigned _sp = 0; while (cond) { __builtin_amdgcn_s_sleep(1); \
    if ((++_sp & 255u) == 0u) { if (xb_ld(&(bar)[XB_TMO])) break; if (_sp > XB_SPIN_CAP) { atomicAdd(&(bar)[XB_TMO], 1u); break; } } } } while (0)
struct XcdBarrier { unsigned* bar; unsigned x; volatile LAS unsigned* st; };
DI XcdBarrier xcd_barrier_post(unsigned* bar, volatile LAS unsigned* st) {
    XcdBarrier b; b.bar = bar; b.x = xb_xcc_id(); b.st = st;
    if (threadIdx.x == 0) (void)xb_add(&bar[XB_XCNT(b.x)], 1u);
    return b;
}
DI void xcd_barrier_complete(unsigned* bar, unsigned x, unsigned& nloc, unsigned& nx) {
    const unsigned G = gridDim.x * gridDim.y * gridDim.z;
    unsigned sum, cnt, mine, sp = 0u;
    for (;;) {
        sum = 0u; cnt = 0u; mine = 0u;
#pragma unroll
        for (unsigned j = 0; j < 16; ++j) { const unsigned c = xb_ld(&bar[XB_XCNT(j)]); sum += c; cnt += (c > 0u) ? 1u : 0u; mine = (j == x) ? c : mine; }
        if (sum == G) break;
        __builtin_amdgcn_s_sleep(1);
        if ((++sp & 255u) == 0u) { if (xb_ld(&bar[XB_TMO])) break; if (sp > XB_SPIN_CAP) { atomicAdd(&bar[XB_TMO], 1u); break; } }
    }
    nloc = mine > 0u ? mine : 1u; nx = cnt > 0u ? cnt : 1u;
}
DI void xcd_barrier(const XcdBarrier& b) {
    asm volatile("s_waitcnt vmcnt(0)" ::: "memory");
    __syncthreads();
    if (threadIdx.x == 0) {
        unsigned* bar = b.bar;
        __builtin_amdgcn_s_waitcnt(0);
        unsigned nloc = b.st[0], nx = b.st[1];
        if (nloc == 0u) { xcd_barrier_complete(bar, b.x, nloc, nx); b.st[0] = nloc; b.st[1] = nx; }
        const unsigned old = xb_add(&bar[XB_XSUB(b.x)], 1u);
        const unsigned gen = old / nloc;
        if (old + 1u == (gen + 1u) * nloc) {
            __builtin_amdgcn_fence(__ATOMIC_RELEASE, "agent");
            asm volatile("s_waitcnt vmcnt(0)" ::: "memory");
            const unsigned og = xb_add(&bar[XB_TOP], 1u);
            const unsigned tg = og / nx;
            if (og + 1u == (tg + 1u) * nx) xb_add(&bar[XB_TOPGEN], 1u);
            else XB_SPIN(xb_ld(&bar[XB_TOPGEN]) == tg, bar);
            __builtin_amdgcn_fence(__ATOMIC_ACQUIRE, "agent");
            xb_add(&bar[XB_XGEN(b.x)], 1u);
            asm volatile("s_waitcnt vmcnt(0)" ::: "memory");
        } else {
            XB_SPIN(xb_ld(&bar[XB_XGEN(b.x)]) == gen, bar);
            __builtin_amdgcn_fence(__ATOMIC_ACQUIRE, "agent");
            asm volatile("s_waitcnt vmcnt(0)" ::: "memory");
        }
    }
    __syncthreads();
}

namespace pg8 {
constexpr int BM = 256, BK = 64, HALF = 128, HTB = HALF * BK * 2, STAGE_BYTES = 8 * HTB, NXCD = 8, WGM = 8;
DI int lds_byte(int r, int c) { const int st = (r >> 4) * 2 + (c >> 5), rr = r & 15, cc = c & 31, ob = rr * 64 + cc * 2; return st * 1024 + (ob ^ (((ob >> 9) & 1) << 5)); }
DI void stage_rc(int b, int& R, int& C) { const int st = b / 1024, sb = b % 1024, swz = sb ^ (((sb >> 9) & 1) << 5); R = (st >> 1) * 16 + swz / 64; C = (st & 1) * 32 + (swz % 64) / 2; }
DI int perm32(int rho) { const int n = rho >> 4, i = rho & 15; return 8 * (i >> 2) + 4 * n + (i & 3); }
struct Unit { int pm, pn; };
struct Gemm { const bf16_t* A; const bf16_t* Bt; int K; const bf16_t* A2; const bf16_t* Bt2; };

DI void tile_map(int L, int nM, int nN, int& pm, int& pn) {
    const int nwg = nM * nN; int wgid = L;
    { const int q = nwg / NXCD, r = nwg % NXCD, xcd = wgid % NXCD, off = wgid / NXCD; wgid = (xcd < r ? xcd * (q + 1) : r * (q + 1) + (xcd - r) * q) + off; }
    const int nig = WGM * nN, gid = wgid / nig, fm = gid * WGM, gsz = (nM - fm) < WGM ? (nM - fm) : WGM;
    pm = fm + ((wgid % nig) % gsz); pn = (wgid % nig) / gsz;
}
template <int KIND> struct Sched {
    int nM, nN, G, c;
    DI bool next(int i, Unit& u) const {
        const int L = i * G + c;
        if (KIND == 0) { if (L >= nM * nN) return false; tile_map(L, nM, nN, u.pm, u.pn); return true; }
        else {
            if (L < 2880) { int lm, ln; tile_map(L, 64, 45, lm, ln); u.pm = (lm >> 3) * 9 + 1 + (lm & 7); u.pn = ln; return true; }
            if (L < 3000) { int lm, ln; tile_map(L - 2880, 8, 15, lm, ln); u.pm = lm * 9; u.pn = ln; return true; }
            return false;
        }
    }
    DI void a_ready(const Unit&) const {}
    DI void done(const Unit&) const {}
};

template <class Epi, class SchedT>
DI void gemm_phase(LAS unsigned char* lds, const Gemm g, const SchedT& S, const Epi& E) {
    int tid = threadIdx.x; asm volatile("" : "+v"(tid));
    const int wid = __builtin_amdgcn_readfirstlane(tid >> 6), lane = tid & 63, wr = wid >> 2, wc = wid & 3, fr = lane & 15, fq = lane >> 4;
    constexpr bool DUAL = Epi::DUAL;
    const int K = g.K, nth = K / BK, nt = DUAL ? 2 * nth : nth;
    unsigned voffA[2], voffB[2];
#pragma unroll
    for (int i = 0; i < 2; ++i) { int R, C; stage_rc(tid * 16 + i * 8192, R, C); const int Rb = Epi::PERM ? ((R & ~31) + perm32(R & 31)) : R;
        voffA[i] = (unsigned)(R * K + C) * 2u; voffB[i] = (unsigned)(Rb * K + C) * 2u; }
    const size_t kstep = (size_t)(BK * 2);
    const size_t hstep = (size_t)HALF * K * 2;
    const size_t tstep = 2 * hstep;
    const unsigned ldsw = (unsigned)wid * 1024u;
    const int aoff = lds_byte(wr * 64 + fr, fq * 8), boff = lds_byte(wc * 32 + fr, fq * 8);
#define PG8_SA(b, h) (((b) * 2 + (h)) * HTB)
#define PG8_SB(b, h) ((4 + (b) * 2 + (h)) * HTB)
#define PG8_STAGE(bufoff, gbase, voff) do { _Pragma("unroll") for (int _i = 0; _i < 2; ++_i) \
        __builtin_amdgcn_global_load_lds((const unsigned*)((const char*)(gbase) + (voff)[_i]), (LAS unsigned*)(lds + (bufoff) + ldsw + _i * 8192), 16, 0, 0); } while (0)
#define PG8_LDA(dst, b, h) do { _Pragma("unroll") for (int m = 0; m < 4; ++m) _Pragma("unroll") for (int k = 0; k < 2; ++k) dst[m][k] = *(const LAS bf16x8*)(lds + PG8_SA(b, h) + aoff + m * 2048 + k * 1024); } while (0)
#define PG8_LDB(dst, b, h) do { _Pragma("unroll") for (int n = 0; n < 2; ++n) _Pragma("unroll") for (int k = 0; k < 2; ++k) dst[n][k] = *(const LAS bf16x8*)(lds + PG8_SB(b, h) + boff + n * 2048 + k * 1024); } while (0)
#define PG8_MMA(ai, bj, At, Bt) do { __builtin_amdgcn_s_setprio(1); _Pragma("unroll") for (int m = 0; m < 4; ++m) _Pragma("unroll") for (int n = 0; n < 2; ++n) _Pragma("unroll") for (int k = 0; k < 2; ++k) \
        acc[ai][bj][m][n] = __builtin_amdgcn_mfma_f32_16x16x32_bf16(Bt[n][k], At[m][k], acc[ai][bj][m][n], 0, 0, 0); __builtin_amdgcn_s_setprio(0); } while (0)
#define PG8_WAIT_V(n) asm volatile("s_waitcnt vmcnt(" #n ")" ::: "memory")
#define PG8_WAIT_L(n) asm volatile("s_waitcnt lgkmcnt(" #n ")" ::: "memory")
#define PG8_BAR __builtin_amdgcn_s_barrier()
#define PG8_SCHED __builtin_amdgcn_sched_barrier(0)
    Unit cur, nxt; int ui = 0;
    if (!S.next(0, cur)) return;
    f32x4 acc[2][2][4][2];
#pragma unroll
    for (int a = 0; a < 2; ++a)
#pragma unroll
        for (int b = 0; b < 2; ++b)
#pragma unroll
            for (int m = 0; m < 4; ++m)
#pragma unroll
                for (int n = 0; n < 2; ++n) acc[a][b][m][n] = (f32x4){0.f, 0.f, 0.f, 0.f};
    bf16x8 At[4][2], B0[2][2], B1[2][2];
    const char* cA = (const char*)g.A + (size_t)cur.pm * tstep; const char* cB = (const char*)g.Bt + (size_t)cur.pn * tstep;
    const char* cA2 = DUAL ? (const char*)g.A2 + (size_t)cur.pm * tstep : cA; const char* cB2 = DUAL ? (const char*)g.Bt2 + (size_t)cur.pn * tstep : cB;
    S.a_ready(cur);
    PG8_STAGE(PG8_SB(0, 0), cB, voffB); PG8_STAGE(PG8_SA(0, 0), cA, voffA); PG8_STAGE(PG8_SB(0, 1), cB + hstep, voffB); PG8_STAGE(PG8_SA(0, 1), cA + hstep, voffA);
    if (wr == 1) PG8_BAR;
    PG8_WAIT_V(4); PG8_BAR;
    PG8_STAGE(PG8_SB(1, 0), cB + kstep, voffB); PG8_STAGE(PG8_SA(1, 0), cA + kstep, voffA); PG8_STAGE(PG8_SB(1, 1), cB + hstep + kstep, voffB);
    PG8_WAIT_V(6); PG8_BAR;
    for (;;) {
        const bool has_next = S.next(ui + 1, nxt);
        const char* nA = has_next ? (const char*)g.A + (size_t)nxt.pm * tstep : cA; const char* nB = has_next ? (const char*)g.Bt + (size_t)nxt.pn * tstep : cB;
        for (int t = 0; t < nt; t += 2) {
            const bool last = (t == nt - 2);
            const bool h2a = DUAL && (t + 1 >= nth), h2b = DUAL && (t + 2 >= nth);
            const char* a1 = (h2a ? cA2 - (size_t)nth * kstep : cA) + (size_t)(t + 1) * kstep;
            const char* a2 = last ? nA : (h2b ? cA2 - (size_t)nth * kstep : cA) + (size_t)(t + 2) * kstep; const char* b2 = last ? nB : (h2b ? cB2 - (size_t)nth * kstep : cB) + (size_t)(t + 2) * kstep;
            const char* a3 = a2 + kstep; const char* b3 = b2 + kstep;
            if (last && has_next) S.a_ready(nxt);
            if constexpr (DUAL) { if (t == nth) { int fr_ = fr, fq_ = fq; asm volatile("" : "+v"(fr_), "+v"(fq_)); E.mid(acc, cur, wr, wc, fr_, fq_); } }
            PG8_LDB(B0, 0, 0); PG8_SCHED; PG8_LDA(At, 0, 0); PG8_STAGE(PG8_SA(1, 1), a1 + hstep, voffA);
            PG8_WAIT_L(8); PG8_BAR; PG8_WAIT_L(0); PG8_MMA(0, 0, At, B0); PG8_BAR; PG8_SCHED;
            PG8_LDB(B1, 0, 1); PG8_STAGE(PG8_SB(0, 0), b2, voffB);
            PG8_BAR; PG8_WAIT_L(0); PG8_MMA(0, 1, At, B1); PG8_BAR;
            PG8_LDA(At, 0, 1); PG8_STAGE(PG8_SA(0, 0), a2, voffA);
            PG8_BAR; PG8_WAIT_L(0); PG8_MMA(1, 0, At, B0); PG8_BAR; PG8_SCHED;
            PG8_STAGE(PG8_SB(0, 1), b2 + hstep, voffB);
            PG8_WAIT_V(6); PG8_BAR; PG8_MMA(1, 1, At, B1); PG8_BAR;
            PG8_LDB(B0, 1, 0); PG8_SCHED; PG8_LDA(At, 1, 0); PG8_STAGE(PG8_SA(0, 1), a2 + hstep, voffA);
            PG8_WAIT_L(8); PG8_BAR; PG8_WAIT_L(0); PG8_MMA(0, 0, At, B0); PG8_BAR; PG8_SCHED;
            PG8_LDB(B1, 1, 1); PG8_STAGE(PG8_SB(1, 0), b3, voffB);
            PG8_BAR; PG8_WAIT_L(0); PG8_MMA(0, 1, At, B1); PG8_BAR;
            PG8_LDA(At, 1, 1); PG8_STAGE(PG8_SA(1, 0), a3, voffA);
            PG8_BAR; PG8_WAIT_L(0); PG8_MMA(1, 0, At, B0); PG8_BAR; PG8_SCHED;
            PG8_STAGE(PG8_SB(1, 1), b3 + hstep, voffB);
            PG8_WAIT_V(6); PG8_BAR; PG8_MMA(1, 1, At, B1); PG8_BAR;
        }
        { int fr_ = fr, fq_ = fq; asm volatile("" : "+v"(fr_), "+v"(fq_)); E(acc, cur, wr, wc, fr_, fq_); } S.done(cur);
        if (!has_next) break;
#pragma unroll
        for (int a = 0; a < 2; ++a)
#pragma unroll
            for (int b = 0; b < 2; ++b)
#pragma unroll
                for (int m = 0; m < 4; ++m)
#pragma unroll
                    for (int n = 0; n < 2; ++n) acc[a][b][m][n] = (f32x4){0.f, 0.f, 0.f, 0.f};
        cur = nxt; cA = nA; cB = nB; ++ui;
        if constexpr (DUAL) { cA2 = (const char*)g.A2 + (size_t)cur.pm * tstep; cB2 = (const char*)g.Bt2 + (size_t)cur.pn * tstep; }
    }
    PG8_WAIT_V(0);
    if (wr == 0) PG8_BAR;
    PG8_BAR;
#undef PG8_SA
#undef PG8_SB
#undef PG8_STAGE
#undef PG8_LDA
#undef PG8_LDB
#undef PG8_MMA
#undef PG8_WAIT_V
#undef PG8_WAIT_L
#undef PG8_BAR
#undef PG8_SCHED
}
}
using pg8::Unit;
typedef const f32x4 (&AccRef)[2][2][4][2];

template <int ACT  >
DI void store_plain(AccRef acc, bf16_t* dst, size_t ld, int row0, int col0) {
#pragma unroll
    for (int ai = 0; ai < 2; ++ai)
#pragma unroll
        for (int m = 0; m < 4; ++m) { int rowi = row0 + ai * 128 + m * 16; asm volatile("" : "+v"(rowi)); bf16_t* rowp = dst + (size_t)rowi * ld + col0;
#pragma unroll
            for (int bj = 0; bj < 2; ++bj) { f32x4 v0 = acc[ai][bj][m][0], v1 = acc[ai][bj][m][1];
                if (ACT == 1) {
#pragma unroll
                    for (int j = 0; j < 4; ++j) { v0[j] = siluf_(v0[j]); v1[j] = siluf_(v1[j]); } }
                if (ACT == 2) {
#pragma unroll
                    for (int j = 0; j < 4; ++j) { v0[j] = sigmoidf_(v0[j]); v1[j] = sigmoidf_(v1[j]); } }
                u32x4 w;
                if (ACT == 0) { w.x = cvt_pk_bf16(v0[0], v0[1]); w.y = cvt_pk_bf16(v0[2], v0[3]); w.z = cvt_pk_bf16(v1[0], v1[1]); w.w = cvt_pk_bf16(v1[2], v1[3]); }
                else { w.x = cvt_pk_bf16_t(v0[0], v0[1]); w.y = cvt_pk_bf16_t(v0[2], v0[3]); w.z = cvt_pk_bf16_t(v1[0], v1[1]); w.w = cvt_pk_bf16_t(v1[2], v1[3]); }
                *(u32x4*)(rowp + bj * 128) = w; } }
}
DI void add_ssq(AccRef acc, float* ssq, int row0, int fq) {
#pragma unroll
    for (int ai = 0; ai < 2; ++ai)
#pragma unroll
        for (int m = 0; m < 4; ++m) { float s = 0.f;
#pragma unroll
            for (int bj = 0; bj < 2; ++bj)
#pragma unroll
                for (int n = 0; n < 2; ++n)
#pragma unroll
                    for (int j = 0; j < 4; ++j) { const float v = acc[ai][bj][m][n][j]; s += v * v; }
            s += __shfl_xor(s, 16); s += __shfl_xor(s, 32);
            if (fq == 0) atomicAdd(ssq + row0 + ai * 128 + m * 16, s); }
}
DI void store_rope128(AccRef acc, bf16_t* dst, int row0, int head0, int s0, bool do_rope, float scale, int wc, int fq) {
    const int half = wc >> 1, f0 = ((wc & 1) * 4 + fq) * 4;
    float inv[4];
#pragma unroll
    for (int j = 0; j < 4; ++j) inv[j] = __builtin_amdgcn_exp2f(-(float)(f0 + j) * 0.41524101186f) * 0.15915494309f;
#pragma unroll
    for (int ai = 0; ai < 2; ++ai)
#pragma unroll
        for (int m = 0; m < 4; ++m) { const int s = s0 + ai * 128 + m * 16; const float pos = (float)(half ? (s & 63) : (s >> 6));
            float cs[4], sn[4];
#pragma unroll
            for (int j = 0; j < 4; ++j) { const float rev = pos * inv[j]; cs[j] = do_rope ? __builtin_amdgcn_cosf(rev) : 1.f; sn[j] = do_rope ? __builtin_amdgcn_sinf(rev) : 0.f; }
#pragma unroll
            for (int bj = 0; bj < 2; ++bj) { const f32x4 t1 = acc[ai][bj][m][0], t2 = acc[ai][bj][m][1]; float o1[4], o2[4];
#pragma unroll
                for (int j = 0; j < 4; ++j) { o1[j] = (t1[j] * cs[j] - t2[j] * sn[j]) * scale; o2[j] = (t2[j] * cs[j] + t1[j] * sn[j]) * scale; }
                int rowi = row0 + ai * 128 + m * 16; asm volatile("" : "+v"(rowi)); bf16_t* p = dst + (size_t)rowi * 1024 + (head0 + bj) * 128 + half * 64 + f0;
                u32x2 w1, w2; w1.x = cvt_pk_bf16(o1[0], o1[1]); w1.y = cvt_pk_bf16(o1[2], o1[3]); w2.x = cvt_pk_bf16(o2[0], o2[1]); w2.y = cvt_pk_bf16(o2[2], o2[3]);
                *(u32x2*)p = w1; *(u32x2*)(p + 32) = w2; } }
}
DI void store_rope32(AccRef acc, int bj, const float (&rs)[2][4], bf16_t* dst, size_t ld, int row0, int colbase, int g, int s0, bool do_rope, int fq) {
    const int f0 = 4 * fq; float inv[4];
#pragma unroll
    for (int j = 0; j < 4; ++j) inv[j] = __builtin_amdgcn_exp2f(-(float)(f0 + j) * 0.83048202372f) * 0.15915494309f;
#pragma unroll
    for (int ai = 0; ai < 2; ++ai)
#pragma unroll
        for (int m = 0; m < 4; ++m) { const int s = s0 + ai * 128 + m * 16; const float pos = (float)(g ? (s & 63) : (s >> 6));
            const f32x4 t1 = (bj ? acc[ai][1][m][0] : acc[ai][0][m][0]) * rs[ai][m], t2 = (bj ? acc[ai][1][m][1] : acc[ai][0][m][1]) * rs[ai][m]; float o1[4], o2[4];
#pragma unroll
            for (int j = 0; j < 4; ++j) { const float rev = pos * inv[j]; const float cs = do_rope ? __builtin_amdgcn_cosf(rev) : 1.f, sn = do_rope ? __builtin_amdgcn_sinf(rev) : 0.f;
                o1[j] = t1[j] * cs - t2[j] * sn; o2[j] = t2[j] * cs + t1[j] * sn; }
            int rowi = row0 + ai * 128 + m * 16; asm volatile("" : "+v"(rowi)); bf16_t* p = dst + (size_t)rowi * ld + colbase + f0;
            u32x2 w1, w2; w1.x = cvt_pk_bf16(o1[0], o1[1]); w1.y = cvt_pk_bf16(o1[2], o1[3]); w2.x = cvt_pk_bf16(o2[0], o2[1]); w2.y = cvt_pk_bf16(o2[2], o2[3]);
            *(u32x2*)p = w1; *(u32x2*)(p + 16) = w2; }
}

struct EpiInProj {
    static constexpr bool PERM = true, DUAL = false;
    bf16_t *rk, *rv, *kvd, *kr, *rq, *rg, *qd, *gr, *gm; float *ssq_kv, *ssq_q; bf16_t* dcopy;
    DI void operator()(AccRef acc, const Unit& u, int wr, int wc, int fr, int fq) const {
        const int pn = u.pn, b = u.pm / 9, jt = u.pm % 9; const bool latent = jt != 0;
        const int trow0 = u.pm * 256 + wr * 64 + fr;
        const int srow0 = (b * 8 + jt - 1) * 256 + wr * 64 + fr;
        const int s0 = (jt - 1) * 256 + wr * 64 + fr;
        const int cw = wc * 32 + 8 * fq;
        if (pn < 4) store_rope128(acc, rk, trow0, pn * 2, s0, latent, 0.08838834764831845f, wc, fq);
        else if (pn < 12) store_plain<0>(acc, rv, 2048, trow0, (pn - 4) * 256 + cw);
        else if (pn < 14) { store_plain<0>(acc, kvd, 512, trow0, (pn - 12) * 256 + cw); add_ssq(acc, ssq_kv, trow0, fq); }
        else if (pn == 14) { if (wc < 2) { const float one[2][4] = {{1.f, 1.f, 1.f, 1.f}, {1.f, 1.f, 1.f, 1.f}}; store_rope32(acc, 0, one, kr, 64, trow0, wc * 32, wc, s0, latent, fq); } }
        else if (pn < 19) store_rope128(acc, rq, srow0, (pn - 15) * 2, s0, true, 1.f, wc, fq);
        else if (pn < 27) store_plain<1>(acc, rg, 2048, srow0, (pn - 19) * 256 + cw);
        else if (pn < 29) { store_plain<0>(acc, qd, 512, srow0, (pn - 27) * 256 + cw); add_ssq(acc, ssq_q, srow0, fq); }
        else if (pn < 37) store_plain<2>(acc, gr, 2048, srow0, (pn - 29) * 256 + cw);
        else store_plain<2>(acc, gm, 2048, srow0, (pn - 37) * 256 + cw);
    }
};
struct EpiQup {
    static constexpr bool PERM = true, DUAL = false;
    bf16_t* qm; const float* ssq_q;
    DI void operator()(AccRef acc, const Unit& u, int wr, int wc, int fr, int fq) const {
        const int row0 = u.pm * 256 + wr * 64 + fr; const int s0 = (u.pm & 7) * 256 + wr * 64 + fr;
        float rs[2][4];
#pragma unroll
        for (int ai = 0; ai < 2; ++ai)
#pragma unroll
            for (int m = 0; m < 4; ++m) rs[ai][m] = __builtin_amdgcn_rsqf(ssq_q[row0 + ai * 128 + m * 16] * (1.f / 512.f) + EPS);
#pragma unroll
        for (int bj = 0; bj < 2; ++bj) {
            const int gidx = u.pn * 8 + bj * 4 + wc, head = gidx / 6, gi = gidx % 6;
            if (gi < 4) {
#pragma unroll
                for (int ai = 0; ai < 2; ++ai)
#pragma unroll
                    for (int m = 0; m < 4; ++m) { const f32x4 v0 = acc[ai][bj][m][0] * rs[ai][m], v1 = acc[ai][bj][m][1] * rs[ai][m];
                        u32x4 w; w.x = cvt_pk_bf16(v0[0], v0[1]); w.y = cvt_pk_bf16(v0[2], v0[3]); w.z = cvt_pk_bf16(v1[0], v1[1]); w.w = cvt_pk_bf16(v1[2], v1[3]);
                        int rowi = row0 + ai * 128 + m * 16; asm volatile("" : "+v"(rowi));
                        *(u32x4*)(qm + (size_t)rowi * 3072 + head * 192 + gi * 32 + 8 * fq) = w; }
            } else store_rope32(acc, bj, rs, qm, 3072, row0, head * 192 + 128 + (gi - 4) * 32, gi - 4, s0, true, fq);
        }
    }
};
struct EpiKvup {
    static constexpr bool PERM = true, DUAL = false;
    bf16_t* kvup; const float* ssq_kv;
    DI void operator()(AccRef acc, const Unit& u, int wr, int wc, int fr, int fq) const {
        const int row0 = u.pm * 256 + wr * 64 + fr, col0 = u.pn * 256 + wc * 32 + 8 * fq;
        float rs[2][4];
#pragma unroll
        for (int ai = 0; ai < 2; ++ai)
#pragma unroll
            for (int m = 0; m < 4; ++m) rs[ai][m] = __builtin_amdgcn_rsqf(ssq_kv[row0 + ai * 128 + m * 16] * (1.f / 512.f) + EPS);
#pragma unroll
        for (int ai = 0; ai < 2; ++ai)
#pragma unroll
            for (int m = 0; m < 4; ++m) { int row = row0 + ai * 128 + m * 16; asm volatile("" : "+v"(row));
#pragma unroll
                for (int bj = 0; bj < 2; ++bj) { const f32x4 v0 = acc[ai][bj][m][0] * rs[ai][m], v1 = acc[ai][bj][m][1] * rs[ai][m];
                    u32x4 w; w.x = cvt_pk_bf16(v0[0], v0[1]); w.y = cvt_pk_bf16(v0[2], v0[3]); w.z = cvt_pk_bf16(v1[0], v1[1]); w.w = cvt_pk_bf16(v1[2], v1[3]);
                    *(u32x4*)(kvup + (size_t)row * 4096 + col0 + bj * 128) = w; } }
    }
};
struct EpiDual {
    static constexpr bool PERM = true, DUAL = true;
    const bf16_t *gr, *gm; bf16_t* mixed;
    DI void mid(f32x4 (&acc)[2][2][4][2], const Unit& u, int wr, int wc, int fr, int fq) const {
        const int row0 = u.pm * 256 + wr * 64 + fr, col0 = u.pn * 256 + wc * 32 + 8 * fq;
#pragma unroll
        for (int ai = 0; ai < 2; ++ai)
#pragma unroll
            for (int mp = 0; mp < 2; ++mp) { u32x4 ga[2][2], gb[2][2];
#pragma unroll
                for (int mm = 0; mm < 2; ++mm) { int rowi = row0 + ai * 128 + (mp * 2 + mm) * 16; asm volatile("" : "+v"(rowi));
#pragma unroll
                    for (int bj = 0; bj < 2; ++bj) { const size_t o = (size_t)rowi * 2048 + col0 + bj * 128; ga[mm][bj] = *(const u32x4*)(gr + o); gb[mm][bj] = *(const u32x4*)(gm + o); } }
#pragma unroll
                for (int mm = 0; mm < 2; ++mm)
#pragma unroll
                    for (int bj = 0; bj < 2; ++bj) { const u32x4 a = ga[mm][bj], b = gb[mm][bj]; f32x4 r0, r1;
                        r0[0] = bf_lo(a.x) * __builtin_amdgcn_rcpf(fmaxf(bf_lo(b.x), 1e-30f)); r0[1] = bf_hi(a.x) * __builtin_amdgcn_rcpf(fmaxf(bf_hi(b.x), 1e-30f));
                        r0[2] = bf_lo(a.y) * __builtin_amdgcn_rcpf(fmaxf(bf_lo(b.y), 1e-30f)); r0[3] = bf_hi(a.y) * __builtin_amdgcn_rcpf(fmaxf(bf_hi(b.y), 1e-30f));
                        r1[0] = bf_lo(a.z) * __builtin_amdgcn_rcpf(fmaxf(bf_lo(b.z), 1e-30f)); r1[1] = bf_hi(a.z) * __builtin_amdgcn_rcpf(fmaxf(bf_hi(b.z), 1e-30f));
                        r1[2] = bf_lo(a.w) * __builtin_amdgcn_rcpf(fmaxf(bf_lo(b.w), 1e-30f)); r1[3] = bf_hi(a.w) * __builtin_amdgcn_rcpf(fmaxf(bf_hi(b.w), 1e-30f));
                        acc[ai][bj][mp * 2 + mm][0] *= r0; acc[ai][bj][mp * 2 + mm][1] *= r1; }
                asm volatile("" ::: "memory"); }
    }
    DI void operator()(AccRef acc, const Unit& u, int wr, int wc, int fr, int fq) const {
        const int row0 = u.pm * 256 + wr * 64 + fr, col0 = u.pn * 256 + wc * 32 + 8 * fq;
#pragma unroll
        for (int ai = 0; ai < 2; ++ai) { u32x4 gg[4][2]; size_t off[4];
#pragma unroll
            for (int m = 0; m < 4; ++m) { int rowi = row0 + ai * 128 + m * 16; asm volatile("" : "+v"(rowi)); off[m] = (size_t)rowi * 2048 + col0;
#pragma unroll
                for (int bj = 0; bj < 2; ++bj) gg[m][bj] = *(const u32x4*)(gm + off[m] + bj * 128); }
#pragma unroll
            for (int m = 0; m < 4; ++m)
#pragma unroll
                for (int bj = 0; bj < 2; ++bj) { const u32x4 g = gg[m][bj]; const f32x4 a0 = acc[ai][bj][m][0], a1 = acc[ai][bj][m][1];
                    u32x4 w; w.x = cvt_pk_bf16(a0[0] * bf_lo(g.x), a0[1] * bf_hi(g.x)); w.y = cvt_pk_bf16(a0[2] * bf_lo(g.y), a0[3] * bf_hi(g.y));
                    w.z = cvt_pk_bf16(a1[0] * bf_lo(g.z), a1[1] * bf_hi(g.z)); w.w = cvt_pk_bf16(a1[2] * bf_lo(g.w), a1[3] * bf_hi(g.w));
                    *(u32x4*)(mixed + off[m] + bj * 128) = w; }
            asm volatile("" ::: "memory"); }
    }
};
struct EpiResid {
    static constexpr bool PERM = true, DUAL = false;
    const float* base; float* out; const float* mod; const float* b_ada; int chunk; float gscale;
    DI void operator()(AccRef acc, const Unit& u, int wr, int wc, int fr, int fq) const {
        const int row0 = u.pm * 256 + wr * 64 + fr, col0 = u.pn * 256 + wc * 32 + 8 * fq, b = u.pm >> 3;
        f32x4 gt[2][2];
#pragma unroll
        for (int bj = 0; bj < 2; ++bj)
#pragma unroll
            for (int n = 0; n < 2; ++n) { const int c = chunk * 2048 + col0 + bj * 128 + n * 4; gt[bj][n] = (*(const f32x4*)(mod + b * 12288 + c) + *(const f32x4*)(b_ada + c)) * gscale; }
#pragma unroll
        for (int ai = 0; ai < 2; ++ai)
#pragma unroll
            for (int mp = 0; mp < 2; ++mp) {
                f32x4 bv[2][2][2]; size_t off[2];
#pragma unroll
                for (int mm = 0; mm < 2; ++mm) { int rowi = row0 + ai * 128 + (mp * 2 + mm) * 16; asm volatile("" : "+v"(rowi)); off[mm] = (size_t)rowi * 2048 + col0;
#pragma unroll
                    for (int bj = 0; bj < 2; ++bj)
#pragma unroll
                        for (int n = 0; n < 2; ++n) bv[mm][bj][n] = *(const f32x4*)(base + off[mm] + bj * 128 + n * 4); }
#pragma unroll
                for (int mm = 0; mm < 2; ++mm)
#pragma unroll
                    for (int bj = 0; bj < 2; ++bj)
#pragma unroll
                        for (int n = 0; n < 2; ++n) *(f32x4*)(out + off[mm] + bj * 128 + n * 4) = bv[mm][bj][n] + gt[bj][n] * acc[ai][bj][mp * 2 + mm][n];
                asm volatile("" ::: "memory"); }
    }
};
DI float dpp_prev(float x) { return __int_as_float(__builtin_amdgcn_update_dpp(0, __float_as_int(x), 0x121, 0xf, 0xf, false)); }
DI float dpp_next(float x) { return __int_as_float(__builtin_amdgcn_update_dpp(0, __float_as_int(x), 0x12F, 0xf, 0xf, false)); }
struct EpiUp {
    static constexpr bool PERM = true, DUAL = false;
    bf16_t *u, *aside, *vside; const float *cw, *cb;
    DI void operator()(AccRef acc, const Unit& un, int wr, int wc, int fr, int fq) const {
        const int ch0 = un.pn * 128 + wc * 32 + 8 * fq;
        f32x4 w0[2], w1[2], w2[2], bb[2];
#pragma unroll
        for (int n = 0; n < 2; ++n) { w0[n] = *(const f32x4*)(cw + ch0 + 4 * n); w1[n] = *(const f32x4*)(cw + FFN + ch0 + 4 * n); w2[n] = *(const f32x4*)(cw + 2 * FFN + ch0 + 4 * n); bb[n] = *(const f32x4*)(cb + ch0 + 4 * n); }
#pragma unroll
        for (int ai = 0; ai < 2; ++ai) {
            int rowb = un.pm * 256 + ai * 128 + wr * 64; asm volatile("" : "+s"(rowb));
            u32x2 pu[4][2], pa[4][2], pv[4][2];
#pragma unroll
            for (int n = 0; n < 2; ++n) {
                f32x4 rd[4], ru[4];
#pragma unroll
                for (int m = 0; m < 4; ++m)
#pragma unroll
                    for (int j = 0; j < 4; ++j) { rd[m][j] = dpp_prev(acc[ai][0][m][n][j]); ru[m][j] = dpp_next(acc[ai][0][m][n][j]); }
#pragma unroll
                for (int m = 0; m < 4; ++m) { const f32x4 a = acc[ai][0][m][n], vv = acc[ai][1][m][n]; float uu[4];
#pragma unroll
                    for (int j = 0; j < 4; ++j) {
                        const float prev = (fr == 0) ? (m > 0 ? rd[m > 0 ? m - 1 : 0][j] : 0.f) : rd[m][j];
                        const float next = (fr == 15) ? (m < 3 ? ru[m < 3 ? m + 1 : 3][j] : 0.f) : ru[m][j];
                        const float z = bb[n][j] + w0[n][j] * prev + w1[n][j] * a[j] + w2[n][j] * next;
                        uu[j] = siluf_(z) * vv[j]; }
                    pu[m][n].x = cvt_pk_bf16(uu[0], uu[1]); pu[m][n].y = cvt_pk_bf16(uu[2], uu[3]);
                    if (m == 0 || m == 3) { pa[m][n].x = cvt_pk_bf16(a[0], a[1]); pa[m][n].y = cvt_pk_bf16(a[2], a[3]); pv[m][n].x = cvt_pk_bf16(vv[0], vv[1]); pv[m][n].y = cvt_pk_bf16(vv[2], vv[3]); } }
            }
#pragma unroll
            for (int m = 0; m < 4; ++m) { int rowi = rowb + m * 16 + fr; asm volatile("" : "+v"(rowi));
                u32x4 w; w.x = pu[m][0].x; w.y = pu[m][0].y; w.z = pu[m][1].x; w.w = pu[m][1].y;
                *(u32x4*)(u + (size_t)rowi * FFN + ch0) = w; }
            const int kb = rowb >> 6;
            if (fr < 2) { u32x4 w; w.x = pa[0][0].x; w.y = pa[0][0].y; w.z = pa[0][1].x; w.w = pa[0][1].y; *(u32x4*)(aside + (size_t)(kb * 4 + fr) * FFN + ch0) = w; }
            if (fr >= 14) { u32x4 w; w.x = pa[3][0].x; w.y = pa[3][0].y; w.z = pa[3][1].x; w.w = pa[3][1].y; *(u32x4*)(aside + (size_t)(kb * 4 + fr - 12) * FFN + ch0) = w; }
            if (fr == 0) { u32x4 w; w.x = pv[0][0].x; w.y = pv[0][0].y; w.z = pv[0][1].x; w.w = pv[0][1].y; *(u32x4*)(vside + (size_t)(kb * 2) * FFN + ch0) = w; }
            if (fr == 15) { u32x4 w; w.x = pv[3][0].x; w.y = pv[3][0].y; w.z = pv[3][1].x; w.w = pv[3][1].y; *(u32x4*)(vside + (size_t)(kb * 2 + 1) * FFN + ch0) = w; }
            asm volatile("" ::: "memory");
        }
    }
};

namespace att {
constexpr int NW = 8, QBLK = 32, KVBLK = 64, NT = TT / KVBLK;
constexpr size_t SHM_V = KVBLK * 128 * 2, SHM_K = KVBLK * 128 * 2, SHM_KR = KVBLK * 64 * 2;
constexpr size_t OFF_K = 2 * SHM_V, OFF_KR = OFF_K + 2 * SHM_K, OFF_WS = OFF_KR + 2 * SHM_KR;
#define KSWZ(row, colB) ((row) * 256 + ((colB) ^ (((row) & 7) << 4)))
#define KRSWZ(row, colB) ((row) * 128 + ((colB) ^ (((row) & 7) << 4)))
#define SBAR() __builtin_amdgcn_sched_barrier(0)
DI int crow(int r, int hi) { return (r & 3) + 8 * (r >> 2) + 4 * hi; }
DI int v_st(int k, int c) { const int kk = (k & ~0xC) | ((k & 4) << 1) | ((k & 8) >> 1); return ((kk >> 3) * 4 + (c >> 5)) * 512 + ((kk & 7) * 32 + (c & 31)) * 2; }
DI int v_rd_base(int lane) { return ((lane & 3) << 3) | (((lane >> 2) & 3) << 6) | (((lane >> 4) & 1) << 5) | (((lane >> 5) & 1) << 8); }
constexpr int v_rd_off(int d0, int ks, int half) { return d0 * 512 + ks * 4096 + half * 2048; }
template <int OFF> DI s16x4 tr_read(int vb) { s16x4 r; asm volatile("ds_read_b64_tr_b16 %0, %1 offset:%2" : "=&v"(r) : "v"(vb), "i"(OFF) : "memory"); return r; }
template <int D0> DI void pv_one(f32x16& od, int vb, bf16x8 pa0, bf16x8 pa1, bf16x8 pa2, bf16x8 pa3) {
    const s16x4 l0 = tr_read<v_rd_off(D0, 0, 0)>(vb), h0 = tr_read<v_rd_off(D0, 0, 1)>(vb), l1 = tr_read<v_rd_off(D0, 1, 0)>(vb), h1 = tr_read<v_rd_off(D0, 1, 1)>(vb);
    const s16x4 l2 = tr_read<v_rd_off(D0, 2, 0)>(vb), h2 = tr_read<v_rd_off(D0, 2, 1)>(vb), l3 = tr_read<v_rd_off(D0, 3, 0)>(vb), h3 = tr_read<v_rd_off(D0, 3, 1)>(vb);
    asm volatile("s_waitcnt lgkmcnt(0)" ::: "memory"); SBAR();
#define PK(L, H) (bf16x8){L[0], L[1], L[2], L[3], H[0], H[1], H[2], H[3]}
    od = __builtin_amdgcn_mfma_f32_32x32x16_bf16(pa0, PK(l0, h0), od, 0, 0, 0);
    od = __builtin_amdgcn_mfma_f32_32x32x16_bf16(pa1, PK(l1, h1), od, 0, 0, 0);
    od = __builtin_amdgcn_mfma_f32_32x32x16_bf16(pa2, PK(l2, h2), od, 0, 0, 0);
    od = __builtin_amdgcn_mfma_f32_32x32x16_bf16(pa3, PK(l3, h3), od, 0, 0, 0);
#undef PK
}
DI void pv_d0(f32x16* o, int vb, bf16x8 pa0, bf16x8 pa1, bf16x8 pa2, bf16x8 pa3) {
    pv_one<0>(o[0], vb, pa0, pa1, pa2, pa3); pv_one<1>(o[1], vb, pa0, pa1, pa2, pa3); pv_one<2>(o[2], vb, pa0, pa1, pa2, pa3); pv_one<3>(o[3], vb, pa0, pa1, pa2, pa3);
}
DI void pack_p(const f32x16& p0, const f32x16& p1, bf16x8& pa0, bf16x8& pa1, bf16x8& pa2, bf16x8& pa3) {
#define PK4(P, BASE, OUT) do { unsigned a0 = cvt_pk_bf16_t(P[BASE + 0], P[BASE + 1]), a1 = cvt_pk_bf16_t(P[BASE + 2], P[BASE + 3]);   \
    unsigned b0 = cvt_pk_bf16_t(P[BASE + 4], P[BASE + 5]), b1 = cvt_pk_bf16_t(P[BASE + 6], P[BASE + 7]);                              \
    auto r0 = __builtin_amdgcn_permlane32_swap(a0, b0, false, false); auto r1 = __builtin_amdgcn_permlane32_swap(a1, b1, false, false); \
    u32x4 w = {r0[0], r1[0], r0[1], r1[1]}; OUT = *reinterpret_cast<bf16x8*>(&w); } while (0)
    PK4(p0, 0, pa0); PK4(p0, 8, pa1); PK4(p1, 0, pa2); PK4(p1, 8, pa3);
#undef PK4
}
constexpr float MLA_SCALE = 0.07216878364870322f;
constexpr float THR = 8.f;
DI void partialSM(f32x16& p0, f32x16& p1, float& m_reg, float& mn, float& alpha) {
    constexpr float C = MLA_SCALE * 1.4426950408889634f;
    float pmax = p0[0];
#pragma unroll
    for (int r = 1; r < 16; ++r) pmax = fmaxf(pmax, p0[r]);
#pragma unroll
    for (int r = 0; r < 16; ++r) pmax = fmaxf(pmax, p1[r]);
    { auto rr = __builtin_amdgcn_permlane32_swap(__float_as_uint(pmax), __float_as_uint(pmax), false, false); pmax = fmaxf(__uint_as_float(rr[0]), __uint_as_float(rr[1])); }
    if (__builtin_expect(__all(pmax - m_reg <= THR / MLA_SCALE), 1)) { mn = m_reg; alpha = 1.f; }
    else { mn = fmaxf(m_reg, pmax); alpha = __builtin_amdgcn_exp2f((m_reg - mn) * C); m_reg = mn; }
    const float mnC = -mn * C;
#pragma unroll
    for (int r = 0; r < 16; ++r) p0[r] = fmaf(p0[r], C, mnC);
#pragma unroll
    for (int r = 0; r < 16; ++r) p1[r] = fmaf(p1[r], C, mnC);
#pragma unroll
    for (int r = 0; r < 16; ++r) p0[r] = __builtin_amdgcn_exp2f(p0[r]);
}
DI void finishSM(f32x16& p0, f32x16& p1, float alpha, float& l_reg, bf16x8& pa0, bf16x8& pa1, bf16x8& pa2, bf16x8& pa3) {
#pragma unroll
    for (int r = 0; r < 16; ++r) p1[r] = __builtin_amdgcn_exp2f(p1[r]);
    float ps = 0;
#pragma unroll
    for (int r = 0; r < 16; ++r) ps += p0[r];
#pragma unroll
    for (int r = 0; r < 16; ++r) ps += p1[r];
    { auto rr = __builtin_amdgcn_permlane32_swap(__float_as_uint(ps), __float_as_uint(ps), false, false); ps = __uint_as_float(rr[0]) + __uint_as_float(rr[1]); }
    l_reg = l_reg * alpha + ps;
    pack_p(p0, p1, pa0, pa1, pa2, pa3);
}
template <int ND0>
DI void qkt(f32x16& p0, f32x16& p1, const char* Ks, const char* Krs, const bf16x8* qr, int r32, int hi, const char* qx = nullptr) {
    p0 = f32x16{}; p1 = f32x16{};
#pragma unroll
    for (int d0 = 0; d0 < 8; ++d0) { const int cb = (d0 * 16 + hi * 8) * 2;
        const bf16x8 b0 = *reinterpret_cast<const bf16x8*>(Ks + KSWZ(r32, cb));
        const bf16x8 b1 = *reinterpret_cast<const bf16x8*>(Ks + KSWZ(32 + r32, cb));
        p0 = __builtin_amdgcn_mfma_f32_32x32x16_bf16(b0, qr[d0], p0, 0, 0, 0);
        p1 = __builtin_amdgcn_mfma_f32_32x32x16_bf16(b1, qr[d0], p1, 0, 0, 0); }
    if (ND0 == 12) {
#pragma unroll
        for (int d0 = 0; d0 < 4; ++d0) { const int cb = (d0 * 16 + hi * 8) * 2;
            const bf16x8 b0 = *reinterpret_cast<const bf16x8*>(Krs + KRSWZ(r32, cb));
            const bf16x8 b1 = *reinterpret_cast<const bf16x8*>(Krs + KRSWZ(32 + r32, cb));
            const bf16x8 qf = *reinterpret_cast<const bf16x8*>(qx + d0 * 1024);
            p0 = __builtin_amdgcn_mfma_f32_32x32x16_bf16(b0, qf, p0, 0, 0, 0);
            p1 = __builtin_amdgcn_mfma_f32_32x32x16_bf16(b1, qf, p1, 0, 0, 0); }
    }
}

DI void mla_body(const bf16_t* __restrict__ Qb, const bf16_t* __restrict__ Kh, const bf16_t* __restrict__ Vh, const bf16_t* __restrict__ Krh, bf16_t* __restrict__ Ob, char* lds) {
    constexpr int LDQ = 3072, LDK = 4096, LDKR = 64, LDO = 2048;
    int tid = threadIdx.x; asm volatile("" : "+v"(tid));
    const int wid = tid >> 6, lane = tid & 63, r32 = lane & 31, hi = lane >> 5;
    char* V_lds = lds; char* K_lds = lds + OFF_K; char* Kr_lds = lds + OFF_KR;
    float* ws = (float*)(lds + OFF_WS) + wid * 64; float* li_l = ws; float* al_l = ws + 32;
    float m_reg = -1e30f, l_reg = 0; f32x16 o[4] = {}; bf16x8 qr[8];
    const bf16_t* Qw = Qb + (long)(wid * QBLK + r32) * LDQ + hi * 8;
    char* qx = lds + OFF_WS + 2048 + wid * 4096 + lane * 16;
#pragma unroll
    for (int d0 = 0; d0 < 8; ++d0) qr[d0] = *reinterpret_cast<const bf16x8*>(Qw + d0 * 16);
#pragma unroll
    for (int d0 = 0; d0 < 4; ++d0) *reinterpret_cast<bf16x8*>(qx + d0 * 1024) = *reinterpret_cast<const bf16x8*>(Qw + (8 + d0) * 16);
    const int sr = tid >> 4, sc = (tid & 15) * 8, vst0 = v_st(sr, sc), vst1 = v_st(32 + sr, sc);
    const int rr = tid >> 3, rc = (tid & 7) * 8;
    const int vb0 = (int)(uintptr_t)V_lds + v_rd_base(lane);
    struct { bf16x8 vs0, vs1, ks0, ks1, kr; } sr_[1];
#define SLOAD(i, k0) do { sr_[i].vs0 = *(const bf16x8*)(&Vh[(long)((k0) + sr) * LDK + sc]); sr_[i].vs1 = *(const bf16x8*)(&Vh[(long)((k0) + 32 + sr) * LDK + sc]); \
    sr_[i].ks0 = *(const bf16x8*)(&Kh[(long)((k0) + sr) * LDK + sc]); sr_[i].ks1 = *(const bf16x8*)(&Kh[(long)((k0) + 32 + sr) * LDK + sc]); \
    sr_[i].kr = *(const bf16x8*)(&Krh[(long)((k0) + rr) * LDKR + rc]); } while (0)
#define SWRITE(b, i) do { *(bf16x8*)(V_lds + (b) * SHM_V + vst0) = sr_[i].vs0; *(bf16x8*)(V_lds + (b) * SHM_V + vst1) = sr_[i].vs1; const int kc = sc * 2; \
    *(bf16x8*)(K_lds + (b) * SHM_K + KSWZ(sr, kc)) = sr_[i].ks0; *(bf16x8*)(K_lds + (b) * SHM_K + KSWZ(32 + sr, kc)) = sr_[i].ks1; \
    *(bf16x8*)(Kr_lds + (b) * SHM_KR + KRSWZ(rr, rc * 2)) = sr_[i].kr; } while (0)
#define SWAIT() asm volatile("s_waitcnt vmcnt(0)" ::: "memory")
#define RESC(a) do { if (__any((a) < 1.f)) { if (hi == 0) al_l[r32] = (a); asm volatile("s_waitcnt lgkmcnt(0)" ::: "memory"); \
    _Pragma("unroll") for (int d = 0; d < 4; ++d) _Pragma("unroll") for (int r = 0; r < 16; ++r) o[d][r] *= al_l[crow(r, hi)]; } } while (0)
    f32x16 pA0, pA1, pB0, pB1; float mnA, mnB, alA, alB; bf16x8 pa0, pa1, pa2, pa3;
    __syncthreads();
    SLOAD(0, 0); SWAIT(); SWRITE(0, 0); __syncthreads();
    qkt<12>(pA0, pA1, K_lds, Kr_lds, qr, r32, hi, qx); partialSM(pA0, pA1, m_reg, mnA, alA);
    SLOAD(0, KVBLK); SWAIT(); SWRITE(1, 0); __syncthreads();
    for (int j = 1; j + 1 < NT; j += 2) {
        SBAR(); qkt<12>(pB0, pB1, K_lds + SHM_K, Kr_lds + SHM_KR, qr, r32, hi, qx);
        finishSM(pA0, pA1, alA, l_reg, pa0, pa1, pa2, pa3); SBAR();
        SLOAD(0, (j + 1) * KVBLK); SBAR();
        pv_d0(o, vb0, pa0, pa1, pa2, pa3); partialSM(pB0, pB1, m_reg, mnB, alB);
        __syncthreads(); SWAIT(); SWRITE(0, 0);
        RESC(alB); __syncthreads();
        SBAR(); qkt<12>(pA0, pA1, K_lds, Kr_lds, qr, r32, hi, qx);
        finishSM(pB0, pB1, alB, l_reg, pa0, pa1, pa2, pa3); SBAR();
        SLOAD(0, (j + 2) * KVBLK); SBAR();
        pv_d0(o, vb0 + (int)SHM_V, pa0, pa1, pa2, pa3); partialSM(pA0, pA1, m_reg, mnA, alA);
        __syncthreads(); SWAIT(); SWRITE(1, 0);
        RESC(alA); __syncthreads();
    }
    SBAR(); qkt<12>(pB0, pB1, K_lds + SHM_K, Kr_lds + SHM_KR, qr, r32, hi, qx);
    finishSM(pA0, pA1, alA, l_reg, pa0, pa1, pa2, pa3); SBAR();
    pv_d0(o, vb0, pa0, pa1, pa2, pa3); partialSM(pB0, pB1, m_reg, mnB, alB);
    __syncthreads(); RESC(alB);
    finishSM(pB0, pB1, alB, l_reg, pa0, pa1, pa2, pa3); SBAR();
    pv_d0(o, vb0 + (int)SHM_V, pa0, pa1, pa2, pa3);
    if (hi == 0) li_l[r32] = l_reg; asm volatile("s_waitcnt lgkmcnt(0)" ::: "memory");
    float rli[16];
#pragma unroll
    for (int r = 0; r < 16; ++r) rli[r] = __builtin_amdgcn_rcpf(li_l[crow(r, hi)]);
    bf16_t* Ow = Ob + (long)(wid * QBLK) * LDO;
    int hio = hi, r32o = r32; asm volatile("" : "+v"(Ow), "+v"(hio), "+v"(r32o));
#pragma unroll
    for (int r = 0; r < 16; ++r) { const int orow = crow(r, hio);
#pragma unroll
        for (int d0 = 0; d0 < 4; ++d0) Ow[(long)orow * LDO + d0 * 32 + r32o] = (bf16_t)(cvt_pk_bf16(o[d0][r] * rli[r], 0.f) & 0xffffu); }
#undef SLOAD
#undef SWRITE
#undef SWAIT
#undef RESC
}

#define UNI(x) __int_as_float(__builtin_amdgcn_readfirstlane(__float_as_int(x)))
struct DecayTab { float af[4], bf[4], ab[4], bb[4], c32f, c32b; };
DI void decayP(f32x16& p0, f32x16& p1, int kt, int irow, int imin, int hi, float lf2, float lb2, const DecayTab& T) {
    if (kt < 4) {
        const float ff = (float)(irow + LC - kt * 64 - 4 * hi), fb = (float)(SEQ + kt * 64 + 4 * hi - irow);
#pragma unroll
        for (int r = 0; r < 16; ++r) { const float kf = (float)((r & 3) + 8 * (r >> 2));
            p0[r] *= __builtin_amdgcn_exp2f(lf2 * (ff - kf)) + __builtin_amdgcn_exp2f(lb2 * (fb + kf));
            p1[r] *= __builtin_amdgcn_exp2f(lf2 * (ff - kf - 32.f)) + __builtin_amdgcn_exp2f(lb2 * (fb + kf + 32.f)); }
    } else {
        const int j0 = (kt - 4) * 64;
        const float fd = (float)(irow - j0 - 4 * hi);
        if (j0 + 63 < imin) {
            const float A = __builtin_amdgcn_exp2f(lf2 * fd); float Ab[4];
#pragma unroll
            for (int q = 0; q < 4; ++q) Ab[q] = A * T.bf[q];
#pragma unroll
            for (int r = 0; r < 16; ++r) { const float w = Ab[r >> 2] * T.af[r & 3]; p0[r] *= w; p1[r] *= w * T.c32f; }
        } else if (j0 > imin + 31) {
            const float A = __builtin_amdgcn_exp2f(-lb2 * fd); float Ab[4];
#pragma unroll
            for (int q = 0; q < 4; ++q) Ab[q] = A * T.bb[q];
#pragma unroll
            for (int r = 0; r < 16; ++r) { const float w = Ab[r >> 2] * T.ab[r & 3]; p0[r] *= w; p1[r] *= w * T.c32b; }
        } else {
#pragma unroll
            for (int r = 0; r < 16; ++r) { const float kf = (float)((r & 3) + 8 * (r >> 2));
                const float d0 = fd - kf, d1 = d0 - 32.f;
                const float e0 = __builtin_amdgcn_exp2f(d0 >= 0.f ? lf2 * d0 : -lb2 * d0), e1 = __builtin_amdgcn_exp2f(d1 >= 0.f ? lf2 * d1 : -lb2 * d1);
                p0[r] *= (d0 == 0.f) ? 2.f : e0; p1[r] *= (d1 == 0.f) ? 2.f : e1; }
        }
    }
}
DI void ret_body(const bf16_t* __restrict__ Qb, const bf16_t* __restrict__ Kh, const bf16_t* __restrict__ Vh, bf16_t* __restrict__ Ob, float* __restrict__ ssq, int irow0, float lf2, float lb2, char* lds) {
    constexpr int LDQ = 1024, LDK = 1024, LDV = 2048, LDO = 2048;
    int tid = threadIdx.x; asm volatile("" : "+v"(tid));
    const int wid = __builtin_amdgcn_readfirstlane(tid >> 6), lane = tid & 63, r32 = lane & 31, hi = lane >> 5;
    char* V_lds = lds; char* K_lds = lds + OFF_K;
    DecayTab T;
#pragma unroll
    for (int m = 0; m < 4; ++m) { T.af[m] = UNI(__builtin_amdgcn_exp2f(-lf2 * (float)m)); T.bf[m] = UNI(__builtin_amdgcn_exp2f(-lf2 * (float)(8 * m))); T.ab[m] = UNI(__builtin_amdgcn_exp2f(lb2 * (float)m)); T.bb[m] = UNI(__builtin_amdgcn_exp2f(lb2 * (float)(8 * m))); }
    T.c32f = UNI(__builtin_amdgcn_exp2f(-lf2 * 32.f)); T.c32b = UNI(__builtin_amdgcn_exp2f(lb2 * 32.f));
    const int imin = irow0 + wid * QBLK;
    f32x16 o[4] = {}; bf16x8 qr[8];
    const bf16_t* Qw = Qb + (long)(wid * QBLK + r32) * LDQ + hi * 8;
#pragma unroll
    for (int d0 = 0; d0 < 8; ++d0) qr[d0] = *reinterpret_cast<const bf16x8*>(Qw + d0 * 16);
    const int irow = irow0 + wid * QBLK + r32;
    const int sr = tid >> 4, sc = (tid & 15) * 8, vst0 = v_st(sr, sc), vst1 = v_st(32 + sr, sc);
    const int vb0 = (int)(uintptr_t)V_lds + v_rd_base(lane);
    struct { bf16x8 vs0, vs1, ks0, ks1; } sr_[1];
#define SLOAD(i, k0) do { sr_[i].vs0 = *(const bf16x8*)(&Vh[(long)((k0) + sr) * LDV + sc]); sr_[i].vs1 = *(const bf16x8*)(&Vh[(long)((k0) + 32 + sr) * LDV + sc]); \
    sr_[i].ks0 = *(const bf16x8*)(&Kh[(long)((k0) + sr) * LDK + sc]); sr_[i].ks1 = *(const bf16x8*)(&Kh[(long)((k0) + 32 + sr) * LDK + sc]); } while (0)
#define SWRITE(b, i) do { *(bf16x8*)(V_lds + (b) * SHM_V + vst0) = sr_[i].vs0; *(bf16x8*)(V_lds + (b) * SHM_V + vst1) = sr_[i].vs1; const int kc = sc * 2; \
    *(bf16x8*)(K_lds + (b) * SHM_K + KSWZ(sr, kc)) = sr_[i].ks0; *(bf16x8*)(K_lds + (b) * SHM_K + KSWZ(32 + sr, kc)) = sr_[i].ks1; } while (0)
#define SWAIT() asm volatile("s_waitcnt vmcnt(0)" ::: "memory")
    f32x16 pA0, pA1, pB0, pB1; bf16x8 pa0, pa1, pa2, pa3;
    __syncthreads();
    SLOAD(0, 0); SWAIT(); SWRITE(0, 0); __syncthreads();
    qkt<8>(pA0, pA1, K_lds, K_lds, qr, r32, hi); decayP(pA0, pA1, 0, irow, imin, hi, lf2, lb2, T);
    SLOAD(0, KVBLK); SWAIT(); SWRITE(1, 0); __syncthreads();
    for (int j = 1; j + 1 < NT; j += 2) {
        SBAR(); qkt<8>(pB0, pB1, K_lds + SHM_K, K_lds, qr, r32, hi);
        pack_p(pA0, pA1, pa0, pa1, pa2, pa3); SBAR();
        SLOAD(0, (j + 1) * KVBLK); SBAR();
        pv_d0(o, vb0, pa0, pa1, pa2, pa3); decayP(pB0, pB1, j, irow, imin, hi, lf2, lb2, T);
        __syncthreads(); SWAIT(); SWRITE(0, 0);
        __syncthreads();
        SBAR(); qkt<8>(pA0, pA1, K_lds, K_lds, qr, r32, hi);
        pack_p(pB0, pB1, pa0, pa1, pa2, pa3); SBAR();
        SLOAD(0, (j + 2) * KVBLK); SBAR();
        pv_d0(o, vb0 + (int)SHM_V, pa0, pa1, pa2, pa3); decayP(pA0, pA1, j + 1, irow, imin, hi, lf2, lb2, T);
        __syncthreads(); SWAIT(); SWRITE(1, 0);
        __syncthreads();
    }
    SBAR(); qkt<8>(pB0, pB1, K_lds + SHM_K, K_lds, qr, r32, hi);
    pack_p(pA0, pA1, pa0, pa1, pa2, pa3); SBAR();
    pv_d0(o, vb0, pa0, pa1, pa2, pa3); decayP(pB0, pB1, NT - 1, irow, imin, hi, lf2, lb2, T);
    __syncthreads();
    pack_p(pB0, pB1, pa0, pa1, pa2, pa3); SBAR();
    pv_d0(o, vb0 + (int)SHM_V, pa0, pa1, pa2, pa3);
    bf16_t* Ow = Ob + (long)(wid * QBLK) * LDO; float* ssw = ssq + (long)(wid * QBLK) * 8;
    int hio = hi, r32o = r32; asm volatile("" : "+v"(Ow), "+v"(ssw), "+v"(hio), "+v"(r32o));
#pragma unroll
    for (int r = 0; r < 16; ++r) { const int orow = crow(r, hio);
        float s = 0.f;
#pragma unroll
        for (int d0 = 0; d0 < 4; ++d0) { s += o[d0][r] * o[d0][r]; Ow[(long)orow * LDO + d0 * 32 + r32o] = (bf16_t)(cvt_pk_bf16(o[d0][r], 0.f) & 0xffffu); }
#pragma unroll
        for (int x = 1; x < 32; x <<= 1) s += __shfl_xor(s, x);
        if (r32o == 0) ssw[(long)orow * 8] = s; }
#undef SLOAD
#undef SWRITE
#undef SWAIT
}
DI void decay32(f32x16& p0, int kt, int irow, int imin, int hi, float lf2, float lb2, const DecayTab& T) {
    if (kt < 8) {
        const float ff = (float)(irow + LC - kt * 32 - 4 * hi), fb = (float)(SEQ + kt * 32 + 4 * hi - irow);
#pragma unroll
        for (int r = 0; r < 16; ++r) { const float kf = (float)((r & 3) + 8 * (r >> 2)); p0[r] *= __builtin_amdgcn_exp2f(lf2 * (ff - kf)) + __builtin_amdgcn_exp2f(lb2 * (fb + kf)); }
    } else {
        const int j0 = (kt - 8) * 32; const float fd = (float)(irow - j0 - 4 * hi);
        if (j0 < imin) {
            const float A = __builtin_amdgcn_exp2f(lf2 * fd); float Ab[4];
#pragma unroll
            for (int q = 0; q < 4; ++q) Ab[q] = A * T.bf[q];
#pragma unroll
            for (int r = 0; r < 16; ++r) p0[r] *= Ab[r >> 2] * T.af[r & 3];
        } else if (j0 > imin) {
            const float A = __builtin_amdgcn_exp2f(-lb2 * fd); float Ab[4];
#pragma unroll
            for (int q = 0; q < 4; ++q) Ab[q] = A * T.bb[q];
#pragma unroll
            for (int r = 0; r < 16; ++r) p0[r] *= Ab[r >> 2] * T.ab[r & 3];
        } else {
#pragma unroll
            for (int r = 0; r < 16; ++r) { const float d0 = fd - (float)((r & 3) + 8 * (r >> 2));
                const float e0 = __builtin_amdgcn_exp2f(d0 >= 0.f ? lf2 * d0 : -lb2 * d0); p0[r] *= (d0 == 0.f) ? 2.f : e0; }
        }
    }
}
template <int D0> DI void pv32_one(f32x16& od, int vb, bf16x8 pa0, bf16x8 pa1) {
    const s16x4 l0 = tr_read<v_rd_off(D0, 0, 0)>(vb), h0 = tr_read<v_rd_off(D0, 0, 1)>(vb), l1 = tr_read<v_rd_off(D0, 1, 0)>(vb), h1 = tr_read<v_rd_off(D0, 1, 1)>(vb);
    asm volatile("s_waitcnt lgkmcnt(0)" ::: "memory"); SBAR();
#define PK(L, H) (bf16x8){L[0], L[1], L[2], L[3], H[0], H[1], H[2], H[3]}
    od = __builtin_amdgcn_mfma_f32_32x32x16_bf16(pa0, PK(l0, h0), od, 0, 0, 0);
    od = __builtin_amdgcn_mfma_f32_32x32x16_bf16(pa1, PK(l1, h1), od, 0, 0, 0);
#undef PK
}
DI void ret_body3(const bf16_t* __restrict__ Qb, const bf16_t* __restrict__ Kh, const bf16_t* __restrict__ Vh, bf16_t* __restrict__ Ob, float* __restrict__ ssq, int irow0, float lf2, float lb2, char* lds) {
    constexpr int LDQ = 1024, LDK = 1024, LDV = 2048, LDO = 2048, KB = 32, NT3 = TT / KB, VIMG = 8192, VBUF = 2 * VIMG, KBUF = 8192, OFFK3 = 2 * VBUF;
    int tid = threadIdx.x; asm volatile("" : "+v"(tid));
    const int wid = __builtin_amdgcn_readfirstlane(tid >> 6), lane = tid & 63, r32 = lane & 31, hi = lane >> 5;
    char* V_lds = lds; char* K_lds = lds + OFFK3;
    DecayTab T;
#pragma unroll
    for (int m = 0; m < 4; ++m) { T.af[m] = UNI(__builtin_amdgcn_exp2f(-lf2 * (float)m)); T.bf[m] = UNI(__builtin_amdgcn_exp2f(-lf2 * (float)(8 * m))); T.ab[m] = UNI(__builtin_amdgcn_exp2f(lb2 * (float)m)); T.bb[m] = UNI(__builtin_amdgcn_exp2f(lb2 * (float)(8 * m))); }
    T.c32f = 0.f; T.c32b = 0.f;
    const int imin = irow0 + wid * QBLK;
    f32x16 o[8] = {}; bf16x8 qr[8];
    const bf16_t* Qw = Qb + (long)(wid * QBLK + r32) * LDQ + hi * 8;
#pragma unroll
    for (int d0 = 0; d0 < 8; ++d0) qr[d0] = *reinterpret_cast<const bf16x8*>(Qw + d0 * 16);
    const int irow = irow0 + wid * QBLK + r32;
    const int sr = tid >> 4, sc = (tid & 15) * 8, vst0 = v_st(sr, sc), kst0 = KSWZ(sr, sc * 2);
    const int vb0 = (int)(uintptr_t)V_lds + v_rd_base(lane);
    bf16x8 vsa, vsb, ks;
#define SLOAD3(k0) do { vsa = *(const bf16x8*)(&Vh[(long)((k0) + sr) * LDV + sc]); vsb = *(const bf16x8*)(&Vh[(long)((k0) + sr) * LDV + 128 + sc]); ks = *(const bf16x8*)(&Kh[(long)((k0) + sr) * LDK + sc]); } while (0)
#define SWRITE3(b) do { *(bf16x8*)(V_lds + (b) * VBUF + vst0) = vsa; *(bf16x8*)(V_lds + (b) * VBUF + VIMG + vst0) = vsb; *(bf16x8*)(K_lds + (b) * KBUF + kst0) = ks; } while (0)
    f32x16 p0; bf16x8 pa0, pa1;
    __syncthreads();
    SLOAD3(0); asm volatile("s_waitcnt vmcnt(0)" ::: "memory"); SWRITE3(0); __syncthreads();
    for (int j = 0; j < NT3; ++j) {
        const int bsel = j & 1;
        if (j + 1 < NT3) SLOAD3((j + 1) * KB);
        SBAR();
        { const char* Ks = K_lds + bsel * KBUF; p0 = f32x16{};
#pragma unroll
          for (int d0 = 0; d0 < 8; ++d0) { const bf16x8 b0 = *reinterpret_cast<const bf16x8*>(Ks + KSWZ(r32, (d0 * 16 + hi * 8) * 2)); p0 = __builtin_amdgcn_mfma_f32_32x32x16_bf16(b0, qr[d0], p0, 0, 0, 0); } }
        decay32(p0, j, irow, imin, hi, lf2, lb2, T);
        {
#define PK4(P, BASE, OUT) do { unsigned a0 = cvt_pk_bf16(P[BASE + 0], P[BASE + 1]), a1 = cvt_pk_bf16(P[BASE + 2], P[BASE + 3]);   \
    unsigned b0 = cvt_pk_bf16(P[BASE + 4], P[BASE + 5]), b1 = cvt_pk_bf16(P[BASE + 6], P[BASE + 7]);                              \
    auto r0 = __builtin_amdgcn_permlane32_swap(a0, b0, false, false); auto r1 = __builtin_amdgcn_permlane32_swap(a1, b1, false, false); \
    u32x4 w = {r0[0], r1[0], r0[1], r1[1]}; OUT = *reinterpret_cast<bf16x8*>(&w); } while (0)
          PK4(p0, 0, pa0); PK4(p0, 8, pa1);
#undef PK4
        }
        SBAR();
        { const int vb = vb0 + bsel * VBUF;
          pv32_one<0>(o[0], vb, pa0, pa1); pv32_one<1>(o[1], vb, pa0, pa1); pv32_one<2>(o[2], vb, pa0, pa1); pv32_one<3>(o[3], vb, pa0, pa1);
          pv32_one<0>(o[4], vb + VIMG, pa0, pa1); pv32_one<1>(o[5], vb + VIMG, pa0, pa1); pv32_one<2>(o[6], vb + VIMG, pa0, pa1); pv32_one<3>(o[7], vb + VIMG, pa0, pa1); }
        if (j + 1 < NT3) { asm volatile("s_waitcnt vmcnt(0)" ::: "memory"); SWRITE3(bsel ^ 1); }
        __syncthreads();
    }
    bf16_t* Ow = Ob + (long)(wid * QBLK) * LDO; float* ssw = ssq + (long)(wid * QBLK) * 8;
    int hio = hi, r32o = r32; asm volatile("" : "+v"(Ow), "+v"(ssw), "+v"(hio), "+v"(r32o));
#pragma unroll
    for (int r = 0; r < 16; ++r) { const int orow = crow(r, hio);
        float s = 0.f;
#pragma unroll
        for (int d0 = 0; d0 < 8; ++d0) { s += o[d0][r] * o[d0][r]; Ow[(long)orow * LDO + d0 * 32 + r32o] = (bf16_t)(cvt_pk_bf16(o[d0][r], 0.f) & 0xffffu); }
#pragma unroll
        for (int x = 1; x < 32; x <<= 1) s += __shfl_xor(s, x);
        if (r32o == 0) ssw[(long)orow * 8] = s; }
#undef SLOAD3
#undef SWRITE3
}
}

DI int rope128perm(int vv) { const int wc = vv >> 5, fq = (vv >> 3) & 3, n = (vv >> 2) & 1, j = vv & 3; const int p = (wc * 4 + fq) * 4 + j; return (p >> 5) * 64 + n * 32 + (p & 31); }
DI int rope32perm(int vv) { const int fq = vv >> 3, n = (vv >> 2) & 1, j = vv & 3; return n * 16 + fq * 4 + j; }
DI int src_col(int mode, int v) {
    if (mode == 0) return v;
    if (mode == 1) {
        if (v < 1024) return (v & ~127) + rope128perm(v & 127);
        if (v < 3584) return v;
        if (v < 3840) { const int vv = v - 3584; return vv < 64 ? 3584 + (vv & ~31) + rope32perm(vv & 31) : -1; }
        if (v < 4864) { const int vv = v - 3840; return 3648 + (vv & ~127) + rope128perm(vv & 127); }
        return v - 192;
    }
    if (mode == 3) { const int pn = v >> 8, bj = (v >> 7) & 1, i = v & 127; return (bj ? FFN : 0) + pn * 128 + i; }
    const int g = v >> 5, gi = g % 6; return gi < 4 ? v : (v & ~31) + rope32perm(v & 31);
}
DI void conv_weight(const float* __restrict__ W, int ldw, bf16_t* __restrict__ Bt, int K, int N, int mode, const float* __restrict__ kscale, int rot, unsigned* lds32) {
    int tid = threadIdx.x; asm volatile("" : "+v"(tid));
    const int G = gridDim.x, nkt = K / 128, ntiles = (N / 128) * nkt;
    for (int t = (int)((blockIdx.x + G - (rot % G)) % G); t < ntiles; t += G) {
        const int n0 = (t / nkt) * 128, k0 = (t % nkt) * 128;
        { const int nn = tid & 127, kq = tid >> 7; const int scol = src_col(mode, n0 + nn);
#pragma unroll 4
          for (int i = 0; i < 16; ++i) { const int kp = kq + 4 * i, k = k0 + 2 * kp; float a = 0.f, b = 0.f;
              if (scol >= 0) { a = W[(size_t)k * ldw + scol]; b = W[(size_t)(k + 1) * ldw + scol]; }
              if (kscale) { a *= kscale[k]; b *= kscale[k + 1]; }
              lds32[nn * 68 + kp] = cvt_pk_bf16(a, b); } }
        __syncthreads();
        { const int n = tid >> 2, seg = tid & 3;
#pragma unroll
          for (int q = 0; q < 4; ++q) { const u32x4 w = *(const u32x4*)(lds32 + n * 68 + seg * 16 + q * 4); *(u32x4*)(Bt + (size_t)(n0 + n) * K + k0 + seg * 32 + q * 8) = w; } }
        __syncthreads();
    }
}

template <int MODE>
DI void rows_norm(const Params& p, const float* mod) {
    int tid = threadIdx.x; asm volatile("" : "+v"(tid));
    const int lane = tid & 63, gw = blockIdx.x * 8 + (tid >> 6), nw = gridDim.x * 8;
    const int nrows = MODE == 0 ? MROWS : SROWS; const int per = (nrows + nw - 1) / nw;
    float sc[32], sh[32]; int cur = -1;
    if (MODE == 2) {
#pragma unroll
        for (int i = 0; i < 8; ++i) { const f32x4 w = *(const f32x4*)(p.final_norm + i * 256 + lane * 4); sc[i * 4] = w[0]; sc[i * 4 + 1] = w[1]; sc[i * 4 + 2] = w[2]; sc[i * 4 + 3] = w[3]; }
    }
    for (int row = gw * per; row < (gw + 1) * per && row < nrows; ++row) {
        const float* src; int mr;
        if (MODE == 0) { const int b = row / TT, t = row % TT; if (t < LC) { src = p.ctx + ((size_t)b * LC + t) * DM; mr = 8; } else { src = p.x + ((size_t)b * SEQ + t - LC) * DM; mr = b; } }
        else { src = p.out + (size_t)row * DM; mr = row / SEQ; }
        if (MODE != 2 && mr != cur) { cur = mr; const int csh = MODE == 0 ? 0 : 3, csc = csh + 1;
#pragma unroll
            for (int i = 0; i < 8; ++i) { const int c = i * 256 + lane * 4;
                const f32x4 a = *(const f32x4*)(mod + mr * 12288 + csc * 2048 + c) + *(const f32x4*)(p.b_ada + csc * 2048 + c);
                const f32x4 s = *(const f32x4*)(mod + mr * 12288 + csh * 2048 + c) + *(const f32x4*)(p.b_ada + csh * 2048 + c);
#pragma unroll
                for (int j = 0; j < 4; ++j) { sc[i * 4 + j] = 1.f + a[j]; sh[i * 4 + j] = s[j]; } } }
        f32x4 v[8]; float ss = 0.f;
#pragma unroll
        for (int i = 0; i < 8; ++i) { v[i] = *(const f32x4*)(src + i * 256 + lane * 4); ss += v[i][0] * v[i][0] + v[i][1] * v[i][1] + v[i][2] * v[i][2] + v[i][3] * v[i][3]; }
        ss = wave_sum(ss); float rstd = __builtin_amdgcn_rsqf(ss * (1.f / DM) + EPS);
#if MK_DEBUG
        if (MODE == 2) { const float* dbg = (const float*)(p.ws + WS_DBG); int first = -1; for (int k = 15; k >= 0; --k) if (dbg[k] > 0.08f) first = k; rstd *= 1.f + 0.1f * (float)(first + 1); }
#endif
        if (MODE == 2) {
#pragma unroll
            for (int i = 0; i < 8; ++i) { f32x4 o; o[0] = v[i][0] * rstd * sc[i * 4]; o[1] = v[i][1] * rstd * sc[i * 4 + 1]; o[2] = v[i][2] * rstd * sc[i * 4 + 2]; o[3] = v[i][3] * rstd * sc[i * 4 + 3];
                *(f32x4*)(p.out + (size_t)row * DM + i * 256 + lane * 4) = o; }
        } else {
            bf16_t* dst = (bf16_t*)(p.ws + (MODE == 0 ? WS_HBUF : WS_H2)) + (size_t)row * DM;
#pragma unroll
            for (int i = 0; i < 8; ++i) { u32x2 w; w.x = cvt_pk_bf16(v[i][0] * rstd * sc[i * 4] + sh[i * 4], v[i][1] * rstd * sc[i * 4 + 1] + sh[i * 4 + 1]);
                w.y = cvt_pk_bf16(v[i][2] * rstd * sc[i * 4 + 2] + sh[i * 4 + 2], v[i][3] * rstd * sc[i * 4 + 3] + sh[i * 4 + 3]);
                *(u32x2*)(dst + i * 256 + lane * 4) = w; }
        }
    }
}


#if MK_DEBUG
DI unsigned hsh(unsigned x) { x ^= x >> 16; x *= 0x7feb352dU; x ^= x >> 15; x *= 0x846ca68bU; x ^= x >> 16; return x; }
DI void dbg_report(float* dbg, int k, float err) { if ((threadIdx.x & 63) == 0) atomicMax((int*)dbg + k, __float_as_int(fabsf(err))); }
DI float bfr(float x) { return bf_lo(cvt_pk_bf16(x, 0.f)); }
DI float bfv(const bf16_t* p, size_t i) { return __uint_as_float(((unsigned)p[i]) << 16); }
DI int samp_s(int si) { const int q = (si >> 3) & 7; return si < 64 ? (q == 0 ? 0 : q == 1 ? 1 : q == 2 ? 63 : q == 3 ? 64 : q == 4 ? 255 : q == 5 ? 256 : q == 6 ? 1024 : 2047) : (int)(hsh(si * 77 + 5) & 2047); }
DI float relerr(float ref, float got, float floor_) { return fabsf(ref - got) / (fabsf(ref) + floor_); }
DI float wdot(const bf16_t* A, int K, const float* W, int ldw, int col, const float* ks) {
    const int lane = threadIdx.x & 63; float a = 0.f;
    for (int k = lane; k < K; k += 64) a += bfv(A, k) * bfr(W[(size_t)k * ldw + col] * (ks ? ks[k] : 1.f));
    return wave_sum(a);
}
DI void rope_ref(float t1, float t2, float pos, int f, float q4, bool on, float& o1, float& o2) {
    const float ang = pos * __builtin_amdgcn_exp2f(-(float)f * 13.287712379549449f / q4); const float c = on ? __cosf(ang) : 1.f, sn = on ? __sinf(ang) : 0.f;
    o1 = t1 * c - t2 * sn; o2 = t2 * c + t1 * sn;
}
__global__ __launch_bounds__(512) void dbg_kernel(Params p, int ph) {
    const int bid = blockIdx.x;
    unsigned char* ws = p.ws; float* dbg = (float*)(ws + WS_DBG); const float* mod = (const float*)(ws + WS_MOD);
    float* sav = (float*)(ws + 655360);
    const int lane = threadIdx.x & 63, wid = threadIdx.x >> 6;
    for (int rnd = 0; rnd < 9; ++rnd) {
    const int si = rnd * 2048 + bid * 8 + wid;
    const unsigned hh = hsh(si * 2654435761u + ph * 97u);
    const bool okS = si < SROWS;
    const int b = (si >> 11) & 7, s = si & 2047;
    const int bT = si / TT, t = si % TT;
    if (ph == 1 && rnd == 0) {
        for (int q = 0; q < 54; ++q) { const int e = (si * 54 + q); if (e < 9 * 12288) { const int r = e / 12288, n = e % 12288; float a = 0.f;
            for (int k = lane; k < 2048; k += 64) { const float xv = r < 8 ? p.c[r * 2048 + k] : p.c_ctx[k]; a += xv / (1.f + expf(-xv)) * p.w_ada[(size_t)k * 12288 + n]; }
            a = wave_sum(a); dbg_report(dbg, 0, relerr(a, mod[r * 12288 + n], 0.05f)); } }
    }
    if (ph == 2 || (ph == 9 && okS)) {
        const bool isH = ph == 2;
        const float* src; int mr; size_t drow; const bf16_t* dst;
        if (isH) { if (t < LC) { src = p.ctx + ((size_t)bT * LC + t) * DM; mr = 8; } else { src = p.x + ((size_t)bT * SEQ + t - LC) * DM; mr = bT; } drow = (size_t)si; dst = (const bf16_t*)(ws + WS_HBUF); }
        else { src = p.out + (size_t)si * DM; mr = b; drow = (size_t)si; dst = (const bf16_t*)(ws + WS_H2); }
        float ss = 0.f; for (int k = lane; k < DM; k += 64) ss += src[k] * src[k]; ss = wave_sum(ss); const float rstd = 1.f / sqrtf(ss / DM + EPS);
        const int csh = isH ? 0 : 3, csc = csh + 1; float e = 0.f;
        for (int k = lane; k < DM; k += 64) { const float ref = src[k] * rstd * (1.f + mod[mr * 12288 + csc * 2048 + k] + p.b_ada[csc * 2048 + k]) + mod[mr * 12288 + csh * 2048 + k] + p.b_ada[csh * 2048 + k];
            e = fmaxf(e, relerr(ref, bfv(dst, drow * DM + k), 1.f)); }
        for (int o = 32; o > 0; o >>= 1) e = fmaxf(e, __shfl_xor(e, o));
        dbg_report(dbg, isH ? 1 : 8, e);
    }
    if (ph == 3) {
      for (int rep = 0; rep < 2; ++rep) {
        const unsigned hr = hsh(hh + rep * 1234567u);
        const bool latent = t >= LC; const int seg = latent ? (int)((hr >> 8) % 9u) : (int)((hr >> 8) % 4u);
        const size_t trow = (size_t)si, srow = (size_t)bT * SEQ + (t - LC); const int sp = t - LC;
        const bf16_t* hrow = (const bf16_t*)(ws + WS_HBUF) + trow * DM; const unsigned h2 = hsh(hr);
        float e = 0.f;
        if (seg == 0 || seg == 4) { const int head = h2 & 7, half = (h2 >> 3) & 1, f = (h2 >> 4) & 31, base = (seg == 0 ? 0 : 3648) + head * 128 + half * 64 + f;
            const float t1 = wdot(hrow, DM, p.w_in, INCOLS, base, nullptr), t2 = wdot(hrow, DM, p.w_in, INCOLS, base + 32, nullptr); float o1, o2;
            rope_ref(t1, t2, (float)(half ? (sp & 63) : (sp >> 6)), f, 32.f, latent, o1, o2); const float sc = seg == 0 ? 0.08838834764831845f : 1.f;
            const bf16_t* dst = seg == 0 ? (const bf16_t*)(ws + WS_RK) + trow * 1024 : (const bf16_t*)(ws + WS_RQ) + srow * 1024; const int dc = head * 128 + half * 64 + f;
            e = fmaxf(relerr(o1 * sc, bfv(dst, dc), 0.05f * sc), relerr(o2 * sc, bfv(dst, dc + 32), 0.05f * sc)); }
        else if (seg == 3) { const int g = h2 & 1, f = (h2 >> 1) & 15, base = 3584 + g * 32 + f;
            const float t1 = wdot(hrow, DM, p.w_in, INCOLS, base, nullptr), t2 = wdot(hrow, DM, p.w_in, INCOLS, base + 16, nullptr); float o1, o2;
            rope_ref(t1, t2, (float)(g ? (sp & 63) : (sp >> 6)), f, 16.f, latent, o1, o2); const bf16_t* dst = (const bf16_t*)(ws + WS_KR) + trow * 64 + g * 32 + f;
            e = fmaxf(relerr(o1, bfv(dst, 0), 0.05f), relerr(o2, bfv(dst, 16), 0.05f)); }
        else { int oc, dc; const bf16_t* dst; size_t ld; size_t row; int act = 0;
            if (seg == 1) { dc = h2 % 2048u; oc = 1024 + dc; dst = (const bf16_t*)(ws + WS_RV); ld = 2048; row = trow; }
            else if (seg == 2) { dc = h2 % 512u; oc = 3072 + dc; dst = (const bf16_t*)(ws + WS_KVD); ld = 512; row = trow; }
            else if (seg == 5) { dc = h2 % 2048u; oc = 4672 + dc; dst = (const bf16_t*)(ws + WS_RG); ld = 2048; row = srow; act = 1; }
            else if (seg == 6) { dc = h2 % 512u; oc = 6720 + dc; dst = (const bf16_t*)(ws + WS_QD); ld = 512; row = srow; }
            else if (seg == 7) { dc = h2 % 2048u; oc = 7232 + dc; dst = (const bf16_t*)p.out; ld = 2048; row = srow; act = 2; }
            else { dc = h2 % 2048u; oc = 9280 + dc; dst = (const bf16_t*)p.out + (size_t)SROWS * 2048; ld = 2048; row = srow; act = 2; }
            float z = wdot(hrow, DM, p.w_in, INCOLS, oc, nullptr); if (act == 1) z = z / (1.f + expf(-z)); if (act == 2) z = 1.f / (1.f + expf(-z));
            e = relerr(z, bfv(dst, row * ld + dc), 0.05f); }
        dbg_report(dbg, 16 + seg + (latent ? 0 : 9), e);
        if (seg == 7 && latent && e > 0.08f && lane == 0) { atomicAdd((int*)dbg + 40, 1); atomicMax((int*)dbg + 41, 1000 - (int)(srow >> 8)); atomicMax((int*)dbg + 42, (int)(srow >> 8)); }
      }
    }
    if (ph == 4 && okS) {
        const int h = (hh >> 4) & 7, ecol = (hh >> 8) & 255; const size_t srow = (size_t)si;
        const bf16_t* q = (const bf16_t*)(ws + WS_RQ) + srow * 1024 + h * 128; const bf16_t* K = (const bf16_t*)(ws + WS_RK) + (size_t)b * TT * 1024 + h * 128; const bf16_t* V = (const bf16_t*)(ws + WS_RV) + (size_t)b * TT * 2048 + h * 256 + ecol;
        const float xf = p.dec_f[h], xb = p.dec_b[h]; const float lf = fminf(xf, 0.f) - log1pf(expf(-fabsf(xf))), lb = fminf(xb, 0.f) - log1pf(expf(-fabsf(xb)));
        float acc = 0.f, nrm = 0.f;
        for (int tt = lane; tt < TT; tt += 64) { float d = 0.f; for (int k = 0; k < 128; ++k) d += bfv(q, k) * bfv(K, (size_t)tt * 1024 + k);
            float w; if (tt < LC) w = expf(lf * (float)(s + LC - tt)) + expf(lb * (float)(SEQ + tt - s)); else { const int j = tt - LC; w = j < s ? expf(lf * (float)(s - j)) : j > s ? expf(lb * (float)(j - s)) : 2.f; }
            const float term = w * d * bfv(V, (size_t)tt * 2048); acc += term; nrm += term * term; }
        acc = wave_sum(acc); nrm = wave_sum(nrm);
        dbg_report(dbg, 3, fabsf(acc - bfv((const bf16_t*)(ws + WS_ORET), srow * 2048 + h * 256 + ecol)) / (fabsf(acc) + 0.25f * sqrtf(nrm) + 1e-6f));
        const bf16_t* o = (const bf16_t*)(ws + WS_ORET) + srow * 2048 + h * 256;
        float ss = 0.f; for (int k = lane; k < 256; k += 64) ss += bfv(o, k) * bfv(o, k); ss = wave_sum(ss);
        const float ref = bfv(o, ecol) / sqrtf(ss / 256.f + EPS) * p.ret_gn[h * 256 + ecol] * bfv((const bf16_t*)(ws + WS_RG), srow * 2048 + h * 256 + ecol);
        if (lane == 0) sav[si] = ref;
    }
    if (ph == 5) {
        if (okS) { const size_t srow = (size_t)si; const bf16_t* qd = (const bf16_t*)(ws + WS_QD) + srow * 512; float ss = 0.f; for (int k = lane; k < 512; k += 64) ss += bfv(qd, k) * bfv(qd, k); ss = wave_sum(ss); const float rstd = 1.f / sqrtf(ss / 512.f + EPS);
            const int head = (hh >> 4) & 15; const bf16_t* dst = (const bf16_t*)(ws + WS_QM) + srow * 3072 + head * 192; float e;
            if (hh & 1) { const int d = (hh >> 8) & 127; e = relerr(rstd * wdot(qd, 512, p.w_q_up, 3072, head * 192 + d, p.q_norm), bfv(dst, d), 0.05f); }
            else { const int g = (hh >> 8) & 1, f = (hh >> 9) & 15, base = head * 192 + 128 + g * 32 + f; float o1, o2;
                rope_ref(rstd * wdot(qd, 512, p.w_q_up, 3072, base, p.q_norm), rstd * wdot(qd, 512, p.w_q_up, 3072, base + 16, p.q_norm), (float)(g ? (s & 63) : (s >> 6)), f, 16.f, true, o1, o2);
                e = fmaxf(relerr(o1, bfv(dst, 128 + g * 32 + f), 0.05f), relerr(o2, bfv(dst, 128 + g * 32 + 16 + f), 0.05f)); }
            dbg_report(dbg, 4, e);
            const unsigned h4 = hsh(si * 2654435761u + 4 * 97u); const int hq = (h4 >> 4) & 7, eq = (h4 >> 8) & 255;
            dbg_report(dbg, 10, relerr(sav[si], bfv((const bf16_t*)(ws + WS_ORET), srow * 2048 + hq * 256 + eq), 0.03f)); }
        { const size_t trow = (size_t)si; const bf16_t* kd = (const bf16_t*)(ws + WS_KVD) + trow * 512; float ss = 0.f; for (int k = lane; k < 512; k += 64) ss += bfv(kd, k) * bfv(kd, k); ss = wave_sum(ss); const float rstd = 1.f / sqrtf(ss / 512.f + EPS);
            const int c = (hh >> 14) & 4095; dbg_report(dbg, 4, relerr(rstd * wdot(kd, 512, p.w_kv_up, 4096, c, p.kv_norm), bfv((const bf16_t*)(ws + WS_KVUP), trow * 4096 + c), 0.05f)); }
    }
    if (ph == 6 && okS) {
        const int h = (hh >> 4) & 15, ecol = (hh >> 8) & 127; const size_t srow = (size_t)si;
        const bf16_t* q = (const bf16_t*)(ws + WS_QM) + srow * 3072 + h * 192; const bf16_t* KV = (const bf16_t*)(ws + WS_KVUP) + (size_t)b * TT * 4096 + h * 256; const bf16_t* KR = (const bf16_t*)(ws + WS_KR) + (size_t)b * TT * 64;
        float mx = -1e30f;
        for (int i = 0; i < 36; ++i) { const int tt = lane + 64 * i; float d = 0.f; for (int k = 0; k < 128; ++k) d += bfv(q, k) * bfv(KV, (size_t)tt * 4096 + k); for (int k = 0; k < 64; ++k) d += bfv(q, 128 + k) * bfv(KR, (size_t)tt * 64 + k);
            mx = fmaxf(mx, d * 0.07216878364870322f); }
        for (int o = 32; o > 0; o >>= 1) mx = fmaxf(mx, __shfl_xor(mx, o));
        float l = 0.f, acc = 0.f;
        for (int i = 0; i < 36; ++i) { const int tt = lane + 64 * i; float d = 0.f; for (int k = 0; k < 128; ++k) d += bfv(q, k) * bfv(KV, (size_t)tt * 4096 + k); for (int k = 0; k < 64; ++k) d += bfv(q, 128 + k) * bfv(KR, (size_t)tt * 64 + k);
            const float pe = expf(d * 0.07216878364870322f - mx); l += pe; acc += pe * bfv(KV, (size_t)tt * 4096 + 128 + ecol); }
        l = wave_sum(l); acc = wave_sum(acc);
        dbg_report(dbg, 5, relerr(acc / l, bfv((const bf16_t*)(ws + WS_MLAO), srow * 2048 + h * 128 + ecol), 0.02f));
    }
    if (ph == 7 && okS) {
        const size_t srow = (size_t)si; const int c = (hh >> 4) & 2047;
        const float r1 = wdot((const bf16_t*)(ws + WS_ORET) + srow * 2048, 2048, p.w_ret_o, 2048, c, nullptr), r2 = wdot((const bf16_t*)(ws + WS_MLAO) + srow * 2048, 2048, p.w_mla_o, 2048, c, nullptr);
        const float ref = bfv((const bf16_t*)p.out, srow * 2048 + c) * r1 + bfv((const bf16_t*)p.out + (size_t)SROWS * 2048, srow * 2048 + c) * r2;
        dbg_report(dbg, 6, relerr(ref, bfv((const bf16_t*)(ws + WS_MIXED), srow * 2048 + c), 0.03f));
    }
    if (ph == 8 && okS) {
        const size_t srow = (size_t)si; const int c = (hh >> 4) & 2047;
        const float r = wdot((const bf16_t*)(ws + WS_MIXED) + srow * 2048, 2048, p.w_out, 2048, c, nullptr);
        const float refd = (mod[b * 12288 + 2 * 2048 + c] + p.b_ada[2 * 2048 + c]) * r;
        dbg_report(dbg, 7, relerr(refd, p.out[srow * 2048 + c] - p.x[srow * 2048 + c], 0.01f));
    }
    if (ph == 10 && okS) {
        const size_t srow = (size_t)si; const int c = (int)((hh >> 4) % 11264u);
        const float r = wdot((const bf16_t*)(ws + WS_H2) + srow * 2048, 2048, p.w_up, 2 * FFN, c, nullptr);
        const float got = c < FFN ? bfv((const bf16_t*)(ws + WS_ABUF), srow * FFN + c) : bfv((const bf16_t*)(ws + WS_VBUF), srow * FFN + c - FFN);
        dbg_report(dbg, 9, relerr(r, got, 0.05f));
        const int cu = (int)((hh >> 8) % 5632u); const bf16_t* ab = (const bf16_t*)(ws + WS_ABUF);
        const float am = s > 0 ? bfv(ab, (srow - 1) * FFN + cu) : 0.f, a0 = bfv(ab, srow * FFN + cu), ap = s < SEQ - 1 ? bfv(ab, (srow + 1) * FFN + cu) : 0.f;
        const float z = p.conv_b[cu] + p.conv_w[cu] * am + p.conv_w[FFN + cu] * a0 + p.conv_w[2 * FFN + cu] * ap;
        if (lane == 0) sav[16384 + si] = z / (1.f + expf(-z)) * bfv((const bf16_t*)(ws + WS_VBUF), srow * FFN + cu);
    }
    if (ph == 11 && okS) {
        const size_t srow = (size_t)si; const unsigned h10 = hsh(si * 2654435761u + 10 * 97u); const int c10 = (int)((h10 >> 8) % 5632u);
        dbg_report(dbg, 11, relerr(sav[16384 + si], bfv((const bf16_t*)(ws + WS_VBUF), srow * FFN + c10), 0.03f));
        const int c = (hh >> 4) & 2047; const float r = wdot((const bf16_t*)(ws + WS_VBUF) + srow * FFN, FFN, p.w_down, 2048, c, nullptr);
        if (lane == 0) { sav[2 * 16384 + si] = (mod[b * 12288 + 5 * 2048 + c] + p.b_ada[5 * 2048 + c]) * r; sav[3 * 16384 + si] = p.out[srow * 2048 + c]; }
    }
    if (ph == 12 && okS) {
        const size_t srow = (size_t)si; const unsigned h11 = hsh(si * 2654435761u + 11 * 97u); const int c11 = (h11 >> 4) & 2047;
        dbg_report(dbg, 12, relerr(sav[2 * 16384 + si], p.out[srow * 2048 + c11] - sav[3 * 16384 + si], 0.02f));
        const float* xr = p.out + srow * 2048; float ss = 0.f; for (int k = lane; k < DM; k += 64) ss += xr[k] * xr[k]; ss = wave_sum(ss);
        (void)ss;
        dbg_report(dbg, 14, 1.0f);
    }
    }
}
#endif

__global__ __launch_bounds__(512, 2) void fwd_megakernel(Params p) {
    extern __shared__ __attribute__((aligned(16))) unsigned char shm[];
    LAS unsigned char* lds = (LAS unsigned char*)shm;
    unsigned char* ws = p.ws;
    const int G = gridDim.x;
    float* mod = (float*)(ws + WS_MOD); float* ssq_kv = (float*)(ws + WS_SSQKV); float* ssq_q = (float*)(ws + WS_SSQQ); float* ssq_ret = (float*)(ws + WS_SSQRET);
    volatile LAS unsigned* xst = (volatile LAS unsigned*)(lds + pg8::STAGE_BYTES);
    if (threadIdx.x < 2) xst[threadIdx.x] = 0u;
    __syncthreads();
    const XcdBarrier xb = xcd_barrier_post((unsigned*)(ws + WS_BAR), xst);
    for (int ph = p.ph_lo; ph < p.ph_hi; ++ph) {
        if (ph > p.ph_lo) { if (ph > 1000) cg::this_grid().sync(); else xcd_barrier(xb); }
        for (int rep = 0; rep < (ph == MK_REP ? 2 : 1); ++rep) {
        int bid = blockIdx.x; asm volatile("" : "+s"(bid));
#define LOCAL_TID int tid = threadIdx.x; asm volatile("" : "+v"(tid))
        switch (ph) {
        case 0: if (PH_ON(0)) {
            unsigned* l32 = (unsigned*)shm; int rot = 0;
            conv_weight(p.w_in, INCOLS, (bf16_t*)(ws + WS_WIN), 2048, NIN, 1, nullptr, rot, l32); rot += (NIN / 128) * 16;
            conv_weight(p.w_q_up, 3072, (bf16_t*)(ws + WS_WQUP), 512, 3072, 2, p.q_norm, rot, l32); rot += 24 * 4;
            conv_weight(p.w_kv_up, 4096, (bf16_t*)(ws + WS_WKVUP), 512, 4096, 0, p.kv_norm, rot, l32); rot += 32 * 4;
            conv_weight(p.w_ret_o, 2048, (bf16_t*)(ws + WS_WRETO), 2048, 2048, 0, nullptr, rot, l32); rot += 256;
            conv_weight(p.w_mla_o, 2048, (bf16_t*)(ws + WS_WMLAO), 2048, 2048, 0, nullptr, rot, l32); rot += 256;
            conv_weight(p.w_out, 2048, (bf16_t*)(ws + WS_WOUT), 2048, 2048, 0, nullptr, rot, l32);
            float* sl = (float*)shm;
            LOCAL_TID;
            for (int it = bid; it < 768; it += G) {
                const int k0 = (it / 24) * 64, n = (it % 24) * 512 + tid;
                __syncthreads();
                for (int e = tid; e < 576; e += 512) { const int r = e >> 6, kk = e & 63; const float xv = r < 8 ? p.c[r * 2048 + k0 + kk] : p.c_ctx[k0 + kk]; sl[e] = siluf_(xv); }
                __syncthreads();
                float a[9];
#pragma unroll
                for (int r = 0; r < 9; ++r) a[r] = 0.f;
#pragma unroll 8
                for (int kk = 0; kk < 64; ++kk) { const float w = p.w_ada[(size_t)(k0 + kk) * 12288 + n];
#pragma unroll
                    for (int r = 0; r < 9; ++r) a[r] += sl[r * 64 + kk] * w; }
#pragma unroll
                for (int r = 0; r < 9; ++r) atomicAdd(mod + r * 12288 + n, a[r]);
            }
        } break;
        case 1: if (PH_ON(1)) rows_norm<0>(p, mod); break;
        case 2: if (PH_ON(2)) {
            pg8::Gemm g{(const bf16_t*)(ws + WS_HBUF), (const bf16_t*)(ws + WS_WIN), 2048};
            pg8::Sched<2> S{0, 0, G, bid};
            EpiInProj E{(bf16_t*)(ws + WS_RK), (bf16_t*)(ws + WS_RV), (bf16_t*)(ws + WS_KVD), (bf16_t*)(ws + WS_KR), (bf16_t*)(ws + WS_RQ), (bf16_t*)(ws + WS_RG), (bf16_t*)(ws + WS_QD),
                        (bf16_t*)p.out, (bf16_t*)p.out + (size_t)SROWS * 2048, ssq_kv, ssq_q, (bf16_t*)(ws + WS_ORET)};
            pg8::gemm_phase(lds, g, S, E);
        } break;
        case 3: if (PH_ON(3)) {
            const bf16_t* rq = (const bf16_t*)(ws + WS_RQ); const bf16_t* rk = (const bf16_t*)(ws + WS_RK); const bf16_t* rv = (const bf16_t*)(ws + WS_RV); bf16_t* oret = (bf16_t*)(ws + WS_ORET);
            for (int it0 = bid; it0 < 512; it0 += G) {
                const int it = (G == 256) ? ((((it0 >> 8) * 32 + (it0 & 7) * 4 + ((it0 & 255) >> 6)) << 3) | ((it0 >> 3) & 7)) : it0;
                const int qb = it & 7, h = (it >> 3) & 7, b = it >> 6;
                const float xf = p.dec_f[h], xb = p.dec_b[h];
                const float lf2 = (fminf(xf, 0.f) - log1pf(__expf(-fabsf(xf)))) * 1.4426950408889634f, lb2 = (fminf(xb, 0.f) - log1pf(__expf(-fabsf(xb)))) * 1.4426950408889634f;
                const size_t srow0 = (size_t)b * SEQ + qb * 256, trow0 = (size_t)b * TT;
                att::ret_body3(rq + srow0 * 1024 + h * 128, rk + trow0 * 1024 + h * 128, rv + trow0 * 2048 + h * 256, oret + srow0 * 2048 + h * 256,
                               ssq_ret + srow0 * 8 + h, qb * 256, lf2, lb2, (char*)shm);
            }
        } break;
        case 4: if (PH_ON(4)) {
            { LOCAL_TID; bf16_t* oret = (bf16_t*)(ws + WS_ORET); const bf16_t* rg = (const bf16_t*)(ws + WS_RG);
              for (size_t i = (size_t)bid * 512 + tid; i < (size_t)SROWS * 256; i += (size_t)G * 512) {
                  const size_t r = i >> 8; const int col = (int)(i & 255) * 8, h = col >> 8;
                  const float rs = __builtin_amdgcn_rsqf(ssq_ret[r * 8 + h] * (1.f / 256.f) + EPS);
                  const u32x4 o = *(const u32x4*)(oret + r * 2048 + col), g = *(const u32x4*)(rg + r * 2048 + col);
                  const f32x4 n0 = *(const f32x4*)(p.ret_gn + col), n1 = *(const f32x4*)(p.ret_gn + col + 4);
                  u32x4 w; w.x = cvt_pk_bf16(bf_lo(o.x) * rs * n0[0] * bf_lo(g.x), bf_hi(o.x) * rs * n0[1] * bf_hi(g.x)); w.y = cvt_pk_bf16(bf_lo(o.y) * rs * n0[2] * bf_lo(g.y), bf_hi(o.y) * rs * n0[3] * bf_hi(g.y));
                  w.z = cvt_pk_bf16(bf_lo(o.z) * rs * n1[0] * bf_lo(g.z), bf_hi(o.z) * rs * n1[1] * bf_hi(g.z)); w.w = cvt_pk_bf16(bf_lo(o.w) * rs * n1[2] * bf_lo(g.w), bf_hi(o.w) * rs * n1[3] * bf_hi(g.w));
                  *(u32x4*)(oret + r * 2048 + col) = w; } }
            __syncthreads();
            { pg8::Gemm g{(const bf16_t*)(ws + WS_QD), (const bf16_t*)(ws + WS_WQUP), 512}; pg8::Sched<0> S{64, 12, G, bid}; EpiQup E{(bf16_t*)(ws + WS_QM), ssq_q}; pg8::gemm_phase(lds, g, S, E); }
            __syncthreads();
            { pg8::Gemm g{(const bf16_t*)(ws + WS_KVD), (const bf16_t*)(ws + WS_WKVUP), 512}; pg8::Sched<0> S{72, 16, G, (bid + 128) % G}; EpiKvup E{(bf16_t*)(ws + WS_KVUP), ssq_kv}; pg8::gemm_phase(lds, g, S, E); }
        } break;
        case 5: if (PH_ON(5)) {
            conv_weight(p.w_up, 2 * FFN, (bf16_t*)(ws + WS_WUP), 2048, 2 * FFN, 3, nullptr, 0, (unsigned*)shm);
            const bf16_t* qm = (const bf16_t*)(ws + WS_QM); const bf16_t* kvup = (const bf16_t*)(ws + WS_KVUP); const bf16_t* kr = (const bf16_t*)(ws + WS_KR); bf16_t* mo = (bf16_t*)(ws + WS_MLAO);
            for (int it0 = bid; it0 < 1024; it0 += G) {
                const int it = (G == 256) ? ((((it0 >> 8) * 32 + (it0 & 7) * 4 + ((it0 & 255) >> 6)) << 3) | ((it0 >> 3) & 7)) : it0;
                const int qb = it & 7, h = (it >> 3) & 15, b = it >> 7;
                const size_t srow0 = (size_t)b * SEQ + qb * 256, trow0 = (size_t)b * TT;
                att::mla_body(qm + srow0 * 3072 + h * 192, kvup + trow0 * 4096 + h * 256, kvup + trow0 * 4096 + h * 256 + 128, kr + trow0 * 64, mo + srow0 * 2048 + h * 128, (char*)shm);
            }
        } break;
        case 6: if (PH_ON(6)) {
            const bf16_t* gr = (const bf16_t*)p.out; const bf16_t* gm = gr + (size_t)SROWS * 2048;
            pg8::Gemm g{(const bf16_t*)(ws + WS_ORET), (const bf16_t*)(ws + WS_WRETO), 2048, (const bf16_t*)(ws + WS_MLAO), (const bf16_t*)(ws + WS_WMLAO)}; pg8::Sched<0> S{64, 8, G, bid}; EpiDual E{gr, gm, (bf16_t*)(ws + WS_MIXED)}; pg8::gemm_phase(lds, g, S, E);
        } break;
        case 7: if (PH_ON(7)) {
            pg8::Gemm g{(const bf16_t*)(ws + WS_MIXED), (const bf16_t*)(ws + WS_WOUT), 2048}; pg8::Sched<0> S{64, 8, G, bid}; EpiResid E{p.x, p.out, mod, p.b_ada, 2, 1.f}; pg8::gemm_phase(lds, g, S, E);
        } break;
        case 8: if (PH_ON(8)) rows_norm<1>(p, mod); break;
        case 9: if (PH_ON(9)) {
            pg8::Gemm g{(const bf16_t*)(ws + WS_H2), (const bf16_t*)(ws + WS_WUP), 2048}; pg8::Sched<0> S{64, 44, G, bid}; EpiUp E{(bf16_t*)(ws + WS_VBUF), (bf16_t*)(ws + WS_ASIDE), (bf16_t*)(ws + WS_VSIDE), p.conv_w, p.conv_b}; pg8::gemm_phase(lds, g, S, E);
        } break;
        case 10: if (PH_ON(10)) {
            conv_weight(p.w_down, 2048, (bf16_t*)(ws + WS_WDOWN), FFN, 2048, 0, nullptr, 0, (unsigned*)shm);
            const bf16_t* as_ = (const bf16_t*)(ws + WS_ASIDE); const bf16_t* vs_ = (const bf16_t*)(ws + WS_VSIDE); bf16_t* vb = (bf16_t*)(ws + WS_VBUF);
            constexpr int CV = FFN / 8;
            LOCAL_TID;
            for (int i = bid * 512 + tid; i < 512 * CV; i += G * 512) {
                const int cv = i % CV, sr = i / CV, kb = sr >> 1, last = sr & 1, col = cv * 8, r = kb * 64 + (last ? 63 : 0), sq = r & (SEQ - 1);
                const u32x4 zero4 = {0, 0, 0, 0}; u32x4 prev, curv, nxt, vv;
                if (!last) { prev = sq ? *(const u32x4*)(as_ + (size_t)((kb - 1) * 4 + 3) * FFN + col) : zero4; curv = *(const u32x4*)(as_ + (size_t)(kb * 4) * FFN + col);
                             nxt = *(const u32x4*)(as_ + (size_t)(kb * 4 + 1) * FFN + col); vv = *(const u32x4*)(vs_ + (size_t)(kb * 2) * FFN + col); }
                else { prev = *(const u32x4*)(as_ + (size_t)(kb * 4 + 2) * FFN + col); curv = *(const u32x4*)(as_ + (size_t)(kb * 4 + 3) * FFN + col);
                       nxt = (sq != SEQ - 1) ? *(const u32x4*)(as_ + (size_t)((kb + 1) * 4) * FFN + col) : zero4; vv = *(const u32x4*)(vs_ + (size_t)(kb * 2 + 1) * FFN + col); }
                float o[8];
#pragma unroll
                for (int q = 0; q < 4; ++q) { const unsigned pw = prev[q], cw = curv[q], nw = nxt[q], vw = vv[q]; const int c = col + 2 * q;
                    const float a0 = p.conv_b[c] + p.conv_w[c] * bf_lo(pw) + p.conv_w[FFN + c] * bf_lo(cw) + p.conv_w[2 * FFN + c] * bf_lo(nw);
                    const float a1 = p.conv_b[c + 1] + p.conv_w[c + 1] * bf_hi(pw) + p.conv_w[FFN + c + 1] * bf_hi(cw) + p.conv_w[2 * FFN + c + 1] * bf_hi(nw);
                    o[2 * q] = siluf_(a0) * bf_lo(vw); o[2 * q + 1] = siluf_(a1) * bf_hi(vw); }
                u32x4 w; w.x = cvt_pk_bf16(o[0], o[1]); w.y = cvt_pk_bf16(o[2], o[3]); w.z = cvt_pk_bf16(o[4], o[5]); w.w = cvt_pk_bf16(o[6], o[7]);
                *(u32x4*)(vb + (size_t)r * FFN + col) = w;
            }
        } break;
        case 11: if (PH_ON(11)) {
            pg8::Gemm g{(const bf16_t*)(ws + WS_VBUF), (const bf16_t*)(ws + WS_WDOWN), FFN}; pg8::Sched<0> S{64, 8, G, bid}; EpiResid E{p.out, p.out, mod, p.b_ada, 5, 1.f}; pg8::gemm_phase(lds, g, S, E);
        } break;
        case 12: if (PH_ON(12)) rows_norm<2>(p, mod); break;
        default: break;
        }
        }
    }
}

constexpr int LDS_BYTES = pg8::STAGE_BYTES + 16;
extern "C" void kernel_launch(void* const* d_in, const int* in_sizes, int n_in, void* d_out, int out_size, void* d_ws, size_t ws_size, hipStream_t stream) {
    static int grid = 0;
    if (grid == 0) {
        if (n_in != 22 || out_size != SROWS * DM || ws_size < WS_END) { fprintf(stderr, "kernel_launch: unexpected shapes (n_in %d out %d ws %zu need %zu)\n", n_in, out_size, ws_size, (size_t)WS_END); grid = -1; return; }
        int dev = 0, cus = 0, per_cu = 0;
        hipGetDevice(&dev); hipDeviceGetAttribute(&cus, hipDeviceAttributeMultiprocessorCount, dev);
        if (hipFuncSetAttribute((const void*)fwd_megakernel, hipFuncAttributeMaxDynamicSharedMemorySize, LDS_BYTES) != hipSuccess) { fprintf(stderr, "kernel_launch: hipFuncSetAttribute failed\n"); grid = -1; return; }
        hipOccupancyMaxActiveBlocksPerMultiprocessor(&per_cu, (const void*)fwd_megakernel, 512, LDS_BYTES);
        (void)hipGetLastError();
        if (per_cu < 1) per_cu = 1;
        grid = cus * per_cu; if (grid > 256) grid = 256; grid &= ~7; if (grid < 8) grid = 8;
    }
    if (grid < 0) return;
    hipMemsetAsync(d_ws, 0, WS_ZERO_BYTES, stream);
    Params p{};
    const float** pp = (const float**)&p;
    for (int i = 0; i < 22; ++i) pp[i] = (const float*)d_in[i];
    p.out = (float*)d_out; p.ws = (unsigned char*)d_ws;
#if MK_MULTI
    for (int ph = 0; ph < NPHASE; ++ph) {
#if MK_DEBUG
        hipLaunchKernelGGL(dbg_kernel, dim3(256), dim3(512), 0, stream, p, ph);
#endif
        p.ph_lo = ph; p.ph_hi = ph + 1; hipLaunchKernelGGL(fwd_megakernel, dim3(grid), dim3(512), LDS_BYTES, stream, p); }
#if MK_DEBUG
    hipLaunchKernelGGL(dbg_kernel, dim3(256), dim3(512), 0, stream, p, 13);
#endif
#else
    p.ph_lo = 0; p.ph_hi = NPHASE;
    void* args[] = {&p};
    hipError_t e = hipLaunchCooperativeKernel((const void*)fwd_megakernel, dim3(grid), dim3(512), args, LDS_BYTES, stream);
    if (e != hipSuccess) fprintf(stderr, "cooperative launch failed: %s (grid %d)\n", hipGetErrorString(e), grid);
#endif
}
```

```cpp
#include <hip/hip_runtime.h>
#include <hip/hip_cooperative_groups.h>
#include <cstdio>
#include <cstdint>
namespace cg = cooperative_groups;

#ifndef MK_ONLY
#define MK_ONLY -1
#endif
#define PH_ON(k) (MK_ONLY < 0 || MK_ONLY == (k))
#ifndef MK_DEBUG
#define MK_DEBUG 0
#endif
#ifndef MK_REP
#define MK_REP -1
#endif
#ifndef MK_MULTI
#define MK_MULTI 0
#endif

typedef unsigned short bf16_t;
typedef short bf16x8 __attribute__((ext_vector_type(8)));
typedef short s16x4 __attribute__((ext_vector_type(4)));
typedef float f32x2 __attribute__((ext_vector_type(2)));
typedef float f32x4 __attribute__((ext_vector_type(4)));
typedef float f32x16 __attribute__((ext_vector_type(16)));
typedef unsigned u32x2 __attribute__((ext_vector_type(2)));
typedef unsigned u32x4 __attribute__((ext_vector_type(4)));
#define LAS __attribute__((address_space(3)))
#define DI __device__ __forceinline__

constexpr int NB = 8, SEQ = 2048, DM = 2048, LC = 256, TT = LC + SEQ  , MROWS = NB * TT  , SROWS = NB * SEQ  ;
constexpr int FFN = 5632, INCOLS = 11328, NIN = 11520  ;
constexpr float EPS = 1e-6f;
constexpr int NPHASE = 13;

constexpr size_t MB = 1024 * 1024;
constexpr size_t WS_MOD = 0;
constexpr size_t WS_SSQKV = WS_MOD + 9 * 12288 * 4;
constexpr size_t WS_SSQQ = WS_SSQKV + MROWS * 4;
constexpr size_t WS_DBG = WS_SSQQ + SROWS * 4;
constexpr size_t WS_BAR = WS_DBG + 4096;
constexpr size_t WS_ZERO_BYTES = WS_BAR + 3456 * 4;
constexpr size_t WS_SSQRET = 1 * MB;
constexpr size_t WS_WQUP = 2 * MB;
constexpr size_t WS_WKVUP = WS_WQUP + 3072ull * 512 * 2;
constexpr size_t WS_WRETO = WS_WKVUP + 4096ull * 512 * 2;
constexpr size_t WS_WMLAO = WS_WRETO + 2048ull * 2048 * 2;
constexpr size_t WS_WOUT = WS_WMLAO + 2048ull * 2048 * 2;
constexpr size_t WS_ARENA = WS_WOUT + 2048ull * 2048 * 2;
constexpr size_t WS_WIN = WS_ARENA;
constexpr size_t WS_WUP = WS_ARENA;
constexpr size_t SLOTA = (size_t)NIN * 2048 * 2;
constexpr size_t WS_ORET = WS_ARENA + SLOTA;
constexpr size_t WS_H2 = WS_ORET;
constexpr size_t WS_WDOWN = WS_ORET;
constexpr size_t SLOTB = (size_t)SROWS * 2048 * 2;
constexpr size_t WS_C = WS_ORET + SLOTB;
constexpr size_t WS_RG = WS_C;
constexpr size_t WS_MLAO = WS_C;
constexpr size_t WS_KVD = WS_RG + (size_t)SROWS * 2048 * 2;
constexpr size_t WS_QD = WS_KVD + (size_t)MROWS * 512 * 2;
constexpr size_t WS_KR = WS_QD + (size_t)SROWS * 512 * 2;
constexpr size_t WS_C2 = WS_KR + (size_t)MROWS * 64 * 2;
constexpr size_t WS_HBUF = WS_C2;
constexpr size_t WS_RK = WS_HBUF + (size_t)MROWS * 2048 * 2;
constexpr size_t WS_RV = WS_RK + (size_t)MROWS * 1024 * 2;
constexpr size_t WS_RQ = WS_RV + (size_t)MROWS * 2048 * 2;
constexpr size_t WS_QM = WS_C2;
constexpr size_t WS_KVUP = WS_QM + (size_t)SROWS * 3072 * 2;
constexpr size_t WS_TMP1 = WS_C2;
constexpr size_t WS_MIXED = WS_TMP1 + (size_t)SROWS * 2048 * 4;
constexpr size_t WS_ABUF = WS_C;
constexpr size_t WS_ASIDE = WS_ABUF;
constexpr size_t WS_VSIDE = WS_ASIDE + (size_t)1024 * FFN * 2;
constexpr size_t WS_VBUF = WS_ABUF + (size_t)SROWS * FFN * 2;
constexpr size_t WS_END = WS_VBUF + (size_t)SROWS * FFN * 2;
static_assert(WS_KVUP + (size_t)MROWS * 4096 * 2 <= WS_END, "region C overflow");
static_assert(WS_RQ + (size_t)SROWS * 1024 * 2 <= WS_END, "region C overflow");
static_assert(WS_ZERO_BYTES <= WS_SSQRET, "zero region overflow");

struct Params {
    const float *x, *c, *ctx, *c_ctx, *w_ada, *b_ada, *w_in, *dec_f, *dec_b, *ret_gn, *w_ret_o, *q_norm, *w_q_up, *kv_norm, *w_kv_up, *w_mla_o, *w_out, *w_up, *conv_w, *conv_b, *w_down, *final_norm;
    float* out; unsigned char* ws;
    int ph_lo, ph_hi;
};

DI unsigned cvt_pk_bf16(float lo, float hi) { unsigned r; asm volatile("v_cvt_pk_bf16_f32 %0, %1, %2" : "=v"(r) : "v"(lo), "v"(hi)); return r; }
DI unsigned cvt_pk_bf16_t(float lo, float hi) { unsigned r; asm volatile("s_nop 1\n\tv_cvt_pk_bf16_f32 %0, %1, %2" : "=v"(r) : "v"(lo), "v"(hi)); return r; }
DI float bf_lo(unsigned w) { return __uint_as_float(w << 16); }
DI float bf_hi(unsigned w) { return __uint_as_float(w & 0xffff0000u); }
DI float sigmoidf_(float x) { return __builtin_amdgcn_rcpf(1.f + __expf(-x)); }
DI float siluf_(float x) { return x * sigmoidf_(x); }
DI float wave_sum(float v) {
#pragma unroll
    for (int o = 32; o > 0; o >>= 1) v += __shfl_xor(v, o);
    return v;
}


#define XB_TMO      128
#define XB_XCNT(j)  (256  + 64 * (j))
#define XB_XSUB(j)  (1280 + 64 * (j))
#define XB_XGEN(j)  (2304 + 64 * (j))
#define XB_TOP      3328
#define XB_TOPGEN   3392
#define XCD_BAR_WORDS 3456
#define XB_SPIN_CAP (1u << 20)
DI unsigned xb_ld(unsigned* p)              { return __hip_atomic_load(p, __ATOMIC_RELAXED, __HIP_MEMORY_SCOPE_AGENT); }
DI unsigned xb_add(unsigned* p, unsigned v) { return __hip_atomic_fetch_add(p, v, __ATOMIC_RELAXED, __HIP_MEMORY_SCOPE_AGENT); }
DI unsigned xb_xcc_id() { return (unsigned)__builtin_amdgcn_s_getreg((3 << 11) | 20) & 0xFu; }
#define XB_SPIN(cond, bar) do { unsigned _sp = 0; while (cond) { __builtin_amdgcn_s_sleep(1); \
    if ((++_sp & 255u) == 0u) { if (xb_ld(&(bar)[XB_TMO])) break; if (_sp > XB_SPIN_CAP) { atomicAdd(&(bar)[XB_TMO], 1u); break; } } } } while (0)
struct XcdBarrier { unsigned* bar; unsigned x; volatile LAS unsigned* st; };
DI XcdBarrier xcd_barrier_post(unsigned* bar, volatile LAS unsigned* st) {
    XcdBarrier b; b.bar = bar; b.x = xb_xcc_id(); b.st = st;
    if (threadIdx.x == 0) (void)xb_add(&bar[XB_XCNT(b.x)], 1u);
    return b;
}
DI void xcd_barrier_complete(unsigned* bar, unsigned x, unsigned& nloc, unsigned& nx) {
    const unsigned G = gridDim.x * gridDim.y * gridDim.z;
    unsigned sum, cnt, mine, sp = 0u;
    for (;;) {
        sum = 0u; cnt = 0u; mine = 0u;
#pragma unroll
        for (unsigned j = 0; j < 16; ++j) { const unsigned c = xb_ld(&bar[XB_XCNT(j)]); sum += c; cnt += (c > 0u) ? 1u : 0u; mine = (j == x) ? c : mine; }
        if (sum == G) break;
        __builtin_amdgcn_s_sleep(1);
        if ((++sp & 255u) == 0u) { if (xb_ld(&bar[XB_TMO])) break; if (sp > XB_SPIN_CAP) { atomicAdd(&bar[XB_TMO], 1u); break; } }
    }
    nloc = mine > 0u ? mine : 1u; nx = cnt > 0u ? cnt : 1u;
}
DI void xcd_barrier(const XcdBarrier& b) {
    asm volatile("s_waitcnt vmcnt(0)" ::: "memory");
    __syncthreads();
    if (threadIdx.x == 0) {
        unsigned* bar = b.bar;
        __builtin_amdgcn_s_waitcnt(0);
        unsigned nloc = b.st[0], nx = b.st[1];
        if (nloc == 0u) { xcd_barrier_complete(bar, b.x, nloc, nx); b.st[0] = nloc; b.st[1] = nx; }
        const unsigned old = xb_add(&bar[XB_XSUB(b.x)], 1u);
        const unsigned gen = old / nloc;
        if (old + 1u == (gen + 1u) * nloc) {
            __builtin_amdgcn_fence(__ATOMIC_RELEASE, "agent");
            asm volatile("s_waitcnt vmcnt(0)" ::: "memory");
            const unsigned og = xb_add(&bar[XB_TOP], 1u);
            const unsigned tg = og / nx;
            if (og + 1u == (tg + 1u) * nx) xb_add(&bar[XB_TOPGEN], 1u);
            else XB_SPIN(xb_ld(&bar[XB_TOPGEN]) == tg, bar);
            __builtin_amdgcn_fence(__ATOMIC_ACQUIRE, "agent");
            xb_add(&bar[XB_XGEN(b.x)], 1u);
            asm volatile("s_waitcnt vmcnt(0)" ::: "memory");
        } else {
            XB_SPIN(xb_ld(&bar[XB_XGEN(b.x)]) == gen, bar);
            __builtin_amdgcn_fence(__ATOMIC_ACQUIRE, "agent");
            asm volatile("s_waitcnt vmcnt(0)" ::: "memory");
        }
    }
    __syncthreads();
}

namespace pg8 {
constexpr int BM = 256, BK = 64, HALF = 128, HTB = HALF * BK * 2, STAGE_BYTES = 8 * HTB, NXCD = 8, WGM = 8;
DI int lds_byte(int r, int c) { const int st = (r >> 4) * 2 + (c >> 5), rr = r & 15, cc = c & 31, ob = rr * 64 + cc * 2; return st * 1024 + (ob ^ (((ob >> 9) & 1) << 5)); }
DI void stage_rc(int b, int& R, int& C) { const int st = b / 1024, sb = b % 1024, swz = sb ^ (((sb >> 9) & 1) << 5); R = (st >> 1) * 16 + swz / 64; C = (st & 1) * 32 + (swz % 64) / 2; }
DI int perm32(int rho) { const int n = rho >> 4, i = rho & 15; return 8 * (i >> 2) + 4 * n + (i & 3); }
struct Unit { int pm, pn; };
struct Gemm { const bf16_t* A; const bf16_t* Bt; int K; const bf16_t* A2; const bf16_t* Bt2; };

DI void tile_map(int L, int nM, int nN, int& pm, int& pn) {
    const int nwg = nM * nN; int wgid = L;
    { const int q = nwg / NXCD, r = nwg % NXCD, xcd = wgid % NXCD, off = wgid / NXCD; wgid = (xcd < r ? xcd * (q + 1) : r * (q + 1) + (xcd - r) * q) + off; }
    const int nig = WGM * nN, gid = wgid / nig, fm = gid * WGM, gsz = (nM - fm) < WGM ? (nM - fm) : WGM;
    pm = fm + ((wgid % nig) % gsz); pn = (wgid % nig) / gsz;
}
template <int KIND> struct Sched {
    int nM, nN, G, c;
    DI bool next(int i, Unit& u) const {
        const int L = i * G + c;
        if (KIND == 0) { if (L >= nM * nN) return false; tile_map(L, nM, nN, u.pm, u.pn); return true; }
        else {
            if (L < 2880) { int lm, ln; tile_map(L, 64, 45, lm, ln); u.pm = (lm >> 3) * 9 + 1 + (lm & 7); u.pn = ln; return true; }
            if (L < 3000) { int lm, ln; tile_map(L - 2880, 8, 15, lm, ln); u.pm = lm * 9; u.pn = ln; return true; }
            return false;
        }
    }
    DI void a_ready(const Unit&) const {}
    DI void done(const Unit&) const {}
};

template <class Epi, class SchedT>
DI void gemm_phase(LAS unsigned char* lds, const Gemm g, const SchedT& S, const Epi& E) {
    int tid = threadIdx.x; asm volatile("" : "+v"(tid));
    const int wid = __builtin_amdgcn_readfirstlane(tid >> 6), lane = tid & 63, wr = wid >> 2, wc = wid & 3, fr = lane & 15, fq = lane >> 4;
    constexpr bool DUAL = Epi::DUAL;
    const int K = g.K, nth = K / BK, nt = DUAL ? 2 * nth : nth;
    unsigned voffA[2], voffB[2];
#pragma unroll
    for (int i = 0; i < 2; ++i) { int R, C; stage_rc(tid * 16 + i * 8192, R, C); const int Rb = Epi::PERM ? ((R & ~31) + perm32(R & 31)) : R;
        voffA[i] = (unsigned)(R * K + C) * 2u; voffB[i] = (unsigned)(Rb * K + C) * 2u; }
    const size_t kstep = (size_t)(BK * 2);
    const size_t hstep = (size_t)HALF * K * 2;
    const size_t tstep = 2 * hstep;
    const unsigned ldsw = (unsigned)wid * 1024u;
    const int aoff = lds_byte(wr * 64 + fr, fq * 8), boff = lds_byte(wc * 32 + fr, fq * 8);
#define PG8_SA(b, h) (((b) * 2 + (h)) * HTB)
#define PG8_SB(b, h) ((4 + (b) * 2 + (h)) * HTB)
#define PG8_STAGE(bufoff, gbase, voff) do { _Pragma("unroll") for (int _i = 0; _i < 2; ++_i) \
        __builtin_amdgcn_global_load_lds((const unsigned*)((const char*)(gbase) + (voff)[_i]), (LAS unsigned*)(lds + (bufoff) + ldsw + _i * 8192), 16, 0, 0); } while (0)
#define PG8_LDA(dst, b, h) do { _Pragma("unroll") for (int m = 0; m < 4; ++m) _Pragma("unroll") for (int k = 0; k < 2; ++k) dst[m][k] = *(const LAS bf16x8*)(lds + PG8_SA(b, h) + aoff + m * 2048 + k * 1024); } while (0)
#define PG8_LDB(dst, b, h) do { _Pragma("unroll") for (int n = 0; n < 2; ++n) _Pragma("unroll") for (int k = 0; k < 2; ++k) dst[n][k] = *(const LAS bf16x8*)(lds + PG8_SB(b, h) + boff + n * 2048 + k * 1024); } while (0)
#define PG8_MMA(ai, bj, At, Bt) do { __builtin_amdgcn_s_setprio(1); _Pragma("unroll") for (int m = 0; m < 4; ++m) _Pragma("unroll") for (int n = 0; n < 2; ++n) _Pragma("unroll") for (int k = 0; k < 2; ++k) \
        acc[ai][bj][m][n] = __builtin_amdgcn_mfma_f32_16x16x32_bf16(Bt[n][k], At[m][k], acc[ai][bj][m][n], 0, 0, 0); __builtin_amdgcn_s_setprio(0); } while (0)
#define PG8_WAIT_V(n) asm volatile("s_waitcnt vmcnt(" #n ")" ::: "memory")
#define PG8_WAIT_L(n) asm volatile("s_waitcnt lgkmcnt(" #n ")" ::: "memory")
#define PG8_BAR __builtin_amdgcn_s_barrier()
#define PG8_SCHED __builtin_amdgcn_sched_barrier(0)
    Unit cur, nxt; int ui = 0;
    if (!S.next(0, cur)) return;
    f32x4 acc[2][2][4][2];
#pragma unroll
    for (int a = 0; a < 2; ++a)
#pragma unroll
        for (int b = 0; b < 2; ++b)
#pragma unroll
            for (int m = 0; m < 4; ++m)
#pragma unroll
                for (int n = 0; n < 2; ++n) acc[a][b][m][n] = (f32x4){0.f, 0.f, 0.f, 0.f};
    bf16x8 At[4][2], B0[2][2], B1[2][2];
    const char* cA = (const char*)g.A + (size_t)cur.pm * tstep; const char* cB = (const char*)g.Bt + (size_t)cur.pn * tstep;
    const char* cA2 = DUAL ? (const char*)g.A2 + (size_t)cur.pm * tstep : cA; const char* cB2 = DUAL ? (const char*)g.Bt2 + (size_t)cur.pn * tstep : cB;
    S.a_ready(cur);
    PG8_STAGE(PG8_SB(0, 0), cB, voffB); PG8_STAGE(PG8_SA(0, 0), cA, voffA); PG8_STAGE(PG8_SB(0, 1), cB + hstep, voffB); PG8_STAGE(PG8_SA(0, 1), cA + hstep, voffA);
    if (wr == 1) PG8_BAR;
    PG8_WAIT_V(4); PG8_BAR;
    PG8_STAGE(PG8_SB(1, 0), cB + kstep, voffB); PG8_STAGE(PG8_SA(1, 0), cA + kstep, voffA); PG8_STAGE(PG8_SB(1, 1), cB + hstep + kstep, voffB);
    PG8_WAIT_V(6); PG8_BAR;
    for (;;) {
        const bool has_next = S.next(ui + 1, nxt);
        const char* nA = has_next ? (const char*)g.A + (size_t)nxt.pm * tstep : cA; const char* nB = has_next ? (const char*)g.Bt + (size_t)nxt.pn * tstep : cB;
        for (int t = 0; t < nt; t += 2) {
            const bool last = (t == nt - 2);
            const bool h2a = DUAL && (t + 1 >= nth), h2b = DUAL && (t + 2 >= nth);
            const char* a1 = (h2a ? cA2 - (size_t)nth * kstep : cA) + (size_t)(t + 1) * kstep;
            const char* a2 = last ? nA : (h2b ? cA2 - (size_t)nth * kstep : cA) + (size_t)(t + 2) * kstep; const char* b2 = last ? nB : (h2b ? cB2 - (size_t)nth * kstep : cB) + (size_t)(t + 2) * kstep;
            const char* a3 = a2 + kstep; const char* b3 = b2 + kstep;
            if (last && has_next) S.a_ready(nxt);
            if constexpr (DUAL) { if (t == nth) { int fr_ = fr, fq_ = fq; asm volatile("" : "+v"(fr_), "+v"(fq_)); E.mid(acc, cur, wr, wc, fr_, fq_); } }
            PG8_LDB(B0, 0, 0); PG8_SCHED; PG8_LDA(At, 0, 0); PG8_STAGE(PG8_SA(1, 1), a1 + hstep, voffA);
            PG8_WAIT_L(8); PG8_BAR; PG8_WAIT_L(0); PG8_MMA(0, 0, At, B0); PG8_BAR; PG8_SCHED;
            PG8_LDB(B1, 0, 1); PG8_STAGE(PG8_SB(0, 0), b2, voffB);
            PG8_BAR; PG8_WAIT_L(0); PG8_MMA(0, 1, At, B1); PG8_BAR;
            PG8_LDA(At, 0, 1); PG8_STAGE(PG8_SA(0, 0), a2, voffA);
            PG8_BAR; PG8_WAIT_L(0); PG8_MMA(1, 0, At, B0); PG8_BAR; PG8_SCHED;
            PG8_STAGE(PG8_SB(0, 1), b2 + hstep, voffB);
            PG8_WAIT_V(6); PG8_BAR; PG8_MMA(1, 1, At, B1); PG8_BAR;
            PG8_LDB(B0, 1, 0); PG8_SCHED; PG8_LDA(At, 1, 0); PG8_STAGE(PG8_SA(0, 1), a2 + hstep, voffA);
            PG8_WAIT_L(8); PG8_BAR; PG8_WAIT_L(0); PG8_MMA(0, 0, At, B0); PG8_BAR; PG8_SCHED;
            PG8_LDB(B1, 1, 1); PG8_STAGE(PG8_SB(1, 0), b3, voffB);
            PG8_BAR; PG8_WAIT_L(0); PG8_MMA(0, 1, At, B1); PG8_BAR;
            PG8_LDA(At, 1, 1); PG8_STAGE(PG8_SA(1, 0), a3, voffA);
            PG8_BAR; PG8_WAIT_L(0); PG8_MMA(1, 0, At, B0); PG8_BAR; PG8_SCHED;
            PG8_STAGE(PG8_SB(1, 1), b3 + hstep, voffB);
            PG8_WAIT_V(6); PG8_BAR; PG8_MMA(1, 1, At, B1); PG8_BAR;
        }
        { int fr_ = fr, fq_ = fq; asm volatile("" : "+v"(fr_), "+v"(fq_)); E(acc, cur, wr, wc, fr_, fq_); } S.done(cur);
        if (!has_next) break;
#pragma unroll
        for (int a = 0; a < 2; ++a)
#pragma unroll
            for (int b = 0; b < 2; ++b)
#pragma unroll
                for (int m = 0; m < 4; ++m)
#pragma unroll
                    for (int n = 0; n < 2; ++n) acc[a][b][m][n] = (f32x4){0.f, 0.f, 0.f, 0.f};
        cur = nxt; cA = nA; cB = nB; ++ui;
        if constexpr (DUAL) { cA2 = (const char*)g.A2 + (size_t)cur.pm * tstep; cB2 = (const char*)g.Bt2 + (size_t)cur.pn * tstep; }
    }
    PG8_WAIT_V(0);
    if (wr == 0) PG8_BAR;
    PG8_BAR;
#undef PG8_SA
#undef PG8_SB
#undef PG8_STAGE
#undef PG8_LDA
#undef PG8_LDB
#undef PG8_MMA
#undef PG8_WAIT_V
#undef PG8_WAIT_L
#undef PG8_BAR
#undef PG8_SCHED
}
}
using pg8::Unit;
typedef const f32x4 (&AccRef)[2][2][4][2];

template <int ACT  >
DI void store_plain(AccRef acc, bf16_t* dst, size_t ld, int row0, int col0) {
#pragma unroll
    for (int ai = 0; ai < 2; ++ai)
#pragma unroll
        for (int m = 0; m < 4; ++m) { int rowi = row0 + ai * 128 + m * 16; asm volatile("" : "+v"(rowi)); bf16_t* rowp = dst + (size_t)rowi * ld + col0;
#pragma unroll
            for (int bj = 0; bj < 2; ++bj) { f32x4 v0 = acc[ai][bj][m][0], v1 = acc[ai][bj][m][1];
                if (ACT == 1) {
#pragma unroll
                    for (int j = 0; j < 4; ++j) { v0[j] = siluf_(v0[j]); v1[j] = siluf_(v1[j]); } }
                if (ACT == 2) {
#pragma unroll
                    for (int j = 0; j < 4; ++j) { v0[j] = sigmoidf_(v0[j]); v1[j] = sigmoidf_(v1[j]); } }
                u32x4 w;
                if (ACT == 0) { w.x = cvt_pk_bf16(v0[0], v0[1]); w.y = cvt_pk_bf16(v0[2], v0[3]); w.z = cvt_pk_bf16(v1[0], v1[1]); w.w = cvt_pk_bf16(v1[2], v1[3]); }
                else { w.x = cvt_pk_bf16_t(v0[0], v0[1]); w.y = cvt_pk_bf16_t(v0[2], v0[3]); w.z = cvt_pk_bf16_t(v1[0], v1[1]); w.w = cvt_pk_bf16_t(v1[2], v1[3]); }
                *(u32x4*)(rowp + bj * 128) = w; } }
}
DI void add_ssq(AccRef acc, float* ssq, int row0, int fq) {
#pragma unroll
    for (int ai = 0; ai < 2; ++ai)
#pragma unroll
        for (int m = 0; m < 4; ++m) { float s = 0.f;
#pragma unroll
            for (int bj = 0; bj < 2; ++bj)
#pragma unroll
                for (int n = 0; n < 2; ++n)
#pragma unroll
                    for (int j = 0; j < 4; ++j) { const float v = acc[ai][bj][m][n][j]; s += v * v; }
            s += __shfl_xor(s, 16); s += __shfl_xor(s, 32);
            if (fq == 0) atomicAdd(ssq + row0 + ai * 128 + m * 16, s); }
}
DI void store_rope128(AccRef acc, bf16_t* dst, int row0, int head0, int s0, bool do_rope, float scale, int wc, int fq) {
    const int half = wc >> 1, f0 = ((wc & 1) * 4 + fq) * 4;
    float inv[4];
#pragma unroll
    for (int j = 0; j < 4; ++j) inv[j] = __builtin_amdgcn_exp2f(-(float)(f0 + j) * 0.41524101186f) * 0.15915494309f;
#pragma unroll
    for (int ai = 0; ai < 2; ++ai)
#pragma unroll
        for (int m = 0; m < 4; ++m) { const int s = s0 + ai * 128 + m * 16; const float pos = (float)(half ? (s & 63) : (s >> 6));
            float cs[4], sn[4];
#pragma unroll
            for (int j = 0; j < 4; ++j) { const float rev = pos * inv[j]; cs[j] = do_rope ? __builtin_amdgcn_cosf(rev) : 1.f; sn[j] = do_rope ? __builtin_amdgcn_sinf(rev) : 0.f; }
#pragma unroll
            for (int bj = 0; bj < 2; ++bj) { const f32x4 t1 = acc[ai][bj][m][0], t2 = acc[ai][bj][m][1]; float o1[4], o2[4];
#pragma unroll
                for (int j = 0; j < 4; ++j) { o1[j] = (t1[j] * cs[j] - t2[j] * sn[j]) * scale; o2[j] = (t2[j] * cs[j] + t1[j] * sn[j]) * scale; }
                int rowi = row0 + ai * 128 + m * 16; asm volatile("" : "+v"(rowi)); bf16_t* p = dst + (size_t)rowi * 1024 + (head0 + bj) * 128 + half * 64 + f0;
                u32x2 w1, w2; w1.x = cvt_pk_bf16(o1[0], o1[1]); w1.y = cvt_pk_bf16(o1[2], o1[3]); w2.x = cvt_pk_bf16(o2[0], o2[1]); w2.y = cvt_pk_bf16(o2[2], o2[3]);
                *(u32x2*)p = w1; *(u32x2*)(p + 32) = w2; } }
}
DI void store_rope32(AccRef acc, int bj, const float (&rs)[2][4], bf16_t* dst, size_t ld, int row0, int colbase, int g, int s0, bool do_rope, int fq) {
    const int f0 = 4 * fq; float inv[4];
#pragma unroll
    for (int j = 0; j < 4; ++j) inv[j] = __builtin_amdgcn_exp2f(-(float)(f0 + j) * 0.83048202372f) * 0.15915494309f;
#pragma unroll
    for (int ai = 0; ai < 2; ++ai)
#pragma unroll
        for (int m = 0; m < 4; ++m) { const int s = s0 + ai * 128 + m * 16; const float pos = (float)(g ? (s & 63) : (s >> 6));
            const f32x4 t1 = (bj ? acc[ai][1][m][0] : acc[ai][0][m][0]) * rs[ai][m], t2 = (bj ? acc[ai][1][m][1] : acc[ai][0][m][1]) * rs[ai][m]; float o1[4], o2[4];
#pragma unroll
            for (int j = 0; j < 4; ++j) { const float rev = pos * inv[j]; const float cs = do_rope ? __builtin_amdgcn_cosf(rev) : 1.f, sn = do_rope ? __builtin_amdgcn_sinf(rev) : 0.f;
                o1[j] = t1[j] * cs - t2[j] * sn; o2[j] = t2[j] * cs + t1[j] * sn; }
            int rowi = row0 + ai * 128 + m * 16; asm volatile("" : "+v"(rowi)); bf16_t* p = dst + (size_t)rowi * ld + colbase + f0;
            u32x2 w1, w2; w1.x = cvt_pk_bf16(o1[0], o1[1]); w1.y = cvt_pk_bf16(o1[2], o1[3]); w2.x = cvt_pk_bf16(o2[0], o2[1]); w2.y = cvt_pk_bf16(o2[2], o2[3]);
            *(u32x2*)p = w1; *(u32x2*)(p + 16) = w2; }
}

struct EpiInProj {
    static constexpr bool PERM = true, DUAL = false;
    bf16_t *rk, *rv, *kvd, *kr, *rq, *rg, *qd, *gr, *gm; float *ssq_kv, *ssq_q; bf16_t* dcopy;
    DI void operator()(AccRef acc, const Unit& u, int wr, int wc, int fr, int fq) const {
        const int pn = u.pn, b = u.pm / 9, jt = u.pm % 9; const bool latent = jt != 0;
        const int trow0 = u.pm * 256 + wr * 64 + fr;
        const int srow0 = (b * 8 + jt - 1) * 256 + wr * 64 + fr;
        const int s0 = (jt - 1) * 256 + wr * 64 + fr;
        const int cw = wc * 32 + 8 * fq;
        if (pn < 4) store_rope128(acc, rk, trow0, pn * 2, s0, latent, 0.08838834764831845f, wc, fq);
        else if (pn < 12) store_plain<0>(acc, rv, 2048, trow0, (pn - 4) * 256 + cw);
        else if (pn < 14) { store_plain<0>(acc, kvd, 512, trow0, (pn - 12) * 256 + cw); add_ssq(acc, ssq_kv, trow0, fq); }
        else if (pn == 14) { if (wc < 2) { const float one[2][4] = {{1.f, 1.f, 1.f, 1.f}, {1.f, 1.f, 1.f, 1.f}}; store_rope32(acc, 0, one, kr, 64, trow0, wc * 32, wc, s0, latent, fq); } }
        else if (pn < 19) store_rope128(acc, rq, srow0, (pn - 15) * 2, s0, true, 1.f, wc, fq);
        else if (pn < 27) store_plain<1>(acc, rg, 2048, srow0, (pn - 19) * 256 + cw);
        else if (pn < 29) { store_plain<0>(acc, qd, 512, srow0, (pn - 27) * 256 + cw); add_ssq(acc, ssq_q, srow0, fq); }
        else if (pn < 37) store_plain<2>(acc, gr, 2048, srow0, (pn - 29) * 256 + cw);
        else store_plain<2>(acc, gm, 2048, srow0, (pn - 37) * 256 + cw);
    }
};
struct EpiQup {
    static constexpr bool PERM = true, DUAL = false;
    bf16_t* qm; const float* ssq_q;
    DI void operator()(AccRef acc, const Unit& u, int wr, int wc, int fr, int fq) const {
        const int row0 = u.pm * 256 + wr * 64 + fr; const int s0 = (u.pm & 7) * 256 + wr * 64 + fr;
        float rs[2][4];
#pragma unroll
        for (int ai = 0; ai < 2; ++ai)
#pragma unroll
            for (int m = 0; m < 4; ++m) rs[ai][m] = __builtin_amdgcn_rsqf(ssq_q[row0 + ai * 128 + m * 16] * (1.f / 512.f) + EPS);
#pragma unroll
        for (int bj = 0; bj < 2; ++bj) {
            const int gidx = u.pn * 8 + bj * 4 + wc, head = gidx / 6, gi = gidx % 6;
            if (gi < 4) {
#pragma unroll
                for (int ai = 0; ai < 2; ++ai)
#pragma unroll
                    for (int m = 0; m < 4; ++m) { const f32x4 v0 = acc[ai][bj][m][0] * rs[ai][m], v1 = acc[ai][bj][m][1] * rs[ai][m];
                        u32x4 w; w.x = cvt_pk_bf16(v0[0], v0[1]); w.y = cvt_pk_bf16(v0[2], v0[3]); w.z = cvt_pk_bf16(v1[0], v1[1]); w.w = cvt_pk_bf16(v1[2], v1[3]);
                        int rowi = row0 + ai * 128 + m * 16; asm volatile("" : "+v"(rowi));
                        *(u32x4*)(qm + (size_t)rowi * 3072 + head * 192 + gi * 32 + 8 * fq) = w; }
            } else store_rope32(acc, bj, rs, qm, 3072, row0, head * 192 + 128 + (gi - 4) * 32, gi - 4, s0, true, fq);
        }
    }
};
struct EpiKvup {
    static constexpr bool PERM = true, DUAL = false;
    bf16_t* kvup; const float* ssq_kv;
    DI void operator()(AccRef acc, const Unit& u, int wr, int wc, int fr, int fq) const {
        const int row0 = u.pm * 256 + wr * 64 + fr, col0 = u.pn * 256 + wc * 32 + 8 * fq;
        float rs[2][4];
#pragma unroll
        for (int ai = 0; ai < 2; ++ai)
#pragma unroll
            for (int m = 0; m < 4; ++m) rs[ai][m] = __builtin_amdgcn_rsqf(ssq_kv[row0 + ai * 128 + m * 16] * (1.f / 512.f) + EPS);
#pragma unroll
        for (int ai = 0; ai < 2; ++ai)
#pragma unroll
            for (int m = 0; m < 4; ++m) { int row = row0 + ai * 128 + m * 16; asm volatile("" : "+v"(row));
#pragma unroll
                for (int bj = 0; bj < 2; ++bj) { const f32x4 v0 = acc[ai][bj][m][0] * rs[ai][m], v1 = acc[ai][bj][m][1] * rs[ai][m];
                    u32x4 w; w.x = cvt_pk_bf16(v0[0], v0[1]); w.y = cvt_pk_bf16(v0[2], v0[3]); w.z = cvt_pk_bf16(v1[0], v1[1]); w.w = cvt_pk_bf16(v1[2], v1[3]);
                    *(u32x4*)(kvup + (size_t)row * 4096 + col0 + bj * 128) = w; } }
    }
};
struct EpiDual {
    static constexpr bool PERM = true, DUAL = true;
    const bf16_t *gr, *gm; bf16_t* mixed;
    DI void mid(f32x4 (&acc)[2][2][4][2], const Unit& u, int wr, int wc, int fr, int fq) const {
        const int row0 = u.pm * 256 + wr * 64 + fr, col0 = u.pn * 256 + wc * 32 + 8 * fq;
#pragma unroll
        for (int ai = 0; ai < 2; ++ai)
#pragma unroll
            for (int mp = 0; mp < 2; ++mp) { u32x4 ga[2][2], gb[2][2];
#pragma unroll
                for (int mm = 0; mm < 2; ++mm) { int rowi = row0 + ai * 128 + (mp * 2 + mm) * 16; asm volatile("" : "+v"(rowi));
#pragma unroll
                    for (int bj = 0; bj < 2; ++bj) { const size_t o = (size_t)rowi * 2048 + col0 + bj * 128; ga[mm][bj] = *(const u32x4*)(gr + o); gb[mm][bj] = *(const u32x4*)(gm + o); } }
#pragma unroll
                for (int mm = 0; mm < 2; ++mm)
#pragma unroll
                    for (int bj = 0; bj < 2; ++bj) { const u32x4 a = ga[mm][bj], b = gb[mm][bj]; f32x4 r0, r1;
                        r0[0] = bf_lo(a.x) * __builtin_amdgcn_rcpf(fmaxf(bf_lo(b.x), 1e-30f)); r0[1] = bf_hi(a.x) * __builtin_amdgcn_rcpf(fmaxf(bf_hi(b.x), 1e-30f));
                        r0[2] = bf_lo(a.y) * __builtin_amdgcn_rcpf(fmaxf(bf_lo(b.y), 1e-30f)); r0[3] = bf_hi(a.y) * __builtin_amdgcn_rcpf(fmaxf(bf_hi(b.y), 1e-30f));
                        r1[0] = bf_lo(a.z) * __builtin_amdgcn_rcpf(fmaxf(bf_lo(b.z), 1e-30f)); r1[1] = bf_hi(a.z) * __builtin_amdgcn_rcpf(fmaxf(bf_hi(b.z), 1e-30f));
                        r1[2] = bf_lo(a.w) * __builtin_amdgcn_rcpf(fmaxf(bf_lo(b.w), 1e-30f)); r1[3] = bf_hi(a.w) * __builtin_amdgcn_rcpf(fmaxf(bf_hi(b.w), 1e-30f));
                        acc[ai][bj][mp * 2 + mm][0] *= r0; acc[ai][bj][mp * 2 + mm][1] *= r1; }
                asm volatile("" ::: "memory"); }
    }
    DI void operator()(AccRef acc, const Unit& u, int wr, int wc, int fr, int fq) const {
        const int row0 = u.pm * 256 + wr * 64 + fr, col0 = u.pn * 256 + wc * 32 + 8 * fq;
#pragma unroll
        for (int ai = 0; ai < 2; ++ai) { u32x4 gg[4][2]; size_t off[4];
#pragma unroll
            for (int m = 0; m < 4; ++m) { int rowi = row0 + ai * 128 + m * 16; asm volatile("" : "+v"(rowi)); off[m] = (size_t)rowi * 2048 + col0;
#pragma unroll
                for (int bj = 0; bj < 2; ++bj) gg[m][bj] = *(const u32x4*)(gm + off[m] + bj * 128); }
#pragma unroll
            for (int m = 0; m < 4; ++m)
#pragma unroll
                for (int bj = 0; bj < 2; ++bj) { const u32x4 g = gg[m][bj]; const f32x4 a0 = acc[ai][bj][m][0], a1 = acc[ai][bj][m][1];
                    u32x4 w; w.x = cvt_pk_bf16(a0[0] * bf_lo(g.x), a0[1] * bf_hi(g.x)); w.y = cvt_pk_bf16(a0[2] * bf_lo(g.y), a0[3] * bf_hi(g.y));
                    w.z = cvt_pk_bf16(a1[0] * bf_lo(g.z), a1[1] * bf_hi(g.z)); w.w = cvt_pk_bf16(a1[2] * bf_lo(g.w), a1[3] * bf_hi(g.w));
                    *(u32x4*)(mixed + off[m] + bj * 128) = w; }
            asm volatile("" ::: "memory"); }
    }
};
struct EpiResid {
    static constexpr bool PERM = true, DUAL = false;
    const float* base; float* out; const float* mod; const float* b_ada; int chunk; float gscale;
    DI void operator()(AccRef acc, const Unit& u, int wr, int wc, int fr, int fq) const {
        const int row0 = u.pm * 256 + wr * 64 + fr, col0 = u.pn * 256 + wc * 32 + 8 * fq, b = u.pm >> 3;
        f32x4 gt[2][2];
#pragma unroll
        for (int bj = 0; bj < 2; ++bj)
#pragma unroll
            for (int n = 0; n < 2; ++n) { const int c = chunk * 2048 + col0 + bj * 128 + n * 4; gt[bj][n] = (*(const f32x4*)(mod + b * 12288 + c) + *(const f32x4*)(b_ada + c)) * gscale; }
#pragma unroll
        for (int ai = 0; ai < 2; ++ai)
#pragma unroll
            for (int mp = 0; mp < 2; ++mp) {
                f32x4 bv[2][2][2]; size_t off[2];
#pragma unroll
                for (int mm = 0; mm < 2; ++mm) { int rowi = row0 + ai * 128 + (mp * 2 + mm) * 16; asm volatile("" : "+v"(rowi)); off[mm] = (size_t)rowi * 2048 + col0;
#pragma unroll
                    for (int bj = 0; bj < 2; ++bj)
#pragma unroll
                        for (int n = 0; n < 2; ++n) bv[mm][bj][n] = *(const f32x4*)(base + off[mm] + bj * 128 + n * 4); }
#pragma unroll
                for (int mm = 0; mm < 2; ++mm)
#pragma unroll
                    for (int bj = 0; bj < 2; ++bj)
#pragma unroll
                        for (int n = 0; n < 2; ++n) *(f32x4*)(out + off[mm] + bj * 128 + n * 4) = bv[mm][bj][n] + gt[bj][n] * acc[ai][bj][mp * 2 + mm][n];
                asm volatile("" ::: "memory"); }
    }
};
DI float dpp_prev(float x) { return __int_as_float(__builtin_amdgcn_update_dpp(0, __float_as_int(x), 0x121, 0xf, 0xf, false)); }
DI float dpp_next(float x) { return __int_as_float(__builtin_amdgcn_update_dpp(0, __float_as_int(x), 0x12F, 0xf, 0xf, false)); }
struct EpiUp {
    static constexpr bool PERM = true, DUAL = false;
    bf16_t *u, *aside, *vside; const float *cw, *cb;
    DI void operator()(AccRef acc, const Unit& un, int wr, int wc, int fr, int fq) const {
        const int ch0 = un.pn * 128 + wc * 32 + 8 * fq;
        f32x4 w0[2], w1[2], w2[2], bb[2];
#pragma unroll
        for (int n = 0; n < 2; ++n) { w0[n] = *(const f32x4*)(cw + ch0 + 4 * n); w1[n] = *(const f32x4*)(cw + FFN + ch0 + 4 * n); w2[n] = *(const f32x4*)(cw + 2 * FFN + ch0 + 4 * n); bb[n] = *(const f32x4*)(cb + ch0 + 4 * n); }
#pragma unroll
        for (int ai = 0; ai < 2; ++ai) {
            int rowb = un.pm * 256 + ai * 128 + wr * 64; asm volatile("" : "+s"(rowb));
            u32x2 pu[4][2], pa[4][2], pv[4][2];
#pragma unroll
            for (int n = 0; n < 2; ++n) {
                f32x4 rd[4], ru[4];
#pragma unroll
                for (int m = 0; m < 4; ++m)
#pragma unroll
                    for (int j = 0; j < 4; ++j) { rd[m][j] = dpp_prev(acc[ai][0][m][n][j]); ru[m][j] = dpp_next(acc[ai][0][m][n][j]); }
#pragma unroll
                for (int m = 0; m < 4; ++m) { const f32x4 a = acc[ai][0][m][n], vv = acc[ai][1][m][n]; float uu[4];
#pragma unroll
                    for (int j = 0; j < 4; ++j) {
                        const float prev = (fr == 0) ? (m > 0 ? rd[m > 0 ? m - 1 : 0][j] : 0.f) : rd[m][j];
                        const float next = (fr == 15) ? (m < 3 ? ru[m < 3 ? m + 1 : 3][j] : 0.f) : ru[m][j];
                        const float z = bb[n][j] + w0[n][j] * prev + w1[n][j] * a[j] + w2[n][j] * next;
                        uu[j] = siluf_(z) * vv[j]; }
                    pu[m][n].x = cvt_pk_bf16(uu[0], uu[1]); pu[m][n].y = cvt_pk_bf16(uu[2], uu[3]);
                    if (m == 0 || m == 3) { pa[m][n].x = cvt_pk_bf16(a[0], a[1]); pa[m][n].y = cvt_pk_bf16(a[2], a[3]); pv[m][n].x = cvt_pk_bf16(vv[0], vv[1]); pv[m][n].y = cvt_pk_bf16(vv[2], vv[3]); } }
            }
#pragma unroll
            for (int m = 0; m < 4; ++m) { int rowi = rowb + m * 16 + fr; asm volatile("" : "+v"(rowi));
                u32x4 w; w.x = pu[m][0].x; w.y = pu[m][0].y; w.z = pu[m][1].x; w.w = pu[m][1].y;
                *(u32x4*)(u + (size_t)rowi * FFN + ch0) = w; }
            const int kb = rowb >> 6;
            if (fr < 2) { u32x4 w; w.x = pa[0][0].x; w.y = pa[0][0].y; w.z = pa[0][1].x; w.w = pa[0][1].y; *(u32x4*)(aside + (size_t)(kb * 4 + fr) * FFN + ch0) = w; }
            if (fr >= 14) { u32x4 w; w.x = pa[3][0].x; w.y = pa[3][0].y; w.z = pa[3][1].x; w.w = pa[3][1].y; *(u32x4*)(aside + (size_t)(kb * 4 + fr - 12) * FFN + ch0) = w; }
            if (fr == 0) { u32x4 w; w.x = pv[0][0].x; w.y = pv[0][0].y; w.z = pv[0][1].x; w.w = pv[0][1].y; *(u32x4*)(vside + (size_t)(kb * 2) * FFN + ch0) = w; }
            if (fr == 15) { u32x4 w; w.x = pv[3][0].x; w.y = pv[3][0].y; w.z = pv[3][1].x; w.w = pv[3][1].y; *(u32x4*)(vside + (size_t)(kb * 2 + 1) * FFN + ch0) = w; }
            asm volatile("" ::: "memory");
        }
    }
};

namespace att {
constexpr int NW = 8, QBLK = 32, KVBLK = 64, NT = TT / KVBLK;
constexpr size_t SHM_V = KVBLK * 128 * 2, SHM_K = KVBLK * 128 * 2, SHM_KR = KVBLK * 64 * 2;
constexpr size_t OFF_K = 2 * SHM_V, OFF_KR = OFF_K + 2 * SHM_K, OFF_WS = OFF_KR + 2 * SHM_KR;
#define KSWZ(row, colB) ((row) * 256 + ((colB) ^ (((row) & 7) << 4)))
#define KRSWZ(row, colB) ((row) * 128 + ((colB) ^ (((row) & 7) << 4)))
#define SBAR() __builtin_amdgcn_sched_barrier(0)
DI int crow(int r, int hi) { return (r & 3) + 8 * (r >> 2) + 4 * hi; }
DI int v_st(int k, int c) { const int kk = (k & ~0xC) | ((k & 4) << 1) | ((k & 8) >> 1); return ((kk >> 3) * 4 + (c >> 5)) * 512 + ((kk & 7) * 32 + (c & 31)) * 2; }
DI int v_rd_base(int lane) { return ((lane & 3) << 3) | (((lane >> 2) & 3) << 6) | (((lane >> 4) & 1) << 5) | (((lane >> 5) & 1) << 8); }
constexpr int v_rd_off(int d0, int ks, int half) { return d0 * 512 + ks * 4096 + half * 2048; }
template <int OFF> DI s16x4 tr_read(int vb) { s16x4 r; asm volatile("ds_read_b64_tr_b16 %0, %1 offset:%2" : "=&v"(r) : "v"(vb), "i"(OFF) : "memory"); return r; }
template <int D0> DI void pv_one(f32x16& od, int vb, bf16x8 pa0, bf16x8 pa1, bf16x8 pa2, bf16x8 pa3) {
    const s16x4 l0 = tr_read<v_rd_off(D0, 0, 0)>(vb), h0 = tr_read<v_rd_off(D0, 0, 1)>(vb), l1 = tr_read<v_rd_off(D0, 1, 0)>(vb), h1 = tr_read<v_rd_off(D0, 1, 1)>(vb);
    const s16x4 l2 = tr_read<v_rd_off(D0, 2, 0)>(vb), h2 = tr_read<v_rd_off(D0, 2, 1)>(vb), l3 = tr_read<v_rd_off(D0, 3, 0)>(vb), h3 = tr_read<v_rd_off(D0, 3, 1)>(vb);
    asm volatile("s_waitcnt lgkmcnt(0)" ::: "memory"); SBAR();
#define PK(L, H) (bf16x8){L[0], L[1], L[2], L[3], H[0], H[1], H[2], H[3]}
    od = __builtin_amdgcn_mfma_f32_32x32x16_bf16(pa0, PK(l0, h0), od, 0, 0, 0);
    od = __builtin_amdgcn_mfma_f32_32x32x16_bf16(pa1, PK(l1, h1), od, 0, 0, 0);
    od = __builtin_amdgcn_mfma_f32_32x32x16_bf16(pa2, PK(l2, h2), od, 0, 0, 0);
    od = __builtin_amdgcn_mfma_f32_32x32x16_bf16(pa3, PK(l3, h3), od, 0, 0, 0);
#undef PK
}
DI void pv_d0(f32x16* o, int vb, bf16x8 pa0, bf16x8 pa1, bf16x8 pa2, bf16x8 pa3) {
    pv_one<0>(o[0], vb, pa0, pa1, pa2, pa3); pv_one<1>(o[1], vb, pa0, pa1, pa2, pa3); pv_one<2>(o[2], vb, pa0, pa1, pa2, pa3); pv_one<3>(o[3], vb, pa0, pa1, pa2, pa3);
}
DI void pack_p(const f32x16& p0, const f32x16& p1, bf16x8& pa0, bf16x8& pa1, bf16x8& pa2, bf16x8& pa3) {
#define PK4(P, BASE, OUT) do { unsigned a0 = cvt_pk_bf16_t(P[BASE + 0], P[BASE + 1]), a1 = cvt_pk_bf16_t(P[BASE + 2], P[BASE + 3]);   \
    unsigned b0 = cvt_pk_bf16_t(P[BASE + 4], P[BASE + 5]), b1 = cvt_pk_bf16_t(P[BASE + 6], P[BASE + 7]);                              \
    auto r0 = __builtin_amdgcn_permlane32_swap(a0, b0, false, false); auto r1 = __builtin_amdgcn_permlane32_swap(a1, b1, false, false); \
    u32x4 w = {r0[0], r1[0], r0[1], r1[1]}; OUT = *reinterpret_cast<bf16x8*>(&w); } while (0)
    PK4(p0, 0, pa0); PK4(p0, 8, pa1); PK4(p1, 0, pa2); PK4(p1, 8, pa3);
#undef PK4
}
DI void store_tile_gated(const f32x16* o4, const float (&sc)[16], bf16_t* Ow, const bf16_t* Gw, const float* gn, int ldo, char* wl) {
    int lane = threadIdx.x & 63; asm volatile("" : "+v"(lane));
    const int r32 = lane & 31, hi = lane >> 5; const bool odd = lane & 1;
    constexpr int STR = 272;
    u32x4 g[8];
#pragma unroll
    for (int i = 0; i < 8; ++i) { const int chunk = i * 64 + lane, row = chunk >> 4, cc = chunk & 15; g[i] = *(const u32x4*)(Gw + (long)row * ldo + cc * 8); }
#pragma unroll
    for (int d0 = 0; d0 < 4; ++d0)
#pragma unroll
        for (int rp = 0; rp < 8; ++rp) {
            const float a = o4[d0][2 * rp] * sc[2 * rp], b = o4[d0][2 * rp + 1] * sc[2 * rp + 1];
            const float x = odd ? a : b;
            const float y = __int_as_float(__builtin_amdgcn_mov_dpp(__float_as_int(x), 0xB1, 0xF, 0xF, true));
            const unsigned w = cvt_pk_bf16(odd ? y : a, odd ? b : y);
            const int row = crow(2 * rp, hi) + (odd ? 1 : 0);
            *(unsigned*)(wl + row * STR + (d0 * 32 + (r32 & ~1)) * 2) = w;
        }
    const int cc = lane & 15; const f32x4 n0 = *(const f32x4*)(gn + cc * 8), n1 = *(const f32x4*)(gn + cc * 8 + 4);
#pragma unroll
    for (int i = 0; i < 8; ++i) { const int row = (i * 64 + lane) >> 4;
        const u32x4 v = *(const u32x4*)(wl + row * STR + cc * 16); const u32x4 q = g[i];
        u32x4 w; w.x = cvt_pk_bf16(bf_lo(v.x) * n0[0] * bf_lo(q.x), bf_hi(v.x) * n0[1] * bf_hi(q.x)); w.y = cvt_pk_bf16(bf_lo(v.y) * n0[2] * bf_lo(q.y), bf_hi(v.y) * n0[3] * bf_hi(q.y));
        w.z = cvt_pk_bf16(bf_lo(v.z) * n1[0] * bf_lo(q.z), bf_hi(v.z) * n1[1] * bf_hi(q.z)); w.w = cvt_pk_bf16(bf_lo(v.w) * n1[2] * bf_lo(q.w), bf_hi(v.w) * n1[3] * bf_hi(q.w));
        *(u32x4*)(Ow + (long)row * ldo + cc * 8) = w; }
}
constexpr float MLA_SCALE = 0.07216878364870322f;
constexpr float THR = 8.f;
DI void partialSM(f32x16& p0, f32x16& p1, float& m_reg, float& mn, float& alpha) {
    constexpr float C = MLA_SCALE * 1.4426950408889634f;
    float pmax = p0[0];
#pragma unroll
    for (int r = 1; r < 16; ++r) pmax = fmaxf(pmax, p0[r]);
#pragma unroll
    for (int r = 0; r < 16; ++r) pmax = fmaxf(pmax, p1[r]);
    { auto rr = __builtin_amdgcn_permlane32_swap(__float_as_uint(pmax), __float_as_uint(pmax), false, false); pmax = fmaxf(__uint_as_float(rr[0]), __uint_as_float(rr[1])); }
    if (__builtin_expect(__all(pmax - m_reg <= THR / MLA_SCALE), 1)) { mn = m_reg; alpha = 1.f; }
    else { mn = fmaxf(m_reg, pmax); alpha = __builtin_amdgcn_exp2f((m_reg - mn) * C); m_reg = mn; }
    const float mnC = -mn * C;
#pragma unroll
    for (int r = 0; r < 16; ++r) p0[r] = fmaf(p0[r], C, mnC);
#pragma unroll
    for (int r = 0; r < 16; ++r) p1[r] = fmaf(p1[r], C, mnC);
#pragma unroll
    for (int r = 0; r < 16; ++r) p0[r] = __builtin_amdgcn_exp2f(p0[r]);
}
DI void finishSM(f32x16& p0, f32x16& p1, float alpha, float& l_reg, bf16x8& pa0, bf16x8& pa1, bf16x8& pa2, bf16x8& pa3) {
#pragma unroll
    for (int r = 0; r < 16; ++r) p1[r] = __builtin_amdgcn_exp2f(p1[r]);
    float ps = 0;
#pragma unroll
    for (int r = 0; r < 16; ++r) ps += p0[r];
#pragma unroll
    for (int r = 0; r < 16; ++r) ps += p1[r];
    { auto rr = __builtin_amdgcn_permlane32_swap(__float_as_uint(ps), __float_as_uint(ps), false, false); ps = __uint_as_float(rr[0]) + __uint_as_float(rr[1]); }
    l_reg = l_reg * alpha + ps;
    pack_p(p0, p1, pa0, pa1, pa2, pa3);
}
template <int ND0>
DI void qkt(f32x16& p0, f32x16& p1, const char* Ks, const char* Krs, const bf16x8* qr, int r32, int hi, const char* qx = nullptr) {
    p0 = f32x16{}; p1 = f32x16{};
#pragma unroll
    for (int d0 = 0; d0 < 8; ++d0) { const int cb = (d0 * 16 + hi * 8) * 2;
        const bf16x8 b0 = *reinterpret_cast<const bf16x8*>(Ks + KSWZ(r32, cb));
        const bf16x8 b1 = *reinterpret_cast<const bf16x8*>(Ks + KSWZ(32 + r32, cb));
        p0 = __builtin_amdgcn_mfma_f32_32x32x16_bf16(b0, qr[d0], p0, 0, 0, 0);
        p1 = __builtin_amdgcn_mfma_f32_32x32x16_bf16(b1, qr[d0], p1, 0, 0, 0); }
    if (ND0 == 12) {
#pragma unroll
        for (int d0 = 0; d0 < 4; ++d0) { const int cb = (d0 * 16 + hi * 8) * 2;
            const bf16x8 b0 = *reinterpret_cast<const bf16x8*>(Krs + KRSWZ(r32, cb));
            const bf16x8 b1 = *reinterpret_cast<const bf16x8*>(Krs + KRSWZ(32 + r32, cb));
            const bf16x8 qf = *reinterpret_cast<const bf16x8*>(qx + d0 * 1024);
            p0 = __builtin_amdgcn_mfma_f32_32x32x16_bf16(b0, qf, p0, 0, 0, 0);
            p1 = __builtin_amdgcn_mfma_f32_32x32x16_bf16(b1, qf, p1, 0, 0, 0); }
    }
}

DI void mla_body(const bf16_t* __restrict__ Qb, const bf16_t* __restrict__ Kh, const bf16_t* __restrict__ Vh, const bf16_t* __restrict__ Krh, bf16_t* __restrict__ Ob, char* lds) {
    constexpr int LDQ = 3072, LDK = 4096, LDKR = 64, LDO = 2048;
    int tid = threadIdx.x; asm volatile("" : "+v"(tid));
    const int wid = tid >> 6, lane = tid & 63, r32 = lane & 31, hi = lane >> 5;
    char* V_lds = lds; char* K_lds = lds + OFF_K; char* Kr_lds = lds + OFF_KR;
    float* ws = (float*)(lds + OFF_WS) + wid * 64; float* li_l = ws; float* al_l = ws + 32;
    float m_reg = -1e30f, l_reg = 0; f32x16 o[4] = {}; bf16x8 qr[8];
    const bf16_t* Qw = Qb + (long)(wid * QBLK + r32) * LDQ + hi * 8;
    char* qx = lds + OFF_WS + 2048 + wid * 4096 + lane * 16;
#pragma unroll
    for (int d0 = 0; d0 < 8; ++d0) qr[d0] = *reinterpret_cast<const bf16x8*>(Qw + d0 * 16);
#pragma unroll
    for (int d0 = 0; d0 < 4; ++d0) *reinterpret_cast<bf16x8*>(qx + d0 * 1024) = *reinterpret_cast<const bf16x8*>(Qw + (8 + d0) * 16);
    const int sr = tid >> 4, sc = (tid & 15) * 8, vst0 = v_st(sr, sc), vst1 = v_st(32 + sr, sc);
    const int rr = tid >> 3, rc = (tid & 7) * 8;
    const int vb0 = (int)(uintptr_t)V_lds + v_rd_base(lane);
    struct { bf16x8 vs0, vs1, ks0, ks1, kr; } sr_[1];
#define SLOAD(i, k0) do { sr_[i].vs0 = *(const bf16x8*)(&Vh[(long)((k0) + sr) * LDK + sc]); sr_[i].vs1 = *(const bf16x8*)(&Vh[(long)((k0) + 32 + sr) * LDK + sc]); \
    sr_[i].ks0 = *(const bf16x8*)(&Kh[(long)((k0) + sr) * LDK + sc]); sr_[i].ks1 = *(const bf16x8*)(&Kh[(long)((k0) + 32 + sr) * LDK + sc]); \
    sr_[i].kr = *(const bf16x8*)(&Krh[(long)((k0) + rr) * LDKR + rc]); } while (0)
#define SWRITE(b, i) do { *(bf16x8*)(V_lds + (b) * SHM_V + vst0) = sr_[i].vs0; *(bf16x8*)(V_lds + (b) * SHM_V + vst1) = sr_[i].vs1; const int kc = sc * 2; \
    *(bf16x8*)(K_lds + (b) * SHM_K + KSWZ(sr, kc)) = sr_[i].ks0; *(bf16x8*)(K_lds + (b) * SHM_K + KSWZ(32 + sr, kc)) = sr_[i].ks1; \
    *(bf16x8*)(Kr_lds + (b) * SHM_KR + KRSWZ(rr, rc * 2)) = sr_[i].kr; } while (0)
#define SWAIT() asm volatile("s_waitcnt vmcnt(0)" ::: "memory")
#define RESC(a) do { if (__any((a) < 1.f)) { if (hi == 0) al_l[r32] = (a); asm volatile("s_waitcnt lgkmcnt(0)" ::: "memory"); \
    _Pragma("unroll") for (int d = 0; d < 4; ++d) _Pragma("unroll") for (int r = 0; r < 16; ++r) o[d][r] *= al_l[crow(r, hi)]; } } while (0)
    f32x16 pA0, pA1, pB0, pB1; float mnA, mnB, alA, alB; bf16x8 pa0, pa1, pa2, pa3;
    __syncthreads();
    SLOAD(0, 0); SWAIT(); SWRITE(0, 0); __syncthreads();
    qkt<12>(pA0, pA1, K_lds, Kr_lds, qr, r32, hi, qx); partialSM(pA0, pA1, m_reg, mnA, alA);
    SLOAD(0, KVBLK); SWAIT(); SWRITE(1, 0); __syncthreads();
    for (int j = 1; j + 1 < NT; j += 2) {
        SBAR(); qkt<12>(pB0, pB1, K_lds + SHM_K, Kr_lds + SHM_KR, qr, r32, hi, qx);
        finishSM(pA0, pA1, alA, l_reg, pa0, pa1, pa2, pa3); SBAR();
        SLOAD(0, (j + 1) * KVBLK); SBAR();
        pv_d0(o, vb0, pa0, pa1, pa2, pa3); partialSM(pB0, pB1, m_reg, mnB, alB);
        __syncthreads(); SWAIT(); SWRITE(0, 0);
        RESC(alB); __syncthreads();
        SBAR(); qkt<12>(pA0, pA1, K_lds, Kr_lds, qr, r32, hi, qx);
        finishSM(pB0, pB1, alB, l_reg, pa0, pa1, pa2, pa3); SBAR();
        SLOAD(0, (j + 2) * KVBLK); SBAR();
        pv_d0(o, vb0 + (int)SHM_V, pa0, pa1, pa2, pa3); partialSM(pA0, pA1, m_reg, mnA, alA);
        __syncthreads(); SWAIT(); SWRITE(1, 0);
        RESC(alA); __syncthreads();
    }
    SBAR(); qkt<12>(pB0, pB1, K_lds + SHM_K, Kr_lds + SHM_KR, qr, r32, hi, qx);
    finishSM(pA0, pA1, alA, l_reg, pa0, pa1, pa2, pa3); SBAR();
    pv_d0(o, vb0, pa0, pa1, pa2, pa3); partialSM(pB0, pB1, m_reg, mnB, alB);
    __syncthreads(); RESC(alB);
    finishSM(pB0, pB1, alB, l_reg, pa0, pa1, pa2, pa3); SBAR();
    pv_d0(o, vb0 + (int)SHM_V, pa0, pa1, pa2, pa3);
    if (hi == 0) li_l[r32] = l_reg; asm volatile("s_waitcnt lgkmcnt(0)" ::: "memory");
    float rli[16];
#pragma unroll
    for (int r = 0; r < 16; ++r) rli[r] = __builtin_amdgcn_rcpf(li_l[crow(r, hi)]);
    bf16_t* Ow = Ob + (long)(wid * QBLK) * LDO;
    int hio = hi, r32o = r32; asm volatile("" : "+v"(Ow), "+v"(hio), "+v"(r32o));
#pragma unroll
    for (int r = 0; r < 16; ++r) { const int orow = crow(r, hio);
#pragma unroll
        for (int d0 = 0; d0 < 4; ++d0) Ow[(long)orow * LDO + d0 * 32 + r32o] = (bf16_t)(cvt_pk_bf16(o[d0][r] * rli[r], 0.f) & 0xffffu); }
#undef SLOAD
#undef SWRITE
#undef SWAIT
#undef RESC
}

#define UNI(x) __int_as_float(__builtin_amdgcn_readfirstlane(__float_as_int(x)))
struct DecayTab { float af[4], bf[4], ab[4], bb[4], c32f, c32b; };
DI void decayP(f32x16& p0, f32x16& p1, int kt, int irow, int imin, int hi, float lf2, float lb2, const DecayTab& T) {
    if (kt < 4) {
        const float ff = (float)(irow + LC - kt * 64 - 4 * hi), fb = (float)(SEQ + kt * 64 + 4 * hi - irow);
#pragma unroll
        for (int r = 0; r < 16; ++r) { const float kf = (float)((r & 3) + 8 * (r >> 2));
            p0[r] *= __builtin_amdgcn_exp2f(lf2 * (ff - kf)) + __builtin_amdgcn_exp2f(lb2 * (fb + kf));
            p1[r] *= __builtin_amdgcn_exp2f(lf2 * (ff - kf - 32.f)) + __builtin_amdgcn_exp2f(lb2 * (fb + kf + 32.f)); }
    } else {
        const int j0 = (kt - 4) * 64;
        const float fd = (float)(irow - j0 - 4 * hi);
        if (j0 + 63 < imin) {
            const float A = __builtin_amdgcn_exp2f(lf2 * fd); float Ab[4];
#pragma unroll
            for (int q = 0; q < 4; ++q) Ab[q] = A * T.bf[q];
#pragma unroll
            for (int r = 0; r < 16; ++r) { const float w = Ab[r >> 2] * T.af[r & 3]; p0[r] *= w; p1[r] *= w * T.c32f; }
        } else if (j0 > imin + 31) {
            const float A = __builtin_amdgcn_exp2f(-lb2 * fd); float Ab[4];
#pragma unroll
            for (int q = 0; q < 4; ++q) Ab[q] = A * T.bb[q];
#pragma unroll
            for (int r = 0; r < 16; ++r) { const float w = Ab[r >> 2] * T.ab[r & 3]; p0[r] *= w; p1[r] *= w * T.c32b; }
        } else {
#pragma unroll
            for (int r = 0; r < 16; ++r) { const float kf = (float)((r & 3) + 8 * (r >> 2));
                const float d0 = fd - kf, d1 = d0 - 32.f;
                const float e0 = __builtin_amdgcn_exp2f(d0 >= 0.f ? lf2 * d0 : -lb2 * d0), e1 = __builtin_amdgcn_exp2f(d1 >= 0.f ? lf2 * d1 : -lb2 * d1);
                p0[r] *= (d0 == 0.f) ? 2.f : e0; p1[r] *= (d1 == 0.f) ? 2.f : e1; }
        }
    }
}
DI void ret_body(const bf16_t* __restrict__ Qb, const bf16_t* __restrict__ Kh, const bf16_t* __restrict__ Vh, bf16_t* __restrict__ Ob, float* __restrict__ ssq, int irow0, float lf2, float lb2, char* lds) {
    constexpr int LDQ = 1024, LDK = 1024, LDV = 2048, LDO = 2048;
    int tid = threadIdx.x; asm volatile("" : "+v"(tid));
    const int wid = __builtin_amdgcn_readfirstlane(tid >> 6), lane = tid & 63, r32 = lane & 31, hi = lane >> 5;
    char* V_lds = lds; char* K_lds = lds + OFF_K;
    DecayTab T;
#pragma unroll
    for (int m = 0; m < 4; ++m) { T.af[m] = UNI(__builtin_amdgcn_exp2f(-lf2 * (float)m)); T.bf[m] = UNI(__builtin_amdgcn_exp2f(-lf2 * (float)(8 * m))); T.ab[m] = UNI(__builtin_amdgcn_exp2f(lb2 * (float)m)); T.bb[m] = UNI(__builtin_amdgcn_exp2f(lb2 * (float)(8 * m))); }
    T.c32f = UNI(__builtin_amdgcn_exp2f(-lf2 * 32.f)); T.c32b = UNI(__builtin_amdgcn_exp2f(lb2 * 32.f));
    const int imin = irow0 + wid * QBLK;
    f32x16 o[4] = {}; bf16x8 qr[8];
    const bf16_t* Qw = Qb + (long)(wid * QBLK + r32) * LDQ + hi * 8;
#pragma unroll
    for (int d0 = 0; d0 < 8; ++d0) qr[d0] = *reinterpret_cast<const bf16x8*>(Qw + d0 * 16);
    const int irow = irow0 + wid * QBLK + r32;
    const int sr = tid >> 4, sc = (tid & 15) * 8, vst0 = v_st(sr, sc), vst1 = v_st(32 + sr, sc);
    const int vb0 = (int)(uintptr_t)V_lds + v_rd_base(lane);
    struct { bf16x8 vs0, vs1, ks0, ks1; } sr_[1];
#define SLOAD(i, k0) do { sr_[i].vs0 = *(const bf16x8*)(&Vh[(long)((k0) + sr) * LDV + sc]); sr_[i].vs1 = *(const bf16x8*)(&Vh[(long)((k0) + 32 + sr) * LDV + sc]); \
    sr_[i].ks0 = *(const bf16x8*)(&Kh[(long)((k0) + sr) * LDK + sc]); sr_[i].ks1 = *(const bf16x8*)(&Kh[(long)((k0) + 32 + sr) * LDK + sc]); } while (0)
#define SWRITE(b, i) do { *(bf16x8*)(V_lds + (b) * SHM_V + vst0) = sr_[i].vs0; *(bf16x8*)(V_lds + (b) * SHM_V + vst1) = sr_[i].vs1; const int kc = sc * 2; \
    *(bf16x8*)(K_lds + (b) * SHM_K + KSWZ(sr, kc)) = sr_[i].ks0; *(bf16x8*)(K_lds + (b) * SHM_K + KSWZ(32 + sr, kc)) = sr_[i].ks1; } while (0)
#define SWAIT() asm volatile("s_waitcnt vmcnt(0)" ::: "memory")
    f32x16 pA0, pA1, pB0, pB1; bf16x8 pa0, pa1, pa2, pa3;
    __syncthreads();
    SLOAD(0, 0); SWAIT(); SWRITE(0, 0); __syncthreads();
    qkt<8>(pA0, pA1, K_lds, K_lds, qr, r32, hi); decayP(pA0, pA1, 0, irow, imin, hi, lf2, lb2, T);
    SLOAD(0, KVBLK); SWAIT(); SWRITE(1, 0); __syncthreads();
    for (int j = 1; j + 1 < NT; j += 2) {
        SBAR(); qkt<8>(pB0, pB1, K_lds + SHM_K, K_lds, qr, r32, hi);
        pack_p(pA0, pA1, pa0, pa1, pa2, pa3); SBAR();
        SLOAD(0, (j + 1) * KVBLK); SBAR();
        pv_d0(o, vb0, pa0, pa1, pa2, pa3); decayP(pB0, pB1, j, irow, imin, hi, lf2, lb2, T);
        __syncthreads(); SWAIT(); SWRITE(0, 0);
        __syncthreads();
        SBAR(); qkt<8>(pA0, pA1, K_lds, K_lds, qr, r32, hi);
        pack_p(pB0, pB1, pa0, pa1, pa2, pa3); SBAR();
        SLOAD(0, (j + 2) * KVBLK); SBAR();
        pv_d0(o, vb0 + (int)SHM_V, pa0, pa1, pa2, pa3); decayP(pA0, pA1, j + 1, irow, imin, hi, lf2, lb2, T);
        __syncthreads(); SWAIT(); SWRITE(1, 0);
        __syncthreads();
    }
    SBAR(); qkt<8>(pB0, pB1, K_lds + SHM_K, K_lds, qr, r32, hi);
    pack_p(pA0, pA1, pa0, pa1, pa2, pa3); SBAR();
    pv_d0(o, vb0, pa0, pa1, pa2, pa3); decayP(pB0, pB1, NT - 1, irow, imin, hi, lf2, lb2, T);
    __syncthreads();
    pack_p(pB0, pB1, pa0, pa1, pa2, pa3); SBAR();
    pv_d0(o, vb0 + (int)SHM_V, pa0, pa1, pa2, pa3);
    bf16_t* Ow = Ob + (long)(wid * QBLK) * LDO; float* ssw = ssq + (long)(wid * QBLK) * 8;
    int hio = hi, r32o = r32; asm volatile("" : "+v"(Ow), "+v"(ssw), "+v"(hio), "+v"(r32o));
#pragma unroll
    for (int r = 0; r < 16; ++r) { const int orow = crow(r, hio);
        float s = 0.f;
#pragma unroll
        for (int d0 = 0; d0 < 4; ++d0) { s += o[d0][r] * o[d0][r]; Ow[(long)orow * LDO + d0 * 32 + r32o] = (bf16_t)(cvt_pk_bf16(o[d0][r], 0.f) & 0xffffu); }
#pragma unroll
        for (int x = 1; x < 32; x <<= 1) s += __shfl_xor(s, x);
        if (r32o == 0) ssw[(long)orow * 8] = s; }
#undef SLOAD
#undef SWRITE
#undef SWAIT
}
DI void decay32(f32x16& p0, int kt, int irow, int imin, int hi, float lf2, float lb2, const DecayTab& T) {
    if (kt < 8) {
        const float ff = (float)(irow + LC - kt * 32 - 4 * hi), fb = (float)(SEQ + kt * 32 + 4 * hi - irow);
#pragma unroll
        for (int r = 0; r < 16; ++r) { const float kf = (float)((r & 3) + 8 * (r >> 2)); p0[r] *= __builtin_amdgcn_exp2f(lf2 * (ff - kf)) + __builtin_amdgcn_exp2f(lb2 * (fb + kf)); }
    } else {
        const int j0 = (kt - 8) * 32; const float fd = (float)(irow - j0 - 4 * hi);
        if (j0 < imin) {
            const float A = __builtin_amdgcn_exp2f(lf2 * fd); float Ab[4];
#pragma unroll
            for (int q = 0; q < 4; ++q) Ab[q] = A * T.bf[q];
#pragma unroll
            for (int r = 0; r < 16; ++r) p0[r] *= Ab[r >> 2] * T.af[r & 3];
        } else if (j0 > imin) {
            const float A = __builtin_amdgcn_exp2f(-lb2 * fd); float Ab[4];
#pragma unroll
            for (int q = 0; q < 4; ++q) Ab[q] = A * T.bb[q];
#pragma unroll
            for (int r = 0; r < 16; ++r) p0[r] *= Ab[r >> 2] * T.ab[r & 3];
        } else {
#pragma unroll
            for (int r = 0; r < 16; ++r) { const float d0 = fd - (float)((r & 3) + 8 * (r >> 2));
                const float e0 = __builtin_amdgcn_exp2f(d0 >= 0.f ? lf2 * d0 : -lb2 * d0); p0[r] *= (d0 == 0.f) ? 2.f : e0; }
        }
    }
}
template <int D0> DI void pv32_one(f32x16& od, int vb, bf16x8 pa0, bf16x8 pa1) {
    const s16x4 l0 = tr_read<v_rd_off(D0, 0, 0)>(vb), h0 = tr_read<v_rd_off(D0, 0, 1)>(vb), l1 = tr_read<v_rd_off(D0, 1, 0)>(vb), h1 = tr_read<v_rd_off(D0, 1, 1)>(vb);
    asm volatile("s_waitcnt lgkmcnt(0)" ::: "memory"); SBAR();
#define PK(L, H) (bf16x8){L[0], L[1], L[2], L[3], H[0], H[1], H[2], H[3]}
    od = __builtin_amdgcn_mfma_f32_32x32x16_bf16(pa0, PK(l0, h0), od, 0, 0, 0);
    od = __builtin_amdgcn_mfma_f32_32x32x16_bf16(pa1, PK(l1, h1), od, 0, 0, 0);
#undef PK
}
DI void ret_body3(const bf16_t* __restrict__ Qb, const bf16_t* __restrict__ Kh, const bf16_t* __restrict__ Vh, bf16_t* __restrict__ Ob, const bf16_t* __restrict__ Rg, const float* __restrict__ gn, int irow0, float lf2, float lb2, char* lds) {
    constexpr int LDQ = 1024, LDK = 1024, LDV = 2048, LDO = 2048, KB = 32, NT3 = TT / KB, VIMG = 8192, VBUF = 2 * VIMG, KBUF = 8192, OFFK3 = 2 * VBUF;
    int tid = threadIdx.x; asm volatile("" : "+v"(tid));
    const int wid = __builtin_amdgcn_readfirstlane(tid >> 6), lane = tid & 63, r32 = lane & 31, hi = lane >> 5;
    char* V_lds = lds; char* K_lds = lds + OFFK3;
    DecayTab T;
#pragma unroll
    for (int m = 0; m < 4; ++m) { T.af[m] = UNI(__builtin_amdgcn_exp2f(-lf2 * (float)m)); T.bf[m] = UNI(__builtin_amdgcn_exp2f(-lf2 * (float)(8 * m))); T.ab[m] = UNI(__builtin_amdgcn_exp2f(lb2 * (float)m)); T.bb[m] = UNI(__builtin_amdgcn_exp2f(lb2 * (float)(8 * m))); }
    T.c32f = 0.f; T.c32b = 0.f;
    const int imin = irow0 + wid * QBLK;
    f32x16 o[8] = {}; bf16x8 qr[8];
    const bf16_t* Qw = Qb + (long)(wid * QBLK + r32) * LDQ + hi * 8;
#pragma unroll
    for (int d0 = 0; d0 < 8; ++d0) qr[d0] = *reinterpret_cast<const bf16x8*>(Qw + d0 * 16);
    const int irow = irow0 + wid * QBLK + r32;
    const int sr = tid >> 4, sc = (tid & 15) * 8, vst0 = v_st(sr, sc), kst0 = KSWZ(sr, sc * 2);
    const int vb0 = (int)(uintptr_t)V_lds + v_rd_base(lane);
    bf16x8 vsa, vsb, ks;
#define SLOAD3(k0) do { vsa = *(const bf16x8*)(&Vh[(long)((k0) + sr) * LDV + sc]); vsb = *(const bf16x8*)(&Vh[(long)((k0) + sr) * LDV + 128 + sc]); ks = *(const bf16x8*)(&Kh[(long)((k0) + sr) * LDK + sc]); } while (0)
#define SWRITE3(b) do { *(bf16x8*)(V_lds + (b) * VBUF + vst0) = vsa; *(bf16x8*)(V_lds + (b) * VBUF + VIMG + vst0) = vsb; *(bf16x8*)(K_lds + (b) * KBUF + kst0) = ks; } while (0)
    f32x16 p0; bf16x8 pa0, pa1;
    __syncthreads();
    SLOAD3(0); asm volatile("s_waitcnt vmcnt(0)" ::: "memory"); SWRITE3(0); __syncthreads();
    for (int j = 0; j < NT3; ++j) {
        const int bsel = j & 1;
        if (j + 1 < NT3) SLOAD3((j + 1) * KB);
        SBAR();
        { const char* Ks = K_lds + bsel * KBUF; p0 = f32x16{};
#pragma unroll
          for (int d0 = 0; d0 < 8; ++d0) { const bf16x8 b0 = *reinterpret_cast<const bf16x8*>(Ks + KSWZ(r32, (d0 * 16 + hi * 8) * 2)); p0 = __builtin_amdgcn_mfma_f32_32x32x16_bf16(b0, qr[d0], p0, 0, 0, 0); } }
        decay32(p0, j, irow, imin, hi, lf2, lb2, T);
        {
#define PK4(P, BASE, OUT) do { unsigned a0 = cvt_pk_bf16(P[BASE + 0], P[BASE + 1]), a1 = cvt_pk_bf16(P[BASE + 2], P[BASE + 3]);   \
    unsigned b0 = cvt_pk_bf16(P[BASE + 4], P[BASE + 5]), b1 = cvt_pk_bf16(P[BASE + 6], P[BASE + 7]);                              \
    auto r0 = __builtin_amdgcn_permlane32_swap(a0, b0, false, false); auto r1 = __builtin_amdgcn_permlane32_swap(a1, b1, false, false); \
    u32x4 w = {r0[0], r1[0], r0[1], r1[1]}; OUT = *reinterpret_cast<bf16x8*>(&w); } while (0)
          PK4(p0, 0, pa0); PK4(p0, 8, pa1);
#undef PK4
        }
        SBAR();
        { const int vb = vb0 + bsel * VBUF;
          pv32_one<0>(o[0], vb, pa0, pa1); pv32_one<1>(o[1], vb, pa0, pa1); pv32_one<2>(o[2], vb, pa0, pa1); pv32_one<3>(o[3], vb, pa0, pa1);
          pv32_one<0>(o[4], vb + VIMG, pa0, pa1); pv32_one<1>(o[5], vb + VIMG, pa0, pa1); pv32_one<2>(o[6], vb + VIMG, pa0, pa1); pv32_one<3>(o[7], vb + VIMG, pa0, pa1); }
        if (j + 1 < NT3) { asm volatile("s_waitcnt vmcnt(0)" ::: "memory"); SWRITE3(bsel ^ 1); }
        __syncthreads();
    }
    float rstd[16];
#pragma unroll
    for (int r = 0; r < 16; ++r) { float sq = 0.f;
#pragma unroll
        for (int d0 = 0; d0 < 8; ++d0) sq += o[d0][r] * o[d0][r];
#pragma unroll
        for (int x = 1; x < 32; x <<= 1) sq += __shfl_xor(sq, x);
        rstd[r] = __builtin_amdgcn_rsqf(sq * (1.f / 256.f) + EPS); }
    store_tile_gated(o, rstd, Ob + (long)(wid * QBLK) * LDO, Rg + (long)(wid * QBLK) * LDO, gn, LDO, lds + wid * 8704);
    store_tile_gated(o + 4, rstd, Ob + (long)(wid * QBLK) * LDO + 128, Rg + (long)(wid * QBLK) * LDO + 128, gn + 128, LDO, lds + wid * 8704);
#undef SLOAD3
#undef SWRITE3
}
}

DI int rope128perm(int vv) { const int wc = vv >> 5, fq = (vv >> 3) & 3, n = (vv >> 2) & 1, j = vv & 3; const int p = (wc * 4 + fq) * 4 + j; return (p >> 5) * 64 + n * 32 + (p & 31); }
DI int rope32perm(int vv) { const int fq = vv >> 3, n = (vv >> 2) & 1, j = vv & 3; return n * 16 + fq * 4 + j; }
DI int src_col(int mode, int v) {
    if (mode == 0) return v;
    if (mode == 1) {
        if (v < 1024) return (v & ~127) + rope128perm(v & 127);
        if (v < 3584) return v;
        if (v < 3840) { const int vv = v - 3584; return vv < 64 ? 3584 + (vv & ~31) + rope32perm(vv & 31) : -1; }
        if (v < 4864) { const int vv = v - 3840; return 3648 + (vv & ~127) + rope128perm(vv & 127); }
        return v - 192;
    }
    if (mode == 3) { const int pn = v >> 8, bj = (v >> 7) & 1, i = v & 127; return (bj ? FFN : 0) + pn * 128 + i; }
    const int g = v >> 5, gi = g % 6; return gi < 4 ? v : (v & ~31) + rope32perm(v & 31);
}
DI void conv_weight(const float* __restrict__ W, int ldw, bf16_t* __restrict__ Bt, int K, int N, int mode, const float* __restrict__ kscale, int rot, unsigned* lds32) {
    int tid = threadIdx.x; asm volatile("" : "+v"(tid));
    const int G = gridDim.x, nkt = K / 128, ntiles = (N / 128) * nkt;
    for (int t = (int)((blockIdx.x + G - (rot % G)) % G); t < ntiles; t += G) {
        const int n0 = (t / nkt) * 128, k0 = (t % nkt) * 128;
        { const int nn = tid & 127, kq = tid >> 7; const int scol = src_col(mode, n0 + nn);
#pragma unroll 4
          for (int i = 0; i < 16; ++i) { const int kp = kq + 4 * i, k = k0 + 2 * kp; float a = 0.f, b = 0.f;
              if (scol >= 0) { a = W[(size_t)k * ldw + scol]; b = W[(size_t)(k + 1) * ldw + scol]; }
              if (kscale) { a *= kscale[k]; b *= kscale[k + 1]; }
              lds32[nn * 68 + kp] = cvt_pk_bf16(a, b); } }
        __syncthreads();
        { const int n = tid >> 2, seg = tid & 3;
#pragma unroll
          for (int q = 0; q < 4; ++q) { const u32x4 w = *(const u32x4*)(lds32 + n * 68 + seg * 16 + q * 4); *(u32x4*)(Bt + (size_t)(n0 + n) * K + k0 + seg * 32 + q * 8) = w; } }
        __syncthreads();
    }
}

template <int MODE>
DI void rows_norm(const Params& p, const float* mod) {
    int tid = threadIdx.x; asm volatile("" : "+v"(tid));
    const int lane = tid & 63, gw = blockIdx.x * 8 + (tid >> 6), nw = gridDim.x * 8;
    const int nrows = MODE == 0 ? MROWS : SROWS; const int per = (nrows + nw - 1) / nw;
    float sc[32], sh[32]; int cur = -1;
    if (MODE == 2) {
#pragma unroll
        for (int i = 0; i < 8; ++i) { const f32x4 w = *(const f32x4*)(p.final_norm + i * 256 + lane * 4); sc[i * 4] = w[0]; sc[i * 4 + 1] = w[1]; sc[i * 4 + 2] = w[2]; sc[i * 4 + 3] = w[3]; }
    }
    auto rowsrc = [&](int row, int& mr) -> const float* {
        if (MODE == 0) { const int b = row / TT, t = row % TT; if (t < LC) { mr = 8; return p.ctx + ((size_t)b * LC + t) * DM; } mr = b; return p.x + ((size_t)b * SEQ + t - LC) * DM; }
        mr = row / SEQ; return p.out + (size_t)row * DM; };
    const int rbeg = gw * per, rend = ((gw + 1) * per < nrows) ? (gw + 1) * per : nrows;
    f32x4 vn[8];
    if (rbeg < rend) { int mr0; const float* s0 = rowsrc(rbeg, mr0);
#pragma unroll
        for (int i = 0; i < 8; ++i) vn[i] = *(const f32x4*)(s0 + i * 256 + lane * 4); }
    for (int row = rbeg; row < rend; ++row) {
        int mr; (void)rowsrc(row, mr);
        if (MODE != 2 && mr != cur) { cur = mr; const int csh = MODE == 0 ? 0 : 3, csc = csh + 1;
#pragma unroll
            for (int i = 0; i < 8; ++i) { const int c = i * 256 + lane * 4;
                const f32x4 a = *(const f32x4*)(mod + mr * 12288 + csc * 2048 + c) + *(const f32x4*)(p.b_ada + csc * 2048 + c);
                const f32x4 s = *(const f32x4*)(mod + mr * 12288 + csh * 2048 + c) + *(const f32x4*)(p.b_ada + csh * 2048 + c);
#pragma unroll
                for (int j = 0; j < 4; ++j) { sc[i * 4 + j] = 1.f + a[j]; sh[i * 4 + j] = s[j]; } } }
        f32x4 v[8]; float ss = 0.f;
#pragma unroll
        for (int i = 0; i < 8; ++i) { v[i] = vn[i]; ss += v[i][0] * v[i][0] + v[i][1] * v[i][1] + v[i][2] * v[i][2] + v[i][3] * v[i][3]; }
        if (row + 1 < rend) { int mrn; const float* sn = rowsrc(row + 1, mrn);
#pragma unroll
            for (int i = 0; i < 8; ++i) vn[i] = *(const f32x4*)(sn + i * 256 + lane * 4); }
        ss = wave_sum(ss); float rstd = __builtin_amdgcn_rsqf(ss * (1.f / DM) + EPS);
#if MK_DEBUG
        if (MODE == 2) { const float* dbg = (const float*)(p.ws + WS_DBG); int first = -1; for (int k = 15; k >= 0; --k) if (dbg[k] > 0.08f) first = k; rstd *= 1.f + 0.1f * (float)(first + 1); }
#endif
        if (MODE == 2) {
#pragma unroll
            for (int i = 0; i < 8; ++i) { f32x4 o; o[0] = v[i][0] * rstd * sc[i * 4]; o[1] = v[i][1] * rstd * sc[i * 4 + 1]; o[2] = v[i][2] * rstd * sc[i * 4 + 2]; o[3] = v[i][3] * rstd * sc[i * 4 + 3];
                *(f32x4*)(p.out + (size_t)row * DM + i * 256 + lane * 4) = o; }
        } else {
            bf16_t* dst = (bf16_t*)(p.ws + (MODE == 0 ? WS_HBUF : WS_H2)) + (size_t)row * DM;
#pragma unroll
            for (int i = 0; i < 8; ++i) { u32x2 w; w.x = cvt_pk_bf16(v[i][0] * rstd * sc[i * 4] + sh[i * 4], v[i][1] * rstd * sc[i * 4 + 1] + sh[i * 4 + 1]);
                w.y = cvt_pk_bf16(v[i][2] * rstd * sc[i * 4 + 2] + sh[i * 4 + 2], v[i][3] * rstd * sc[i * 4 + 3] + sh[i * 4 + 3]);
                *(u32x2*)(dst + i * 256 + lane * 4) = w; }
        }
    }
}


#if MK_DEBUG
DI unsigned hsh(unsigned x) { x ^= x >> 16; x *= 0x7feb352dU; x ^= x >> 15; x *= 0x846ca68bU; x ^= x >> 16; return x; }
DI void dbg_report(float* dbg, int k, float err) { if ((threadIdx.x & 63) == 0) atomicMax((int*)dbg + k, __float_as_int(fabsf(err))); }
DI float bfr(float x) { return bf_lo(cvt_pk_bf16(x, 0.f)); }
DI float bfv(const bf16_t* p, size_t i) { return __uint_as_float(((unsigned)p[i]) << 16); }
DI int samp_s(int si) { const int q = (si >> 3) & 7; return si < 64 ? (q == 0 ? 0 : q == 1 ? 1 : q == 2 ? 63 : q == 3 ? 64 : q == 4 ? 255 : q == 5 ? 256 : q == 6 ? 1024 : 2047) : (int)(hsh(si * 77 + 5) & 2047); }
DI float relerr(float ref, float got, float floor_) { return fabsf(ref - got) / (fabsf(ref) + floor_); }
DI float wdot(const bf16_t* A, int K, const float* W, int ldw, int col, const float* ks) {
    const int lane = threadIdx.x & 63; float a = 0.f;
    for (int k = lane; k < K; k += 64) a += bfv(A, k) * bfr(W[(size_t)k * ldw + col] * (ks ? ks[k] : 1.f));
    return wave_sum(a);
}
DI void rope_ref(float t1, float t2, float pos, int f, float q4, bool on, float& o1, float& o2) {
    const float ang = pos * __builtin_amdgcn_exp2f(-(float)f * 13.287712379549449f / q4); const float c = on ? __cosf(ang) : 1.f, sn = on ? __sinf(ang) : 0.f;
    o1 = t1 * c - t2 * sn; o2 = t2 * c + t1 * sn;
}
__global__ __launch_bounds__(512) void dbg_kernel(Params p, int ph) {
    const int bid = blockIdx.x;
    unsigned char* ws = p.ws; float* dbg = (float*)(ws + WS_DBG); const float* mod = (const float*)(ws + WS_MOD);
    float* sav = (float*)(ws + 655360);
    const int lane = threadIdx.x & 63, wid = threadIdx.x >> 6;
    for (int rnd = 0; rnd < 9; ++rnd) {
    const int si = rnd * 2048 + bid * 8 + wid;
    const unsigned hh = hsh(si * 2654435761u + ph * 97u);
    const bool okS = si < SROWS;
    const int b = (si >> 11) & 7, s = si & 2047;
    const int bT = si / TT, t = si % TT;
    if (ph == 1 && rnd == 0) {
        for (int q = 0; q < 54; ++q) { const int e = (si * 54 + q); if (e < 9 * 12288) { const int r = e / 12288, n = e % 12288; float a = 0.f;
            for (int k = lane; k < 2048; k += 64) { const float xv = r < 8 ? p.c[r * 2048 + k] : p.c_ctx[k]; a += xv / (1.f + expf(-xv)) * p.w_ada[(size_t)k * 12288 + n]; }
            a = wave_sum(a); dbg_report(dbg, 0, relerr(a, mod[r * 12288 + n], 0.05f)); } }
    }
    if (ph == 2 || (ph == 9 && okS)) {
        const bool isH = ph == 2;
        const float* src; int mr; size_t drow; const bf16_t* dst;
        if (isH) { if (t < LC) { src = p.ctx + ((size_t)bT * LC + t) * DM; mr = 8; } else { src = p.x + ((size_t)bT * SEQ + t - LC) * DM; mr = bT; } drow = (size_t)si; dst = (const bf16_t*)(ws + WS_HBUF); }
        else { src = p.out + (size_t)si * DM; mr = b; drow = (size_t)si; dst = (const bf16_t*)(ws + WS_H2); }
        float ss = 0.f; for (int k = lane; k < DM; k += 64) ss += src[k] * src[k]; ss = wave_sum(ss); const float rstd = 1.f / sqrtf(ss / DM + EPS);
        const int csh = isH ? 0 : 3, csc = csh + 1; float e = 0.f;
        for (int k = lane; k < DM; k += 64) { const float ref = src[k] * rstd * (1.f + mod[mr * 12288 + csc * 2048 + k] + p.b_ada[csc * 2048 + k]) + mod[mr * 12288 + csh * 2048 + k] + p.b_ada[csh * 2048 + k];
            e = fmaxf(e, relerr(ref, bfv(dst, drow * DM + k), 1.f)); }
        for (int o = 32; o > 0; o >>= 1) e = fmaxf(e, __shfl_xor(e, o));
        dbg_report(dbg, isH ? 1 : 8, e);
    }
    if (ph == 3) {
      for (int rep = 0; rep < 2; ++rep) {
        const unsigned hr = hsh(hh + rep * 1234567u);
        const bool latent = t >= LC; const int seg = latent ? (int)((hr >> 8) % 9u) : (int)((hr >> 8) % 4u);
        const size_t trow = (size_t)si, srow = (size_t)bT * SEQ + (t - LC); const int sp = t - LC;
        const bf16_t* hrow = (const bf16_t*)(ws + WS_HBUF) + trow * DM; const unsigned h2 = hsh(hr);
        float e = 0.f;
        if (seg == 0 || seg == 4) { const int head = h2 & 7, half = (h2 >> 3) & 1, f = (h2 >> 4) & 31, base = (seg == 0 ? 0 : 3648) + head * 128 + half * 64 + f;
            const float t1 = wdot(hrow, DM, p.w_in, INCOLS, base, nullptr), t2 = wdot(hrow, DM, p.w_in, INCOLS, base + 32, nullptr); float o1, o2;
            rope_ref(t1, t2, (float)(half ? (sp & 63) : (sp >> 6)), f, 32.f, latent, o1, o2); const float sc = seg == 0 ? 0.08838834764831845f : 1.f;
            const bf16_t* dst = seg == 0 ? (const bf16_t*)(ws + WS_RK) + trow * 1024 : (const bf16_t*)(ws + WS_RQ) + srow * 1024; const int dc = head * 128 + half * 64 + f;
            e = fmaxf(relerr(o1 * sc, bfv(dst, dc), 0.05f * sc), relerr(o2 * sc, bfv(dst, dc + 32), 0.05f * sc)); }
        else if (seg == 3) { const int g = h2 & 1, f = (h2 >> 1) & 15, base = 3584 + g * 32 + f;
            const float t1 = wdot(hrow, DM, p.w_in, INCOLS, base, nullptr), t2 = wdot(hrow, DM, p.w_in, INCOLS, base + 16, nullptr); float o1, o2;
            rope_ref(t1, t2, (float)(g ? (sp & 63) : (sp >> 6)), f, 16.f, latent, o1, o2); const bf16_t* dst = (const bf16_t*)(ws + WS_KR) + trow * 64 + g * 32 + f;
            e = fmaxf(relerr(o1, bfv(dst, 0), 0.05f), relerr(o2, bfv(dst, 16), 0.05f)); }
        else { int oc, dc; const bf16_t* dst; size_t ld; size_t row; int act = 0;
            if (seg == 1) { dc = h2 % 2048u; oc = 1024 + dc; dst = (const bf16_t*)(ws + WS_RV); ld = 2048; row = trow; }
            else if (seg == 2) { dc = h2 % 512u; oc = 3072 + dc; dst = (const bf16_t*)(ws + WS_KVD); ld = 512; row = trow; }
            else if (seg == 5) { dc = h2 % 2048u; oc = 4672 + dc; dst = (const bf16_t*)(ws + WS_RG); ld = 2048; row = srow; act = 1; }
            else if (seg == 6) { dc = h2 % 512u; oc = 6720 + dc; dst = (const bf16_t*)(ws + WS_QD); ld = 512; row = srow; }
            else if (seg == 7) { dc = h2 % 2048u; oc = 7232 + dc; dst = (const bf16_t*)p.out; ld = 2048; row = srow; act = 2; }
            else { dc = h2 % 2048u; oc = 9280 + dc; dst = (const bf16_t*)p.out + (size_t)SROWS * 2048; ld = 2048; row = srow; act = 2; }
            float z = wdot(hrow, DM, p.w_in, INCOLS, oc, nullptr); if (act == 1) z = z / (1.f + expf(-z)); if (act == 2) z = 1.f / (1.f + expf(-z));
            e = relerr(z, bfv(dst, row * ld + dc), 0.05f); }
        dbg_report(dbg, 16 + seg + (latent ? 0 : 9), e);
        if (seg == 7 && latent && e > 0.08f && lane == 0) { atomicAdd((int*)dbg + 40, 1); atomicMax((int*)dbg + 41, 1000 - (int)(srow >> 8)); atomicMax((int*)dbg + 42, (int)(srow >> 8)); }
      }
    }
    if (ph == 4 && okS) {
        const int h = (hh >> 4) & 7, ecol = (hh >> 8) & 255; const size_t srow = (size_t)si;
        const bf16_t* q = (const bf16_t*)(ws + WS_RQ) + srow * 1024 + h * 128; const bf16_t* K = (const bf16_t*)(ws + WS_RK) + (size_t)b * TT * 1024 + h * 128; const bf16_t* V = (const bf16_t*)(ws + WS_RV) + (size_t)b * TT * 2048 + h * 256 + ecol;
        const float xf = p.dec_f[h], xb = p.dec_b[h]; const float lf = fminf(xf, 0.f) - log1pf(expf(-fabsf(xf))), lb = fminf(xb, 0.f) - log1pf(expf(-fabsf(xb)));
        float acc = 0.f, nrm = 0.f;
        for (int tt = lane; tt < TT; tt += 64) { float d = 0.f; for (int k = 0; k < 128; ++k) d += bfv(q, k) * bfv(K, (size_t)tt * 1024 + k);
            float w; if (tt < LC) w = expf(lf * (float)(s + LC - tt)) + expf(lb * (float)(SEQ + tt - s)); else { const int j = tt - LC; w = j < s ? expf(lf * (float)(s - j)) : j > s ? expf(lb * (float)(j - s)) : 2.f; }
            const float term = w * d * bfv(V, (size_t)tt * 2048); acc += term; nrm += term * term; }
        acc = wave_sum(acc); nrm = wave_sum(nrm);
        dbg_report(dbg, 3, fabsf(acc - bfv((const bf16_t*)(ws + WS_ORET), srow * 2048 + h * 256 + ecol)) / (fabsf(acc) + 0.25f * sqrtf(nrm) + 1e-6f));
        const bf16_t* o = (const bf16_t*)(ws + WS_ORET) + srow * 2048 + h * 256;
        float ss = 0.f; for (int k = lane; k < 256; k += 64) ss += bfv(o, k) * bfv(o, k); ss = wave_sum(ss);
        const float ref = bfv(o, ecol) / sqrtf(ss / 256.f + EPS) * p.ret_gn[h * 256 + ecol] * bfv((const bf16_t*)(ws + WS_RG), srow * 2048 + h * 256 + ecol);
        if (lane == 0) sav[si] = ref;
    }
    if (ph == 5) {
        if (okS) { const size_t srow = (size_t)si; const bf16_t* qd = (const bf16_t*)(ws + WS_QD) + srow * 512; float ss = 0.f; for (int k = lane; k < 512; k += 64) ss += bfv(qd, k) * bfv(qd, k); ss = wave_sum(ss); const float rstd = 1.f / sqrtf(ss / 512.f + EPS);
            const int head = (hh >> 4) & 15; const bf16_t* dst = (const bf16_t*)(ws + WS_QM) + srow * 3072 + head * 192; float e;
            if (hh & 1) { const int d = (hh >> 8) & 127; e = relerr(rstd * wdot(qd, 512, p.w_q_up, 3072, head * 192 + d, p.q_norm), bfv(dst, d), 0.05f); }
            else { const int g = (hh >> 8) & 1, f = (hh >> 9) & 15, base = head * 192 + 128 + g * 32 + f; float o1, o2;
                rope_ref(rstd * wdot(qd, 512, p.w_q_up, 3072, base, p.q_norm), rstd * wdot(qd, 512, p.w_q_up, 3072, base + 16, p.q_norm), (float)(g ? (s & 63) : (s >> 6)), f, 16.f, true, o1, o2);
                e = fmaxf(relerr(o1, bfv(dst, 128 + g * 32 + f), 0.05f), relerr(o2, bfv(dst, 128 + g * 32 + 16 + f), 0.05f)); }
            dbg_report(dbg, 4, e);
            const unsigned h4 = hsh(si * 2654435761u + 4 * 97u); const int hq = (h4 >> 4) & 7, eq = (h4 >> 8) & 255;
            dbg_report(dbg, 10, relerr(sav[si], bfv((const bf16_t*)(ws + WS_ORET), srow * 2048 + hq * 256 + eq), 0.03f)); }
        { const size_t trow = (size_t)si; const bf16_t* kd = (const bf16_t*)(ws + WS_KVD) + trow * 512; float ss = 0.f; for (int k = lane; k < 512; k += 64) ss += bfv(kd, k) * bfv(kd, k); ss = wave_sum(ss); const float rstd = 1.f / sqrtf(ss / 512.f + EPS);
            const int c = (hh >> 14) & 4095; dbg_report(dbg, 4, relerr(rstd * wdot(kd, 512, p.w_kv_up, 4096, c, p.kv_norm), bfv((const bf16_t*)(ws + WS_KVUP), trow * 4096 + c), 0.05f)); }
    }
    if (ph == 6 && okS) {
        const int h = (hh >> 4) & 15, ecol = (hh >> 8) & 127; const size_t srow = (size_t)si;
        const bf16_t* q = (const bf16_t*)(ws + WS_QM) + srow * 3072 + h * 192; const bf16_t* KV = (const bf16_t*)(ws + WS_KVUP) + (size_t)b * TT * 4096 + h * 256; const bf16_t* KR = (const bf16_t*)(ws + WS_KR) + (size_t)b * TT * 64;
        float mx = -1e30f;
        for (int i = 0; i < 36; ++i) { const int tt = lane + 64 * i; float d = 0.f; for (int k = 0; k < 128; ++k) d += bfv(q, k) * bfv(KV, (size_t)tt * 4096 + k); for (int k = 0; k < 64; ++k) d += bfv(q, 128 + k) * bfv(KR, (size_t)tt * 64 + k);
            mx = fmaxf(mx, d * 0.07216878364870322f); }
        for (int o = 32; o > 0; o >>= 1) mx = fmaxf(mx, __shfl_xor(mx, o));
        float l = 0.f, acc = 0.f;
        for (int i = 0; i < 36; ++i) { const int tt = lane + 64 * i; float d = 0.f; for (int k = 0; k < 128; ++k) d += bfv(q, k) * bfv(KV, (size_t)tt * 4096 + k); for (int k = 0; k < 64; ++k) d += bfv(q, 128 + k) * bfv(KR, (size_t)tt * 64 + k);
            const float pe = expf(d * 0.07216878364870322f - mx); l += pe; acc += pe * bfv(KV, (size_t)tt * 4096 + 128 + ecol); }
        l = wave_sum(l); acc = wave_sum(acc);
        dbg_report(dbg, 5, relerr(acc / l, bfv((const bf16_t*)(ws + WS_MLAO), srow * 2048 + h * 128 + ecol), 0.02f));
    }
    if (ph == 7 && okS) {
        const size_t srow = (size_t)si; const int c = (hh >> 4) & 2047;
        const float r1 = wdot((const bf16_t*)(ws + WS_ORET) + srow * 2048, 2048, p.w_ret_o, 2048, c, nullptr), r2 = wdot((const bf16_t*)(ws + WS_MLAO) + srow * 2048, 2048, p.w_mla_o, 2048, c, nullptr);
        const float ref = bfv((const bf16_t*)p.out, srow * 2048 + c) * r1 + bfv((const bf16_t*)p.out + (size_t)SROWS * 2048, srow * 2048 + c) * r2;
        dbg_report(dbg, 6, relerr(ref, bfv((const bf16_t*)(ws + WS_MIXED), srow * 2048 + c), 0.03f));
    }
    if (ph == 8 && okS) {
        const size_t srow = (size_t)si; const int c = (hh >> 4) & 2047;
        const float r = wdot((const bf16_t*)(ws + WS_MIXED) + srow * 2048, 2048, p.w_out, 2048, c, nullptr);
        const float refd = (mod[b * 12288 + 2 * 2048 + c] + p.b_ada[2 * 2048 + c]) * r;
        dbg_report(dbg, 7, relerr(refd, p.out[srow * 2048 + c] - p.x[srow * 2048 + c], 0.01f));
    }
    if (ph == 10 && okS) {
        const size_t srow = (size_t)si; const int c = (int)((hh >> 4) % 11264u);
        const float r = wdot((const bf16_t*)(ws + WS_H2) + srow * 2048, 2048, p.w_up, 2 * FFN, c, nullptr);
        const float got = c < FFN ? bfv((const bf16_t*)(ws + WS_ABUF), srow * FFN + c) : bfv((const bf16_t*)(ws + WS_VBUF), srow * FFN + c - FFN);
        dbg_report(dbg, 9, relerr(r, got, 0.05f));
        const int cu = (int)((hh >> 8) % 5632u); const bf16_t* ab = (const bf16_t*)(ws + WS_ABUF);
        const float am = s > 0 ? bfv(ab, (srow - 1) * FFN + cu) : 0.f, a0 = bfv(ab, srow * FFN + cu), ap = s < SEQ - 1 ? bfv(ab, (srow + 1) * FFN + cu) : 0.f;
        const float z = p.conv_b[cu] + p.conv_w[cu] * am + p.conv_w[FFN + cu] * a0 + p.conv_w[2 * FFN + cu] * ap;
        if (lane == 0) sav[16384 + si] = z / (1.f + expf(-z)) * bfv((const bf16_t*)(ws + WS_VBUF), srow * FFN + cu);
    }
    if (ph == 11 && okS) {
        const size_t srow = (size_t)si; const unsigned h10 = hsh(si * 2654435761u + 10 * 97u); const int c10 = (int)((h10 >> 8) % 5632u);
        dbg_report(dbg, 11, relerr(sav[16384 + si], bfv((const bf16_t*)(ws + WS_VBUF), srow * FFN + c10), 0.03f));
        const int c = (hh >> 4) & 2047; const float r = wdot((const bf16_t*)(ws + WS_VBUF) + srow * FFN, FFN, p.w_down, 2048, c, nullptr);
        if (lane == 0) { sav[2 * 16384 + si] = (mod[b * 12288 + 5 * 2048 + c] + p.b_ada[5 * 2048 + c]) * r; sav[3 * 16384 + si] = p.out[srow * 2048 + c]; }
    }
    if (ph == 12 && okS) {
        const size_t srow = (size_t)si; const unsigned h11 = hsh(si * 2654435761u + 11 * 97u); const int c11 = (h11 >> 4) & 2047;
        dbg_report(dbg, 12, relerr(sav[2 * 16384 + si], p.out[srow * 2048 + c11] - sav[3 * 16384 + si], 0.02f));
        const float* xr = p.out + srow * 2048; float ss = 0.f; for (int k = lane; k < DM; k += 64) ss += xr[k] * xr[k]; ss = wave_sum(ss);
        (void)ss;
        dbg_report(dbg, 14, 1.0f);
    }
    }
}
#endif

__global__ __launch_bounds__(512, 2) void fwd_megakernel(Params p) {
    extern __shared__ __attribute__((aligned(16))) unsigned char shm[];
    LAS unsigned char* lds = (LAS unsigned char*)shm;
    unsigned char* ws = p.ws;
    const int G = gridDim.x;
    float* mod = (float*)(ws + WS_MOD); float* ssq_kv = (float*)(ws + WS_SSQKV); float* ssq_q = (float*)(ws + WS_SSQQ); float* ssq_ret = (float*)(ws + WS_SSQRET);
    volatile LAS unsigned* xst = (volatile LAS unsigned*)(lds + pg8::STAGE_BYTES);
    if (threadIdx.x < 2) xst[threadIdx.x] = 0u;
    __syncthreads();
    const XcdBarrier xb = xcd_barrier_post((unsigned*)(ws + WS_BAR), xst);
    for (int ph = p.ph_lo; ph < p.ph_hi; ++ph) {
        if (ph > p.ph_lo) { if (ph > 1000) cg::this_grid().sync(); else xcd_barrier(xb); }
        for (int rep = 0; rep < (ph == MK_REP ? 2 : 1); ++rep) {
        int bid = blockIdx.x; asm volatile("" : "+s"(bid));
#define LOCAL_TID int tid = threadIdx.x; asm volatile("" : "+v"(tid))
        switch (ph) {
        case 0: if (PH_ON(0)) {
            unsigned* l32 = (unsigned*)shm; int rot = 0;
            conv_weight(p.w_in, INCOLS, (bf16_t*)(ws + WS_WIN), 2048, NIN, 1, nullptr, rot, l32); rot += (NIN / 128) * 16;
            conv_weight(p.w_q_up, 3072, (bf16_t*)(ws + WS_WQUP), 512, 3072, 2, p.q_norm, rot, l32); rot += 24 * 4;
            conv_weight(p.w_kv_up, 4096, (bf16_t*)(ws + WS_WKVUP), 512, 4096, 0, p.kv_norm, rot, l32); rot += 32 * 4;
            conv_weight(p.w_ret_o, 2048, (bf16_t*)(ws + WS_WRETO), 2048, 2048, 0, nullptr, rot, l32); rot += 256;
            conv_weight(p.w_mla_o, 2048, (bf16_t*)(ws + WS_WMLAO), 2048, 2048, 0, nullptr, rot, l32); rot += 256;
            conv_weight(p.w_out, 2048, (bf16_t*)(ws + WS_WOUT), 2048, 2048, 0, nullptr, rot, l32);
            float* sl = (float*)shm;
            LOCAL_TID;
            for (int it = bid; it < 768; it += G) {
                const int k0 = (it / 24) * 64, n = (it % 24) * 512 + tid;
                __syncthreads();
                for (int e = tid; e < 576; e += 512) { const int r = e >> 6, kk = e & 63; const float xv = r < 8 ? p.c[r * 2048 + k0 + kk] : p.c_ctx[k0 + kk]; sl[e] = siluf_(xv); }
                __syncthreads();
                float a[9];
#pragma unroll
                for (int r = 0; r < 9; ++r) a[r] = 0.f;
                for (int kb = 0; kb < 64; kb += 32) { float w[32];
#pragma unroll
                    for (int kk = 0; kk < 32; ++kk) w[kk] = p.w_ada[(size_t)(k0 + kb + kk) * 12288 + n];
#pragma unroll
                    for (int kk = 0; kk < 32; ++kk)
#pragma unroll
                        for (int r = 0; r < 9; ++r) a[r] += sl[r * 64 + kb + kk] * w[kk]; }
#pragma unroll
                for (int r = 0; r < 9; ++r) atomicAdd(mod + r * 12288 + n, a[r]);
            }
        } break;
        case 1: if (PH_ON(1)) rows_norm<0>(p, mod); break;
        case 2: if (PH_ON(2)) {
            pg8::Gemm g{(const bf16_t*)(ws + WS_HBUF), (const bf16_t*)(ws + WS_WIN), 2048};
            pg8::Sched<2> S{0, 0, G, bid};
            EpiInProj E{(bf16_t*)(ws + WS_RK), (bf16_t*)(ws + WS_RV), (bf16_t*)(ws + WS_KVD), (bf16_t*)(ws + WS_KR), (bf16_t*)(ws + WS_RQ), (bf16_t*)(ws + WS_RG), (bf16_t*)(ws + WS_QD),
                        (bf16_t*)p.out, (bf16_t*)p.out + (size_t)SROWS * 2048, ssq_kv, ssq_q, (bf16_t*)(ws + WS_ORET)};
            pg8::gemm_phase(lds, g, S, E);
        } break;
        case 3: if (PH_ON(3)) {
            const bf16_t* rq = (const bf16_t*)(ws + WS_RQ); const bf16_t* rk = (const bf16_t*)(ws + WS_RK); const bf16_t* rv = (const bf16_t*)(ws + WS_RV); bf16_t* oret = (bf16_t*)(ws + WS_ORET);
            for (int it0 = bid; it0 < 512; it0 += G) {
                const int it = (G == 256) ? ((((it0 >> 8) * 32 + (it0 & 7) * 4 + ((it0 & 255) >> 6)) << 3) | ((it0 >> 3) & 7)) : it0;
                const int qb = it & 7, h = (it >> 3) & 7, b = it >> 6;
                const float xf = p.dec_f[h], xb = p.dec_b[h];
                const float lf2 = (fminf(xf, 0.f) - log1pf(__expf(-fabsf(xf)))) * 1.4426950408889634f, lb2 = (fminf(xb, 0.f) - log1pf(__expf(-fabsf(xb)))) * 1.4426950408889634f;
                const size_t srow0 = (size_t)b * SEQ + qb * 256, trow0 = (size_t)b * TT;
                att::ret_body3(rq + srow0 * 1024 + h * 128, rk + trow0 * 1024 + h * 128, rv + trow0 * 2048 + h * 256, oret + srow0 * 2048 + h * 256,
                               (const bf16_t*)(ws + WS_RG) + srow0 * 2048 + h * 256, p.ret_gn + h * 256, qb * 256, lf2, lb2, (char*)shm);
            }
        } break;
        case 4: if (PH_ON(4)) {
            { pg8::Gemm g{(const bf16_t*)(ws + WS_QD), (const bf16_t*)(ws + WS_WQUP), 512}; pg8::Sched<0> S{64, 12, G, bid}; EpiQup E{(bf16_t*)(ws + WS_QM), ssq_q}; pg8::gemm_phase(lds, g, S, E); }
            __syncthreads();
            { pg8::Gemm g{(const bf16_t*)(ws + WS_KVD), (const bf16_t*)(ws + WS_WKVUP), 512}; pg8::Sched<0> S{72, 16, G, (bid + 128) % G}; EpiKvup E{(bf16_t*)(ws + WS_KVUP), ssq_kv}; pg8::gemm_phase(lds, g, S, E); }
        } break;
        case 5: if (PH_ON(5)) {
            conv_weight(p.w_up, 2 * FFN, (bf16_t*)(ws + WS_WUP), 2048, 2 * FFN, 3, nullptr, 0, (unsigned*)shm);
            const bf16_t* qm = (const bf16_t*)(ws + WS_QM); const bf16_t* kvup = (const bf16_t*)(ws + WS_KVUP); const bf16_t* kr = (const bf16_t*)(ws + WS_KR); bf16_t* mo = (bf16_t*)(ws + WS_MLAO);
            for (int it0 = bid; it0 < 1024; it0 += G) {
                const int it = (G == 256) ? ((((it0 >> 8) * 32 + (it0 & 7) * 4 + ((it0 & 255) >> 6)) << 3) | ((it0 >> 3) & 7)) : it0;
                const int qb = it & 7, h = (it >> 3) & 15, b = it >> 7;
                const size_t srow0 = (size_t)b * SEQ + qb * 256, trow0 = (size_t)b * TT;
                att::mla_body(qm + srow0 * 3072 + h * 192, kvup + trow0 * 4096 + h * 256, kvup + trow0 * 4096 + h * 256 + 128, kr + trow0 * 64, mo + srow0 * 2048 + h * 128, (char*)shm);
            }
        } break;
        case 6: if (PH_ON(6)) {
            const bf16_t* gr = (const bf16_t*)p.out; const bf16_t* gm = gr + (size_t)SROWS * 2048;
            pg8::Gemm g{(const bf16_t*)(ws + WS_ORET), (const bf16_t*)(ws + WS_WRETO), 2048, (const bf16_t*)(ws + WS_MLAO), (const bf16_t*)(ws + WS_WMLAO)}; pg8::Sched<0> S{64, 8, G, bid}; EpiDual E{gr, gm, (bf16_t*)(ws + WS_MIXED)}; pg8::gemm_phase(lds, g, S, E);
        } break;
        case 7: if (PH_ON(7)) {
            pg8::Gemm g{(const bf16_t*)(ws + WS_MIXED), (const bf16_t*)(ws + WS_WOUT), 2048}; pg8::Sched<0> S{64, 8, G, bid}; EpiResid E{p.x, p.out, mod, p.b_ada, 2, 1.f}; pg8::gemm_phase(lds, g, S, E);
        } break;
        case 8: if (PH_ON(8)) rows_norm<1>(p, mod); break;
        case 9: if (PH_ON(9)) {
            pg8::Gemm g{(const bf16_t*)(ws + WS_H2), (const bf16_t*)(ws + WS_WUP), 2048}; pg8::Sched<0> S{64, 44, G, bid}; EpiUp E{(bf16_t*)(ws + WS_VBUF), (bf16_t*)(ws + WS_ASIDE), (bf16_t*)(ws + WS_VSIDE), p.conv_w, p.conv_b}; pg8::gemm_phase(lds, g, S, E);
        } break;
        case 10: if (PH_ON(10)) {
            conv_weight(p.w_down, 2048, (bf16_t*)(ws + WS_WDOWN), FFN, 2048, 0, nullptr, 0, (unsigned*)shm);
            const bf16_t* as_ = (const bf16_t*)(ws + WS_ASIDE); const bf16_t* vs_ = (const bf16_t*)(ws + WS_VSIDE); bf16_t* vb = (bf16_t*)(ws + WS_VBUF);
            constexpr int CV = FFN / 8;
            LOCAL_TID;
            for (int i = bid * 512 + tid; i < 512 * CV; i += G * 512) {
                const int cv = i % CV, sr = i / CV, kb = sr >> 1, last = sr & 1, col = cv * 8, r = kb * 64 + (last ? 63 : 0), sq = r & (SEQ - 1);
                const u32x4 zero4 = {0, 0, 0, 0}; u32x4 prev, curv, nxt, vv;
                if (!last) { prev = sq ? *(const u32x4*)(as_ + (size_t)((kb - 1) * 4 + 3) * FFN + col) : zero4; curv = *(const u32x4*)(as_ + (size_t)(kb * 4) * FFN + col);
                             nxt = *(const u32x4*)(as_ + (size_t)(kb * 4 + 1) * FFN + col); vv = *(const u32x4*)(vs_ + (size_t)(kb * 2) * FFN + col); }
                else { prev = *(const u32x4*)(as_ + (size_t)(kb * 4 + 2) * FFN + col); curv = *(const u32x4*)(as_ + (size_t)(kb * 4 + 3) * FFN + col);
                       nxt = (sq != SEQ - 1) ? *(const u32x4*)(as_ + (size_t)((kb + 1) * 4) * FFN + col) : zero4; vv = *(const u32x4*)(vs_ + (size_t)(kb * 2 + 1) * FFN + col); }
                float o[8];
#pragma unroll
                for (int q = 0; q < 4; ++q) { const unsigned pw = prev[q], cw = curv[q], nw = nxt[q], vw = vv[q]; const int c = col + 2 * q;
                    const float a0 = p.conv_b[c] + p.conv_w[c] * bf_lo(pw) + p.conv_w[FFN + c] * bf_lo(cw) + p.conv_w[2 * FFN + c] * bf_lo(nw);
                    const float a1 = p.conv_b[c + 1] + p.conv_w[c + 1] * bf_hi(pw) + p.conv_w[FFN + c + 1] * bf_hi(cw) + p.conv_w[2 * FFN + c + 1] * bf_hi(nw);
                    o[2 * q] = siluf_(a0) * bf_lo(vw); o[2 * q + 1] = siluf_(a1) * bf_hi(vw); }
                u32x4 w; w.x = cvt_pk_bf16(o[0], o[1]); w.y = cvt_pk_bf16(o[2], o[3]); w.z = cvt_pk_bf16(o[4], o[5]); w.w = cvt_pk_bf16(o[6], o[7]);
                *(u32x4*)(vb + (size_t)r * FFN + col) = w;
            }
        } break;
        case 11: if (PH_ON(11)) {
            pg8::Gemm g{(const bf16_t*)(ws + WS_VBUF), (const bf16_t*)(ws + WS_WDOWN), FFN}; pg8::Sched<0> S{64, 8, G, bid}; EpiResid E{p.out, p.out, mod, p.b_ada, 5, 1.f}; pg8::gemm_phase(lds, g, S, E);
        } break;
        case 12: if (PH_ON(12)) rows_norm<2>(p, mod); break;
        default: break;
        }
        }
    }
}

constexpr int LDS_BYTES = pg8::STAGE_BYTES + 16;
extern "C" void kernel_launch(void* const* d_in, const int* in_sizes, int n_in, void* d_out, int out_size, void* d_ws, size_t ws_size, hipStream_t stream) {
    static int grid = 0;
    if (grid == 0) {
        if (n_in != 22 || out_size != SROWS * DM || ws_size < WS_END) { fprintf(stderr, "kernel_launch: unexpected shapes (n_in %d out %d ws %zu need %zu)\n", n_in, out_size, ws_size, (size_t)WS_END); grid = -1; return; }
        int dev = 0, cus = 0, per_cu = 0;
        hipGetDevice(&dev); hipDeviceGetAttribute(&cus, hipDeviceAttributeMultiprocessorCount, dev);
        if (hipFuncSetAttribute((const void*)fwd_megakernel, hipFuncAttributeMaxDynamicSharedMemorySize, LDS_BYTES) != hipSuccess) { fprintf(stderr, "kernel_launch: hipFuncSetAttribute failed\n"); grid = -1; return; }
        hipOccupancyMaxActiveBlocksPerMultiprocessor(&per_cu, (const void*)fwd_megakernel, 512, LDS_BYTES);
        (void)hipGetLastError();
        if (per_cu < 1) per_cu = 1;
        grid = cus * per_cu; if (grid > 256) grid = 256; grid &= ~7; if (grid < 8) grid = 8;
    }
    if (grid < 0) return;
    hipMemsetAsync(d_ws, 0, WS_ZERO_BYTES, stream);
    Params p{};
    const float** pp = (const float**)&p;
    for (int i = 0; i < 22; ++i) pp[i] = (const float*)d_in[i];
    p.out = (float*)d_out; p.ws = (unsigned char*)d_ws;
#if MK_MULTI
    for (int ph = 0; ph < NPHASE; ++ph) {
#if MK_DEBUG
        hipLaunchKernelGGL(dbg_kernel, dim3(256), dim3(512), 0, stream, p, ph);
#endif
        p.ph_lo = ph; p.ph_hi = ph + 1; hipLaunchKernelGGL(fwd_megakernel, dim3(grid), dim3(512), LDS_BYTES, stream, p); }
#if MK_DEBUG
    hipLaunchKernelGGL(dbg_kernel, dim3(256), dim3(512), 0, stream, p, 13);
#endif
#else
    p.ph_lo = 0; p.ph_hi = NPHASE;
    void* args[] = {&p};
    hipError_t e = hipLaunchCooperativeKernel((const void*)fwd_megakernel, dim3(grid), dim3(512), args, LDS_BYTES, stream);
    if (e != hipSuccess) fprintf(stderr, "cooperative launch failed: %s (grid %d)\n", hipGetErrorString(e), grid);
#endif
}
```
